# Optimizing an MI355X kernel written in HIP

```python
import math
import jax
import jax.numpy as jnp
from jax import lax
import numpy as np

D_MODEL = 1024
BATCH = 8
SEQ = 2048
DEPTH = 2

N_META = 16
HG_HEADS = 8
HG_KDIM = 128
HG_VDIM = 128
HG_WIDTH = HG_HEADS * HG_VDIM
HG_QK_WIDTH = HG_HEADS * HG_KDIM
CHUNK = 16
AT_HEADS = 8
AT_HEAD_DIM = 64
AT_WIDTH = AT_HEADS * 2 * AT_HEAD_DIM
MIX_WIDTH = HG_WIDTH + AT_WIDTH
Q_BLOCK = 128
ROPE_THETA = 10000.0
NORM_EPS = 1e-6
F_FLOOR = 1e-30
IN_COLS = (HG_QK_WIDTH, HG_QK_WIDTH, HG_QK_WIDTH, HG_WIDTH, HG_WIDTH,
           AT_WIDTH, AT_WIDTH, AT_WIDTH, AT_WIDTH)
IN_WIDTH = 9216

kernel_name = "hymba_hgrn2_diffattn_encoder"


def rmsnorm(x, g):
    xf = x.astype(jnp.float32)
    ms = jnp.mean(xf * xf, axis=-1, keepdims=True)
    return xf * lax.rsqrt(ms + NORM_EPS) * g.astype(jnp.float32)


def rope_tables(L):
    inv = ROPE_THETA ** (-jnp.arange(0, AT_HEAD_DIM, 2, dtype=jnp.float32) / AT_HEAD_DIM)
    ang = jnp.arange(L, dtype=jnp.float32)[:, None] * inv[None, :]
    return jnp.cos(ang), jnp.sin(ang)


def apply_rope(t, cos, sin):
    tf = t.astype(jnp.float32)
    half = AT_HEAD_DIM // 2
    t1, t2 = tf[..., :half], tf[..., half:]
    c = cos[None, :, None, None, :]
    s = sin[None, :, None, None, :]
    return jnp.concatenate([t1 * c - t2 * s, t2 * c + t1 * s], axis=-1)


def hgrn2_chunk_scan(q, k, v, log_f):
    Bs, L, H, K = q.shape
    V = v.shape[-1]
    N = L // CHUNK
    q, k, log_f = (t.reshape(Bs, N, CHUNK, H, K) for t in (q, k, log_f))
    v = v.reshape(Bs, N, CHUNK, H, V)
    b = jnp.cumsum(log_f, axis=2)
    b_last = b[:, :, -1:]
    mask = jnp.tril(jnp.ones((CHUNK, CHUNK), dtype=bool))[:, :, None, None]
    diff = b[:, :, :, None] - b[:, :, None, :]
    dec = jnp.where(mask, jnp.exp(jnp.where(mask, diff, 0.0)), 0.0)
    att = jnp.einsum('bnthk,bnshk,bntshk->bnhts', q, k, dec)
    o_intra = jnp.einsum('bnhts,bnshv->bnthv', att, v)
    q_dec = q * jnp.exp(b)
    k_dec = k * jnp.exp(b_last - b)
    decay = jnp.exp(b_last[:, :, 0])

    def step(S, xs):
        qd, kd, vn, dn = xs
        o = jnp.einsum('bthk,bhkv->bthv', qd, S)
        S = dn[..., None] * S + jnp.einsum('bthk,bthv->bhkv', kd, vn)
        return S, o

    xs = (jnp.moveaxis(q_dec, 1, 0), jnp.moveaxis(k_dec, 1, 0),
          jnp.moveaxis(v, 1, 0), jnp.moveaxis(decay, 1, 0))
    S0 = jnp.zeros((Bs, H, K, V), jnp.float32)
    _, o_inter = lax.scan(step, S0, xs)
    o = o_intra + jnp.moveaxis(o_inter, 0, 1)
    return o.reshape(Bs, L, H, V)


def hgrn2_mixer(q, fz_fwd, fz_bwd, i_v, gate, lb, norm_gain):
    Bs, L = q.shape[:2]
    qh = q.reshape(Bs, L, HG_HEADS, HG_KDIM).astype(jnp.float32)
    vh = i_v.reshape(Bs, L, HG_HEADS, HG_VDIM).astype(jnp.float32)

    def gates(z, lb_dir):
        z = z.reshape(Bs, L, HG_HEADS, HG_KDIM).astype(jnp.float32)
        lb_dir = lb_dir.reshape(HG_HEADS, HG_KDIM)
        f = lb_dir + (1.0 - lb_dir) * jax.nn.sigmoid(z)
        k_in = (1.0 - lb_dir) * jax.nn.sigmoid(-z)
        log_f = jnp.log(jnp.maximum(f, F_FLOOR))
        return k_in, log_f

    k_f, a_f = gates(fz_fwd, lb[0])
    k_b, a_b = gates(fz_bwd, lb[1])
    flip = lambda t: jnp.flip(t, axis=1)
    o = hgrn2_chunk_scan(qh, k_f, vh, a_f) + \
        flip(hgrn2_chunk_scan(flip(qh), flip(k_b), flip(vh), flip(a_b)))
    g = gate.reshape(Bs, L, HG_HEADS, HG_VDIM).astype(jnp.float32)
    o = rmsnorm(o, norm_gain) * jax.nn.silu(g)
    return o.reshape(Bs, L, HG_WIDTH)


def diff_attention_mixer(q, k, v, gate, lam_vecs, subln_g, layer_idx, cos, sin):
    Bs, L = q.shape[:2]
    qh = apply_rope(q.reshape(Bs, L, AT_HEADS, 2, AT_HEAD_DIM), cos, sin)
    kh = apply_rope(k.reshape(Bs, L, AT_HEADS, 2, AT_HEAD_DIM), cos, sin)
    vh = v.reshape(Bs, L, AT_HEADS, 2 * AT_HEAD_DIM).astype(jnp.float32)
    lam_init = 0.8 - 0.6 * math.exp(-0.3 * layer_idx)
    lv = lam_vecs.astype(jnp.float32)
    lam = jnp.exp(jnp.sum(lv[0] * lv[1])) - jnp.exp(jnp.sum(lv[2] * lv[3])) + lam_init
    nb = -(-L // Q_BLOCK)
    pad = nb * Q_BLOCK - L
    qp = jnp.pad(qh, ((0, 0), (0, pad), (0, 0), (0, 0), (0, 0)))
    qb = qp.reshape(Bs, nb, Q_BLOCK, AT_HEADS, 2, AT_HEAD_DIM).transpose(1, 0, 2, 3, 4, 5)
    scale = AT_HEAD_DIM ** -0.5

    def block(qblk):
        s = jnp.einsum('bqhcd,bkhcd->bhcqk', qblk, kh) * scale
        p = jax.nn.softmax(s, axis=-1)
        p_diff = p[:, :, 0] - lam * p[:, :, 1]
        return jnp.einsum('bhqk,bkhv->bqhv', p_diff, vh)

    o = lax.map(block, qb)
    o = o.transpose(1, 0, 2, 3, 4).reshape(Bs, nb * Q_BLOCK, AT_HEADS, 2 * AT_HEAD_DIM)[:, :L]
    g = gate.reshape(Bs, L, AT_HEADS, 2 * AT_HEAD_DIM).astype(jnp.float32)
    o = rmsnorm(o, subln_g) * (1.0 - lam_init) * jax.nn.silu(g)
    return o.reshape(Bs, L, AT_WIDTH)


def setup_inputs(seed: int = 0) -> dict:
    key = jax.random.key(seed)
    ks = jax.random.split(key, 10)
    f32 = jnp.float32
    return {
        "x": jax.random.normal(ks[0], (BATCH, SEQ, D_MODEL), f32),
        "meta_tokens": jax.random.normal(ks[1], (N_META, D_MODEL), f32),
        "norm_g": 1.0 + 0.02 * jax.random.normal(ks[2], (DEPTH, D_MODEL), f32),
        "w_in": jax.random.normal(ks[3], (DEPTH, D_MODEL, IN_WIDTH), f32) * D_MODEL ** -0.5,
        "hg_lb_logits": jax.random.normal(ks[4], (DEPTH, 2, HG_QK_WIDTH), f32),
        "hg_norm_g": 1.0 + 0.02 * jax.random.normal(ks[5], (DEPTH, HG_VDIM), f32),
        "diff_lambda": 0.1 * jax.random.normal(ks[6], (DEPTH, 4, AT_HEAD_DIM), f32),
        "diff_subln_g": 1.0 + 0.02 * jax.random.normal(ks[7], (DEPTH, 2 * AT_HEAD_DIM), f32),
        "w_out": jax.random.normal(ks[8], (DEPTH, MIX_WIDTH, D_MODEL), f32) * MIX_WIDTH ** -0.5,
        "final_norm_g": 1.0 + 0.02 * jax.random.normal(ks[9], (D_MODEL,), f32),
    }


def reference(x, meta_tokens, norm_g, w_in, hg_lb_logits, hg_norm_g, diff_lambda,
              diff_subln_g, w_out, final_norm_g):
    dtype = x.dtype
    Bs = x.shape[0]
    meta = jnp.broadcast_to(meta_tokens[None].astype(dtype), (Bs, N_META, D_MODEL))
    h = jnp.concatenate([meta, x], axis=1)
    L = h.shape[1]
    cos, sin = rope_tables(L)
    lbp = jax.nn.softmax(hg_lb_logits.astype(jnp.float32), axis=0)
    lbs = jnp.cumsum(lbp, axis=0) - lbp[0:1]
    split_idx = [int(s) for s in np.cumsum(IN_COLS)[:-1]]
    for l in range(DEPTH):
        u = rmsnorm(h, norm_g[l]).astype(dtype)
        p = u @ w_in[l]
        hq, hf_f, hf_b, hi, hgt, aq, ak, av, agt = jnp.split(p, split_idx, axis=-1)
        o_h = hgrn2_mixer(hq, hf_f, hf_b, hi, hgt, lbs[l], hg_norm_g[l])
        o_a = diff_attention_mixer(aq, ak, av, agt, diff_lambda[l], diff_subln_g[l], l, cos, sin)
        mixed = jnp.concatenate([o_h, o_a], axis=-1).astype(dtype)
        h = h + mixed @ w_out[l]
    out = rmsnorm(h, final_norm_g).astype(dtype)
    return out[:, N_META:]
```

```cpp
#include <hip/hip_runtime.h>
#include <cstdio>
#include <cstdint>
#include <cmath>

namespace nv {
constexpr int D = 1024, BATCH = 8, SEQ = 2048, NMETA = 16, L = SEQ + NMETA, T = BATCH * L;
constexpr int INW = 9216, MIXW = 2048, NH = 8;
constexpr float EPS = 1e-6f, F_FLOOR = 1e-30f;

__device__ __forceinline__ float wave_sum(float v) {
#pragma unroll
    for (int o = 1; o < 64; o <<= 1) v += __shfl_xor(v, o);
    return v;
}
__device__ __forceinline__ float wave_max(float v) {
#pragma unroll
    for (int o = 1; o < 64; o <<= 1) v = fmaxf(v, __shfl_xor(v, o));
    return v;
}
__device__ __forceinline__ float sigmoidf_(float z) { return 1.0f / (1.0f + expf(-z)); }
__device__ __forceinline__ float siluf_(float z) { return z / (1.0f + expf(-z)); }

__global__ void k_build_h(const float* __restrict__ x, const float* __restrict__ meta, float* __restrict__ h) {
    const size_t n4 = (size_t)T * D / 4;
    for (size_t i = blockIdx.x * (size_t)blockDim.x + threadIdx.x; i < n4; i += (size_t)gridDim.x * blockDim.x) {
        const size_t e = i * 4; const int d = (int)(e % D); const size_t row = e / D; const int b = (int)(row / L), t = (int)(row % L);
        const float4 v = t < NMETA ? *(const float4*)(meta + (size_t)t * D + d) : *(const float4*)(x + ((size_t)b * SEQ + (t - NMETA)) * D + d);
        *(float4*)(h + e) = v;
    }
}
__global__ void k_rmsnorm(const float* __restrict__ in, const float* __restrict__ g, float* __restrict__ out, int rows, int drop_meta) {
    const int wave = (blockIdx.x * blockDim.x + threadIdx.x) >> 6, lane = threadIdx.x & 63;
    if (wave >= rows) return;
    int orow = wave;
    if (drop_meta) { const int b = wave / L, t = wave % L; if (t < NMETA) return; orow = b * SEQ + (t - NMETA); }
    const float* r = in + (size_t)wave * D; float v[16]; float s = 0.f;
#pragma unroll
    for (int j = 0; j < 16; ++j) { v[j] = r[lane + 64 * j]; s += v[j] * v[j]; }
    s = wave_sum(s); const float rs = rsqrtf(s * (1.0f / D) + EPS);
#pragma unroll
    for (int j = 0; j < 16; ++j) out[(size_t)orow * D + lane + 64 * j] = v[j] * rs * g[lane + 64 * j];
}
__global__ void __launch_bounds__(256) k_gemm(const float* __restrict__ A, int lda, const float* __restrict__ B, int ldb, float* __restrict__ C, int ldc,
                                              int M, int N, int K, int accumulate) {
    __shared__ float As[16][68], Bs[16][68];
    const int tid = threadIdx.x, tx = tid & 15, ty = tid >> 4, m0 = blockIdx.y * 64, n0 = blockIdx.x * 64;
    float acc[4][4];
#pragma unroll
    for (int i = 0; i < 4; ++i)
#pragma unroll
        for (int j = 0; j < 4; ++j) acc[i][j] = 0.f;
    for (int k0 = 0; k0 < K; k0 += 16) {
        { const int r = tid >> 2, c = (tid & 3) * 4; const int gr = m0 + r; float4 a = make_float4(0.f, 0.f, 0.f, 0.f);
          if (gr < M) a = *(const float4*)(A + (size_t)gr * lda + k0 + c);
          As[c + 0][r] = a.x; As[c + 1][r] = a.y; As[c + 2][r] = a.z; As[c + 3][r] = a.w; }
        { const int r = tid >> 4, c = (tid & 15) * 4; const float4 b = *(const float4*)(B + (size_t)(k0 + r) * ldb + n0 + c);
          Bs[r][c + 0] = b.x; Bs[r][c + 1] = b.y; Bs[r][c + 2] = b.z; Bs[r][c + 3] = b.w; }
        __syncthreads();
#pragma unroll
        for (int kk = 0; kk < 16; ++kk) {
            float a[4], b[4];
#pragma unroll
            for (int i = 0; i < 4; ++i) a[i] = As[kk][ty * 4 + i];
#pragma unroll
            for (int j = 0; j < 4; ++j) b[j] = Bs[kk][tx * 4 + j];
#pragma unroll
            for (int i = 0; i < 4; ++i)
#pragma unroll
                for (int j = 0; j < 4; ++j) acc[i][j] = fmaf(a[i], b[j], acc[i][j]);
        }
        __syncthreads();
    }
#pragma unroll
    for (int i = 0; i < 4; ++i) { const int gr = m0 + ty * 4 + i; if (gr >= M) continue;
        float* cp = C + (size_t)gr * ldc + n0 + tx * 4;
        float4 o = make_float4(acc[i][0], acc[i][1], acc[i][2], acc[i][3]);
        if (accumulate) { const float4 c = *(const float4*)cp; o.x += c.x; o.y += c.y; o.z += c.z; o.w += c.w; }
        *(float4*)cp = o; }
}
__global__ void k_rope(float* __restrict__ p) {
    const int idx = blockIdx.x * blockDim.x + threadIdx.x;
    if (idx >= L * 2 * NH * 2 * 32) return;
    const int i = idx & 31, c = (idx >> 5) & 1, hd = (idx >> 6) & 7, which = (idx >> 9) & 1, t = idx >> 10;
    const float inv = powf(10000.0f, -(float)(2 * i) / 64.0f); const float ang = (float)t * inv;
    const float cs = cosf(ang), sn = sinf(ang);
    float* base = p + (size_t)t * INW + 5120 + which * 1024 + hd * 128 + c * 64;
    const float t1 = base[i], t2 = base[32 + i];
    base[i] = t1 * cs - t2 * sn; base[32 + i] = t2 * cs + t1 * sn;
}
__global__ void __launch_bounds__(256) k_hgrn(const float* __restrict__ p, const float* __restrict__ lb_logits  , int layer,
                                              float* __restrict__ o_f, float* __restrict__ o_b) {
    __shared__ float sq[128], sf[128], sk[128], sacc[256];
    const int hd = blockIdx.x, dir = blockIdx.y, tid = threadIdx.x, v = tid & 127, kh = tid >> 7;
    float lb = 0.f;
    if (tid < 128) { if (layer == 1) { const float l0 = lb_logits[(0 * 2 + dir) * 1024 + hd * 128 + tid], l1 = lb_logits[(1 * 2 + dir) * 1024 + hd * 128 + tid];
            const float m = fmaxf(l0, l1); const float e0 = expf(l0 - m), e1 = expf(l1 - m); lb = e1 / (e0 + e1); } }
    float S[64];
#pragma unroll
    for (int k = 0; k < 64; ++k) S[k] = 0.f;
    float* out = dir == 0 ? o_f : o_b;
    for (int step = 0; step < L; ++step) {
        const int t = dir == 0 ? step : L - 1 - step;
        const float* row = p + (size_t)t * INW;
        if (tid < 128) {
            const float z = row[(dir == 0 ? 1024 : 2048) + hd * 128 + tid];
            const float s = sigmoidf_(z), sn = sigmoidf_(-z);
            sq[tid] = row[hd * 128 + tid]; sf[tid] = lb + (1.0f - lb) * s; sk[tid] = (1.0f - lb) * sn;
        }
        const float vv = row[3072 + hd * 128 + v];
        __syncthreads();
        float acc = 0.f;
#pragma unroll
        for (int k = 0; k < 64; ++k) { const int kk = kh * 64 + k; S[k] = fmaf(sf[kk], S[k], sk[kk] * vv); acc = fmaf(S[k], sq[kk], acc); }
        sacc[tid] = acc;
        __syncthreads();
        if (tid < 128) out[(size_t)t * 1024 + hd * 128 + tid] = sacc[tid] + sacc[tid + 128];
    }
}
__global__ void k_hgrn_final(const float* __restrict__ o_f, const float* __restrict__ o_b, const float* __restrict__ p, const float* __restrict__ g, float* __restrict__ mixed) {
    const int wave = (blockIdx.x * blockDim.x + threadIdx.x) >> 6, lane = threadIdx.x & 63;
    if (wave >= L * NH) return;
    const int t = wave >> 3, hd = wave & 7;
    const size_t off = (size_t)t * 1024 + hd * 128;
    const float a0 = o_f[off + lane] + o_b[off + lane], a1 = o_f[off + 64 + lane] + o_b[off + 64 + lane];
    const float ss = wave_sum(a0 * a0 + a1 * a1); const float rs = rsqrtf(ss * (1.0f / 128.0f) + EPS);
    const float g0 = p[(size_t)t * INW + 4096 + hd * 128 + lane], g1 = p[(size_t)t * INW + 4096 + hd * 128 + 64 + lane];
    mixed[(size_t)t * MIXW + hd * 128 + lane] = a0 * rs * g[lane] * siluf_(g0);
    mixed[(size_t)t * MIXW + hd * 128 + 64 + lane] = a1 * rs * g[64 + lane] * siluf_(g1);
}
constexpr int NKP = ((L + 63) / 64) * 64;
__global__ void __launch_bounds__(128) k_attn(const float* __restrict__ p, const float* __restrict__ lamv  , const float* __restrict__ subg, int layer, float* __restrict__ mixed) {
    __shared__ float sq[2][128]; __shared__ float sp[2][NKP]; __shared__ float st[2][NKP];
    const int wid = threadIdx.x >> 6, lane = threadIdx.x & 63; const int gw = blockIdx.x * 2 + wid;
    const int t = gw >> 3, hd = gw & 7;
    const float lam_init = 0.8f - 0.6f * expf(-0.3f * (float)layer);
    float d1 = lamv[lane] * lamv[64 + lane], d2 = lamv[128 + lane] * lamv[192 + lane];
    d1 = wave_sum(d1); d2 = wave_sum(d2);
    const float lam = expf(d1) - expf(d2) + lam_init;
    const float* qrow = p + (size_t)t * INW + 5120 + hd * 128;
    sq[wid][lane] = qrow[lane]; sq[wid][64 + lane] = qrow[64 + lane];
    __syncthreads();
#pragma unroll 1
    for (int c = 0; c < 2; ++c) {
        float m = -INFINITY;
#pragma unroll 1
        for (int key = lane; key < L; key += 64) {
            const float* kr = p + (size_t)key * INW + 6144 + hd * 128 + c * 64; float a = 0.f;
#pragma unroll 4
            for (int d = 0; d < 64; d += 4) { const float4 k0 = *(const float4*)(kr + d);
                a += sq[wid][c * 64 + d] * k0.x + sq[wid][c * 64 + d + 1] * k0.y + sq[wid][c * 64 + d + 2] * k0.z + sq[wid][c * 64 + d + 3] * k0.w; }
            a *= 0.125f; st[wid][key] = a; m = fmaxf(m, a);
        }
        m = wave_max(m);
        float l = 0.f;
#pragma unroll 1
        for (int key = lane; key < L; key += 64) { const float e = expf(st[wid][key] - m); st[wid][key] = e; l += e; }
        l = wave_sum(l);
        const float sc = c == 0 ? 1.0f / l : -lam / l;
#pragma unroll 1
        for (int key = lane; key < L; key += 64) { const float v = st[wid][key] * sc; sp[wid][key] = c == 0 ? v : sp[wid][key] + v; }
    }
    __syncthreads();
    float o0 = 0.f, o1 = 0.f;
#pragma unroll 4
    for (int key = 0; key < L; ++key) { const float pd = sp[wid][key]; const float* vr = p + (size_t)key * INW + 7168 + hd * 128;
        o0 = fmaf(pd, vr[lane], o0); o1 = fmaf(pd, vr[64 + lane], o1); }
    const float ss = wave_sum(o0 * o0 + o1 * o1); const float rs = rsqrtf(ss * (1.0f / 128.0f) + EPS) * (1.0f - lam_init);
    const float g0 = p[(size_t)t * INW + 8192 + hd * 128 + lane], g1 = p[(size_t)t * INW + 8192 + hd * 128 + 64 + lane];
    mixed[(size_t)t * MIXW + 1024 + hd * 128 + lane] = o0 * rs * subg[lane] * siluf_(g0);
    mixed[(size_t)t * MIXW + 1024 + hd * 128 + 64 + lane] = o1 * rs * subg[64 + lane] * siluf_(g1);
}
}

extern "C" void kernel_launch(void* const* d_in, const int* in_sizes, int n_in, void* d_out, int out_size, void* d_ws, size_t ws_size, hipStream_t stream) {
    using namespace nv;
    const float* x = (const float*)d_in[0]; const float* meta = (const float*)d_in[1]; const float* norm_g = (const float*)d_in[2]; const float* w_in = (const float*)d_in[3];
    const float* lb_logits = (const float*)d_in[4]; const float* hg_norm_g = (const float*)d_in[5]; const float* diff_lambda = (const float*)d_in[6];
    const float* subln_g = (const float*)d_in[7]; const float* w_out = (const float*)d_in[8]; const float* final_g = (const float*)d_in[9];
    float* out = (float*)d_out;
    float* ws = (float*)d_ws; size_t off = 0;
    float* h = ws + off; off += (size_t)T * D;
    float* ub = ws + off; off += (size_t)L * D;
    float* pb = ws + off; off += (size_t)L * INW;
    float* of = ws + off; off += (size_t)L * 1024;
    float* ob = ws + off; off += (size_t)L * 1024;
    float* mx = ws + off; off += (size_t)L * MIXW;
    if (off * 4 > ws_size) { fprintf(stderr, "kernel_launch: workspace too small: need %zu have %zu\n", off * 4, ws_size); return; }
    k_build_h<<<2048, 256, 0, stream>>>(x, meta, h);
    for (int l = 0; l < 2; ++l) {
        for (int b = 0; b < BATCH; ++b) {
            float* hb = h + (size_t)b * L * D;
            k_rmsnorm<<<(L + 3) / 4, 256, 0, stream>>>(hb, norm_g + l * D, ub, L, 0);
            k_gemm<<<dim3(INW / 64, (L + 63) / 64), 256, 0, stream>>>(ub, D, w_in + (size_t)l * D * INW, INW, pb, INW, L, INW, D, 0);
            k_rope<<<(L * 2 * NH * 2 * 32 + 255) / 256, 256, 0, stream>>>(pb);
            k_hgrn<<<dim3(NH, 2), 256, 0, stream>>>(pb, lb_logits, l, of, ob);
            k_hgrn_final<<<(L * NH + 3) / 4, 256, 0, stream>>>(of, ob, pb, hg_norm_g + l * 128, mx);
            k_attn<<<L * NH / 2, 128, 0, stream>>>(pb, diff_lambda + l * 256, subln_g + l * 128, l, mx);
            k_gemm<<<dim3(D / 64, (L + 63) / 64), 256, 0, stream>>>(mx, MIXW, w_out + (size_t)l * MIXW * D, D, hb, D, L, D, MIXW, 1);
        }
    }
    k_rmsnorm<<<(T + 3) / 4, 256, 0, stream>>>(h, final_g, out, T, 1);
}
```

```cpp
#include <hip/hip_runtime.h>
#include <hip/hip_bf16.h>
#include <cstdio>
#include <cstdint>
#include <cmath>
namespace pg8 {
#define PG8_LAS __attribute__((address_space(3)))
typedef unsigned short bf16_t;
typedef short bf16x8 __attribute__((ext_vector_type(8)));
typedef float f32x4 __attribute__((ext_vector_type(4)));
typedef unsigned u32x4 __attribute__((ext_vector_type(4)));
constexpr int BM = 256, BK = 64, HALF = 128, HTB = HALF * BK * 2  , STAGE_BYTES = 8 * HTB, NXCD = 8, WGM = 8;

__host__ __device__ __forceinline__ int lds_byte(int r, int c) { const int st = (r >> 4) * 2 + (c >> 5), rr = r & 15, cc = c & 31, ob = rr * 64 + cc * 2; return st * 1024 + (ob ^ (((ob >> 9) & 1) << 5)); }
__host__ __device__ __forceinline__ void stage_rc(int b, int& R, int& C) { const int st = b / 1024, sb = b % 1024, swz = sb ^ (((sb >> 9) & 1) << 5); R = (st >> 1) * 16 + swz / 64; C = (st & 1) * 32 + (swz % 64) / 2; }
__host__ __device__ __forceinline__ int perm32(int rho) { const int n = rho >> 4, i = rho & 15; return 8 * (i >> 2) + 4 * n + (i & 3); }

struct Unit { int pm, pn; };
struct Gemm { const bf16_t* A; const bf16_t* Bt; int M, N, K; };

struct StaticOrder {
    int nM, nN, nwg, G, c;
    __host__ __device__ void init(int M, int N, int G_, int c_) { nM = M / BM; nN = N / BM; nwg = nM * nN; G = G_; c = c_; }
    __host__ __device__ bool next(int i, Unit& u) const {
        const long L = (long)i * G + c; if (L >= nwg) return false;
        int wgid = (int)L; { const int q = nwg / NXCD, r = nwg % NXCD, xcd = wgid % NXCD, off = wgid / NXCD; wgid = (xcd < r ? xcd * (q + 1) : r * (q + 1) + (xcd - r) * q) + off; }
        const int nig = WGM * nN, gid = wgid / nig, fm = gid * WGM, gsz = (nM - fm) < WGM ? (nM - fm) : WGM;
        u.pm = fm + ((wgid % nig) % gsz); u.pn = (wgid % nig) / gsz; return true;
    }
    __device__ __forceinline__ void a_ready(const Unit&) const {}
    __device__ __forceinline__ void done(const Unit&) const {}
};

__device__ __forceinline__ unsigned cvt_pk_bf16(float lo, float hi) { unsigned r; asm volatile("v_cvt_pk_bf16_f32 %0, %1, %2" : "=v"(r) : "v"(lo), "v"(hi)); return r; }
}
constexpr int DM = 1024, NBATCH = 8, SEQ = 2048, NMETA = 16, LTOK = SEQ + NMETA, NHEAD = 8, INW = 9216;
constexpr int HROWS = 8448;
constexpr int NWAVES = 8, NTHREADS = 512;
constexpr float NEPS = 1e-6f;
constexpr size_t MiB = 1u << 20;
constexpr size_t WS_CTL = 0, CTL_ZERO_BYTES = 1 * MiB;
constexpr size_t WS_ROPE = 1 * MiB;
constexpr size_t WS_HMETA = 2 * MiB;
constexpr size_t WS_WIN = 3 * MiB;
constexpr size_t WS_WOUT = WS_WIN + 36 * MiB;
constexpr size_t WS_U = WS_WOUT + 8 * MiB;
constexpr size_t SZ_HALF = (size_t)HROWS * 1024 * 2;
constexpr size_t WS_GQ = WS_U + 2 * SZ_HALF;
constexpr size_t WS_QDF = WS_GQ + 4 * SZ_HALF, WS_KTF = WS_QDF + SZ_HALF, WS_QDB = WS_KTF + SZ_HALF, WS_KTB = WS_QDB + SZ_HALF, WS_VH = WS_KTB + SZ_HALF;
constexpr size_t WS_KA = WS_VH + SZ_HALF, WS_VA = WS_KA + SZ_HALF, WS_GA = WS_VA + SZ_HALF;
constexpr size_t SZ_DEC = (size_t)(HROWS / 16) * 1024 * 4;
constexpr size_t WS_DECF = WS_GA + SZ_HALF, WS_DECB = WS_DECF + SZ_DEC, WS_END = WS_DECB + SZ_DEC;
static_assert(WS_END <= 288 * MiB, "workspace map must fit 4 x largest tensor");
constexpr int CW_BAR = 4096;
constexpr int CW_QUEUE = 16384;
constexpr int RING_BYTES = 131072, LDSCTL_OFF = RING_BYTES, MISC_OFF = LDSCTL_OFF + 320, LDS_BYTES = 147456;


namespace pg8 {
typedef unsigned u32x2 __attribute__((ext_vector_type(2)));
__device__ __forceinline__ float fexp(float x) { return __builtin_amdgcn_exp2f(x * 1.4426950408889634f); }
__device__ __forceinline__ float flog(float x) { return __builtin_amdgcn_logf(x) * 0.6931471805599453f; }
__device__ __forceinline__ float frcp(float x) { return __builtin_amdgcn_rcpf(x); }
__device__ __forceinline__ float fsilu(float z) { const float zc = fminf(fmaxf(z, -80.f), 80.f); return z * frcp(1.0f + fexp(-zc)); }
__device__ __forceinline__ float scan16(float x) {
    x += __builtin_bit_cast(float, __builtin_amdgcn_update_dpp(0, __builtin_bit_cast(int, x), 0x111, 0xf, 0xf, true));
    x += __builtin_bit_cast(float, __builtin_amdgcn_update_dpp(0, __builtin_bit_cast(int, x), 0x112, 0xf, 0xf, true));
    x += __builtin_bit_cast(float, __builtin_amdgcn_update_dpp(0, __builtin_bit_cast(int, x), 0x114, 0xf, 0xf, true));
    x += __builtin_bit_cast(float, __builtin_amdgcn_update_dpp(0, __builtin_bit_cast(int, x), 0x118, 0xf, 0xf, true));
    return x;
}
constexpr float QSCALE = 0.125f * 1.4426950408889634f;

struct EpiIn {
    static constexpr bool PERM = true, AFTER_DRAIN = false;
    unsigned char* ws;
    size_t gq_half;
    const float* lbl;
    int layer;
    __device__ __forceinline__ void operator()(const f32x4 (&acc)[2][2][4][2], const Unit& u, int wr, int wc, int fr, int fq) const {
        const int rowb = u.pm * BM + wr * 64 + fr;
        if (u.pn < 16) {
            const int ch0 = u.pn * 64 + wc * 16 + fq * 4;
            float lbf[4], lbb[4];
#pragma unroll
            for (int e = 0; e < 4; ++e) { lbf[e] = 0.f; lbb[e] = 0.f; }
            if (layer == 1) {
#pragma unroll
                for (int e = 0; e < 4; ++e) {
                    lbf[e] = frcp(1.0f + fexp(lbl[0 * 1024 + ch0 + e] - lbl[2048 + 0 * 1024 + ch0 + e]));
                    lbb[e] = frcp(1.0f + fexp(lbl[1 * 1024 + ch0 + e] - lbl[2048 + 1 * 1024 + ch0 + e]));
                }
            }
#pragma unroll
            for (int ai = 0; ai < 2; ++ai)
#pragma unroll
                for (int m = 0; m < 4; ++m) {
                    const int row = rowb + ai * HALF + m * 16; const int chunk = row >> 4;
                    const f32x4 q = acc[ai][0][m][0], zf = acc[ai][0][m][1], zb = acc[ai][1][m][0], vi = acc[ai][1][m][1];
                    float qdf[4], ktf[4], qdb[4], ktb[4], dcf[4], dcb[4];
#pragma unroll
                    for (int e = 0; e < 4; ++e) {
                        {   const float z = fminf(fmaxf(zf[e], -80.f), 80.f);
                            const float t = fexp(-z), s = frcp(1.0f + t);
                            const float f = lbf[e] + (1.0f - lbf[e]) * s, kin = (1.0f - lbf[e]) * t * s;
                            const float a = flog(fmaxf(f, 1e-30f));
                            const float b = scan16(a);
                            const float E = fexp(b);
                            qdf[e] = q[e] * E; ktf[e] = kin * fexp(fminf(-b, 80.f)); dcf[e] = E; }
                        {   const float z = fminf(fmaxf(zb[e], -80.f), 80.f);
                            const float t = fexp(-z), s = frcp(1.0f + t);
                            const float f = lbb[e] + (1.0f - lbb[e]) * s, kin = (1.0f - lbb[e]) * t * s;
                            const float a = flog(fmaxf(f, 1e-30f));
                            const float b = scan16(a);
                            const float tot = __shfl(b, 15, 16);
                            const float bb = tot - b + a;
                            const float E = fexp(bb);
                            qdb[e] = q[e] * E; ktb[e] = kin * fexp(fminf(-bb, 80.f)); dcb[e] = E; }
                    }
                    unsigned char* o = ws + ((size_t)row * 1024 + ch0) * 2;
                    *(u32x2*)(o + WS_QDF) = (u32x2){cvt_pk_bf16(qdf[0], qdf[1]), cvt_pk_bf16(qdf[2], qdf[3])};
                    *(u32x2*)(o + WS_KTF) = (u32x2){cvt_pk_bf16(ktf[0], ktf[1]), cvt_pk_bf16(ktf[2], ktf[3])};
                    *(u32x2*)(o + WS_QDB) = (u32x2){cvt_pk_bf16(qdb[0], qdb[1]), cvt_pk_bf16(qdb[2], qdb[3])};
                    *(u32x2*)(o + WS_KTB) = (u32x2){cvt_pk_bf16(ktb[0], ktb[1]), cvt_pk_bf16(ktb[2], ktb[3])};
                    *(u32x2*)(o + WS_VH)  = (u32x2){cvt_pk_bf16(vi[0], vi[1]), cvt_pk_bf16(vi[2], vi[3])};
                    if (fr == 15 || fr == 0) { const bool fw = fr == 15;
                        *(f32x4*)(ws + (fw ? WS_DECF : WS_DECB) + ((size_t)chunk * 1024 + ch0) * 4) = fw ? (f32x4){dcf[0], dcf[1], dcf[2], dcf[3]} : (f32x4){dcb[0], dcb[1], dcb[2], dcb[3]}; }
                    asm volatile("" ::: "memory");
                }
        } else if (u.pn >= 20 && u.pn < 28) {
            const bool isq = u.pn < 24;
            const int colt = (u.pn - (isq ? 20 : 24)) * BM + wc * 32 + 8 * fq;
            const float sc = isq ? QSCALE : 1.0f;
            unsigned char* base = ws + (isq ? (WS_GQ + gq_half + 2048) : WS_KA); const int ld = isq ? 2048 : 1024;
#pragma unroll
            for (int ai = 0; ai < 2; ++ai)
#pragma unroll
                for (int m = 0; m < 4; ++m) {
                    const int row = rowb + ai * HALF + m * 16;
                    const int tpos = row < 8192 ? 16 + (row & 2047) : ((row - 8192) & 15);
                    const float* rp = (const float*)(ws + WS_ROPE) + (size_t)tpos * 64;
#pragma unroll
                    for (int bj = 0; bj < 2; ++bj) {
                        const int col = colt + bj * HALF;
                        const int i0 = (col & 63) >> 1;
                        const f32x4 cs0 = *(const f32x4*)(rp + 2 * i0), cs1 = *(const f32x4*)(rp + 2 * i0 + 4);
                        const f32x4 a = acc[ai][bj][m][0], b = acc[ai][bj][m][1];
                        const float o0 = a[0] * cs0[0] - a[1] * cs0[1], o1 = a[1] * cs0[0] + a[0] * cs0[1];
                        const float o2 = a[2] * cs0[2] - a[3] * cs0[3], o3 = a[3] * cs0[2] + a[2] * cs0[3];
                        const float o4 = b[0] * cs1[0] - b[1] * cs1[1], o5 = b[1] * cs1[0] + b[0] * cs1[1];
                        const float o6 = b[2] * cs1[2] - b[3] * cs1[3], o7 = b[3] * cs1[2] + b[2] * cs1[3];
                        u32x4 w; w.x = cvt_pk_bf16(o0 * sc, o1 * sc); w.y = cvt_pk_bf16(o2 * sc, o3 * sc); w.z = cvt_pk_bf16(o4 * sc, o5 * sc); w.w = cvt_pk_bf16(o6 * sc, o7 * sc);
                        *(u32x4*)(base + ((size_t)row * ld + col) * 2) = w;
                    }
                    asm volatile("" ::: "memory");
                }
        } else {
            const bool isg = u.pn < 20, isv = (u.pn >= 28 && u.pn < 32);
            const int colt = (u.pn - (isg ? 16 : (isv ? 28 : 32))) * BM + wc * 32 + 8 * fq;
            unsigned char* base = ws + (isg ? (WS_GQ + gq_half) : (isv ? WS_VA : WS_GA)); const int ld = isg ? 2048 : 1024;
#pragma unroll
            for (int ai = 0; ai < 2; ++ai)
#pragma unroll
                for (int m = 0; m < 4; ++m) {
                    const int row = rowb + ai * HALF + m * 16;
#pragma unroll
                    for (int bj = 0; bj < 2; ++bj) {
                        f32x4 a = acc[ai][bj][m][0], b = acc[ai][bj][m][1];
                        if (!isv) {
#pragma unroll
                            for (int e = 0; e < 4; ++e) { a[e] = fsilu(a[e]); b[e] = fsilu(b[e]); }
                        }
                        u32x4 w; w.x = cvt_pk_bf16(a[0], a[1]); w.y = cvt_pk_bf16(a[2], a[3]); w.z = cvt_pk_bf16(b[0], b[1]); w.w = cvt_pk_bf16(b[2], b[3]);
                        *(u32x4*)(base + ((size_t)row * ld + colt + bj * HALF) * 2) = w;
                    }
                    asm volatile("" ::: "memory");
                }
        }
    }
};
struct EpiOut {
    static constexpr bool PERM = false, AFTER_DRAIN = false;
    const float* hin; float* hout;
    __device__ __forceinline__ void operator()(const f32x4 (&acc)[2][2][4][2], const Unit& u, int wr, int wc, int fr, int fq) const {
        const int rowb = u.pm * BM + wr * 64 + fr, colb = u.pn * BM + wc * 32 + 4 * fq;
#pragma unroll
        for (int ai = 0; ai < 2; ++ai)
#pragma unroll
            for (int m = 0; m < 4; ++m) {
                const size_t ro = (size_t)(rowb + ai * HALF + m * 16) * 1024;
#pragma unroll
                for (int bj = 0; bj < 2; ++bj)
#pragma unroll
                    for (int n = 0; n < 2; ++n) {
                        const size_t o = ro + colb + bj * HALF + n * 16;
                        const f32x4 hv = *(const f32x4*)(hin + o);
                        *(f32x4*)(hout + o) = hv + acc[ai][bj][m][n];
                    }
            }
    }
};
struct OrderIn : StaticOrder { __device__ __forceinline__ size_t arow(int pm) const { return (size_t)pm * BM; } };
struct OrderOut : StaticOrder { __device__ __forceinline__ size_t arow(int pm) const { return (size_t)(pm >> 5) * 8448 + (size_t)(pm & 31) * BM; } };

template <class Epi, class Sched, bool ALIGN_EPI = false, bool SP2 = false>
__device__ __forceinline__ void gemm_phase(PG8_LAS unsigned char* lds, const Gemm g, const Sched& S, const Epi& E) {
    int tid_l = threadIdx.x; asm volatile("; LAUNDER" : "+v"(tid_l));
    const int tid = tid_l, wid = __builtin_amdgcn_readfirstlane(tid >> 6), lane = tid & 63, wr = wid >> 2, wc = wid & 3, fr = lane & 15, fq = lane >> 4;
    const int K = g.K, nt = K / BK;
    unsigned voffA[2], voffB[2];
#pragma unroll
    for (int i = 0; i < 2; ++i) { int R, C; stage_rc(tid * 16 + i * 8192, R, C); const int Rb = Epi::PERM ? ((R & ~31) + perm32(R & 31)) : R;
        voffA[i] = (unsigned)(R * K + C) * 2u; voffB[i] = (unsigned)(Rb * K + C) * 2u; }
    const size_t kstep = (size_t)(BK * 2);
    const size_t hstep = (size_t)HALF * K * 2;
    const size_t tstep = 2 * hstep;
    const unsigned ldsw = (unsigned)wid * 1024u;
    const int aoff = lds_byte(wr * 64 + fr, fq * 8), boff = lds_byte(wc * 32 + fr, fq * 8);
#define PG8_SA(b, h) (((b) * 2 + (h)) * HTB)
#define PG8_SB(b, h) ((4 + (b) * 2 + (h)) * HTB)
#define PG8_STAGE(bufoff, gbase, voff) do { _Pragma("unroll") for (int _i = 0; _i < 2; ++_i) \
        __builtin_amdgcn_global_load_lds((const unsigned*)((const char*)(gbase) + (voff)[_i]), (PG8_LAS unsigned*)(lds + (bufoff) + ldsw + _i * 8192), 16, 0, 0); } while (0)
#define PG8_LDA(dst, b, h) do { _Pragma("unroll") for (int m = 0; m < 4; ++m) _Pragma("unroll") for (int k = 0; k < 2; ++k) dst[m][k] = *(const PG8_LAS bf16x8*)(lds + PG8_SA(b, h) + aoff + m * 2048 + k * 1024); } while (0)
#define PG8_LDB(dst, b, h) do { _Pragma("unroll") for (int n = 0; n < 2; ++n) _Pragma("unroll") for (int k = 0; k < 2; ++k) dst[n][k] = *(const PG8_LAS bf16x8*)(lds + PG8_SB(b, h) + boff + n * 2048 + k * 1024); } while (0)
#define PG8_MMA(ai, bj, At, Bt) do { __builtin_amdgcn_s_setprio(1); _Pragma("unroll") for (int m = 0; m < 4; ++m) _Pragma("unroll") for (int n = 0; n < 2; ++n) _Pragma("unroll") for (int k = 0; k < 2; ++k) \
        acc[ai][bj][m][n] = __builtin_amdgcn_mfma_f32_16x16x32_bf16(Bt[n][k], At[m][k], acc[ai][bj][m][n], 0, 0, 0); __builtin_amdgcn_s_setprio(0); } while (0)
#define PG8_WAIT_V(n) asm volatile("s_waitcnt vmcnt(" #n ")" ::: "memory")
#define PG8_WAIT_L(n) asm volatile("s_waitcnt lgkmcnt(" #n ")" ::: "memory")
#define PG8_BAR __builtin_amdgcn_s_barrier()
#define PG8_SCHED __builtin_amdgcn_sched_barrier(0)
    Unit cur, nxt; int ui = 0;
    if (!S.next(0, cur)) return;
    f32x4 acc[2][2][4][2];
#pragma unroll
    for (int a = 0; a < 2; ++a)
#pragma unroll
        for (int b = 0; b < 2; ++b)
#pragma unroll
            for (int m = 0; m < 4; ++m)
#pragma unroll
                for (int n = 0; n < 2; ++n) acc[a][b][m][n] = (f32x4){0.f, 0.f, 0.f, 0.f};
    bf16x8 At[4][2], B0[2][2], B1[2][2];
    const char* cA = (const char*)g.A + S.arow(cur.pm) * (size_t)(K * 2); const char* cB = (const char*)g.Bt + (size_t)cur.pn * tstep;
    S.a_ready(cur);
    if constexpr (SP2) {
        PG8_STAGE(PG8_SB(0, 0), cB, voffB); PG8_STAGE(PG8_SB(0, 1), cB + hstep, voffB); PG8_STAGE(PG8_SA(0, 0), cA, voffA); PG8_STAGE(PG8_SA(0, 1), cA + hstep, voffA);
        if (wr == 1) PG8_BAR;
        PG8_WAIT_V(2); PG8_BAR;
        PG8_STAGE(PG8_SB(1, 0), cB + kstep, voffB); PG8_STAGE(PG8_SA(1, 0), cA + kstep, voffA); PG8_STAGE(PG8_SB(1, 1), cB + hstep + kstep, voffB);
        PG8_WAIT_V(6); PG8_BAR;
    } else {
        PG8_STAGE(PG8_SB(0, 0), cB, voffB); PG8_STAGE(PG8_SA(0, 0), cA, voffA); PG8_STAGE(PG8_SB(0, 1), cB + hstep, voffB); PG8_STAGE(PG8_SA(0, 1), cA + hstep, voffA);
        if (wr == 1) PG8_BAR;
        PG8_WAIT_V(4); PG8_BAR;
        PG8_STAGE(PG8_SB(1, 0), cB + kstep, voffB); PG8_STAGE(PG8_SA(1, 0), cA + kstep, voffA); PG8_STAGE(PG8_SB(1, 1), cB + hstep + kstep, voffB);
        PG8_WAIT_V(6); PG8_BAR;
    }
    for (;;) {
        const bool has_next = S.next(ui + 1, nxt);
        const char* nA = has_next ? (const char*)g.A + S.arow(nxt.pm) * (size_t)(K * 2) : cA; const char* nB = has_next ? (const char*)g.Bt + (size_t)nxt.pn * tstep : cB;
        for (int t = 0; t < nt; t += 2) {
            const bool last = (t == nt - 2);
            const char* a1 = cA + (size_t)(t + 1) * kstep;
            const char* a2 = last ? nA : cA + (size_t)(t + 2) * kstep; const char* b2 = last ? nB : cB + (size_t)(t + 2) * kstep;
            const char* a3 = a2 + kstep; const char* b3 = b2 + kstep;
            if (last && has_next) S.a_ready(nxt);
            if constexpr (SP2) {
            PG8_LDB(B0, 0, 0); PG8_LDB(B1, 0, 1); PG8_SCHED; PG8_LDA(At, 0, 0); PG8_STAGE(PG8_SA(1, 1), a1 + hstep, voffA);
            PG8_WAIT_V(8); PG8_WAIT_L(0); PG8_BAR; PG8_MMA(0, 0, At, B0); PG8_MMA(0, 1, At, B1); PG8_BAR; PG8_SCHED;
            PG8_LDA(At, 0, 1); PG8_STAGE(PG8_SB(0, 0), b2, voffB); PG8_STAGE(PG8_SB(0, 1), b2 + hstep, voffB); PG8_STAGE(PG8_SA(0, 0), a2, voffA);
            PG8_WAIT_V(8); PG8_WAIT_L(0); PG8_BAR; PG8_MMA(1, 0, At, B0); PG8_MMA(1, 1, At, B1); PG8_BAR; PG8_SCHED;
            PG8_LDB(B0, 1, 0); PG8_LDB(B1, 1, 1); PG8_SCHED; PG8_LDA(At, 1, 0); PG8_STAGE(PG8_SA(0, 1), a2 + hstep, voffA);
            PG8_WAIT_V(8); PG8_WAIT_L(0); PG8_BAR; PG8_MMA(0, 0, At, B0); PG8_MMA(0, 1, At, B1); PG8_BAR; PG8_SCHED;
            PG8_LDA(At, 1, 1); PG8_STAGE(PG8_SB(1, 0), b3, voffB); PG8_STAGE(PG8_SB(1, 1), b3 + hstep, voffB); PG8_STAGE(PG8_SA(1, 0), a3, voffA);
            PG8_WAIT_V(8); PG8_WAIT_L(0); PG8_BAR; PG8_MMA(1, 0, At, B0); PG8_MMA(1, 1, At, B1); PG8_BAR; PG8_SCHED;
            } else {
            PG8_LDB(B0, 0, 0); PG8_SCHED; PG8_LDA(At, 0, 0); PG8_STAGE(PG8_SA(1, 1), a1 + hstep, voffA);
            PG8_WAIT_L(8); PG8_BAR; PG8_WAIT_L(0); PG8_MMA(0, 0, At, B0); PG8_BAR; PG8_SCHED;
            PG8_LDB(B1, 0, 1); PG8_STAGE(PG8_SB(0, 0), b2, voffB);
            PG8_BAR; PG8_WAIT_L(0); PG8_MMA(0, 1, At, B1); PG8_BAR;
            PG8_LDA(At, 0, 1); PG8_STAGE(PG8_SA(0, 0), a2, voffA);
            PG8_BAR; PG8_WAIT_L(0); PG8_MMA(1, 0, At, B0); PG8_BAR; PG8_SCHED;
            PG8_STAGE(PG8_SB(0, 1), b2 + hstep, voffB);
            PG8_WAIT_V(6); PG8_BAR; PG8_MMA(1, 1, At, B1); PG8_BAR;
            PG8_LDB(B0, 1, 0); PG8_SCHED; PG8_LDA(At, 1, 0); PG8_STAGE(PG8_SA(0, 1), a2 + hstep, voffA);
            PG8_WAIT_L(8); PG8_BAR; PG8_WAIT_L(0); PG8_MMA(0, 0, At, B0); PG8_BAR; PG8_SCHED;
            PG8_LDB(B1, 1, 1); PG8_STAGE(PG8_SB(1, 0), b3, voffB);
            PG8_BAR; PG8_WAIT_L(0); PG8_MMA(0, 1, At, B1); PG8_BAR;
            PG8_LDA(At, 1, 1); PG8_STAGE(PG8_SA(1, 0), a3, voffA);
            PG8_BAR; PG8_WAIT_L(0); PG8_MMA(1, 0, At, B0); PG8_BAR; PG8_SCHED;
            PG8_STAGE(PG8_SB(1, 1), b3 + hstep, voffB);
            PG8_WAIT_V(6); PG8_BAR; PG8_MMA(1, 1, At, B1); PG8_BAR;
            }
        }
        if constexpr (ALIGN_EPI) { if (wr == 0) PG8_BAR; }
        if constexpr (!Epi::AFTER_DRAIN) { E(acc, cur, wr, wc, fr, fq); S.done(cur); }
        if (!has_next) break;
#pragma unroll
        for (int a = 0; a < 2; ++a)
#pragma unroll
            for (int b = 0; b < 2; ++b)
#pragma unroll
                for (int m = 0; m < 4; ++m)
#pragma unroll
                    for (int n = 0; n < 2; ++n) acc[a][b][m][n] = (f32x4){0.f, 0.f, 0.f, 0.f};
        cur = nxt; cA = nA; cB = nB; ++ui;
        if constexpr (ALIGN_EPI) { if (wr == 1) PG8_BAR; }
    }
    PG8_WAIT_V(0);
    if constexpr (!ALIGN_EPI) { if (wr == 0) PG8_BAR; }
    PG8_BAR;
    if constexpr (Epi::AFTER_DRAIN) { E.fused(acc, cur, wr, wc, fr, fq, lds, wid, lane); S.done(cur); }
#undef PG8_SA
#undef PG8_SB
#undef PG8_STAGE
#undef PG8_LDA
#undef PG8_LDB
#undef PG8_MMA
#undef PG8_WAIT_V
#undef PG8_WAIT_L
#undef PG8_BAR
#undef PG8_SCHED
}
}

#define GAS __attribute__((address_space(1)))
#define LAS __attribute__((address_space(3)))
typedef unsigned short bf16;
typedef unsigned v4u __attribute__((ext_vector_type(4)));
typedef float f32x4 __attribute__((ext_vector_type(4)));
typedef short bf16x8 __attribute__((ext_vector_type(8)));
typedef GAS unsigned gu32;
typedef GAS unsigned long long gu64;
#define RLX_AGENT __ATOMIC_RELAXED, __HIP_MEMORY_SCOPE_AGENT
#define LDS_WAIT() asm volatile("s_waitcnt lgkmcnt(0)" ::: "memory")
#define VM_WAIT() asm volatile("s_waitcnt vmcnt(0)" ::: "memory")
__device__ __forceinline__ unsigned long long rt() { return __builtin_amdgcn_s_memrealtime(); }
__device__ __forceinline__ unsigned f2bf(float f) { unsigned u = __builtin_bit_cast(unsigned, f); return (u + 0x7fffu + ((u >> 16) & 1u)) >> 16; }
__device__ __forceinline__ unsigned pk2(float lo, float hi) { return f2bf(lo) | (f2bf(hi) << 16); }

#define XB_TMO      128
#define XB_XCNT(j)  (256  + 64 * (j))
#define XB_XSUB(j)  (1280 + 64 * (j))
#define XB_XGEN(j)  (2304 + 64 * (j))
#define XB_TOP      3328
#define XB_TOPGEN   3392
#define XCD_BAR_WORDS 3456
#define XB_SPIN_CAP (1u << 18)

__device__ __forceinline__ unsigned xb_ld(unsigned* p)              { return __hip_atomic_load(p, __ATOMIC_RELAXED, __HIP_MEMORY_SCOPE_AGENT); }
__device__ __forceinline__ unsigned xb_add(unsigned* p, unsigned v) { return __hip_atomic_fetch_add(p, v, __ATOMIC_RELAXED, __HIP_MEMORY_SCOPE_AGENT); }
__device__ __forceinline__ unsigned xb_xcc_id() { return (unsigned)__builtin_amdgcn_s_getreg((3 << 11) | 20) & 0xFu; }
#define XB_SPIN(cond, bar) do { unsigned _sp = 0; while (cond) { __builtin_amdgcn_s_sleep(1); \
    if ((++_sp & 255u) == 0u) { if (xb_ld(&(bar)[XB_TMO])) break; if (_sp > XB_SPIN_CAP) { atomicAdd(&(bar)[XB_TMO], 1u); break; } } } } while (0)

struct XcdBarrier {
    unsigned* bar; unsigned x;
    volatile LAS unsigned* st;
};

__device__ __forceinline__ XcdBarrier xcd_barrier_post(unsigned* bar, volatile LAS unsigned* st) {
    XcdBarrier b; b.bar = bar; b.x = xb_xcc_id(); b.st = st;
    if (threadIdx.x == 0) (void)xb_add(&bar[XB_XCNT(b.x)], 1u);
    return b;
}
__device__ __forceinline__ void xcd_barrier_complete(unsigned* bar, unsigned x, unsigned& nloc, unsigned& nx) {
    const unsigned G = gridDim.x * gridDim.y * gridDim.z;
    unsigned sum, cnt, mine, sp = 0u;
    for (;;) {
        sum = 0u; cnt = 0u; mine = 0u;
#pragma unroll
        for (unsigned j = 0; j < 16; ++j) { const unsigned c = xb_ld(&bar[XB_XCNT(j)]); sum += c; cnt += (c > 0u) ? 1u : 0u; mine = (j == x) ? c : mine; }
        if (sum == G) break;
        __builtin_amdgcn_s_sleep(1);
        if ((++sp & 255u) == 0u) { if (xb_ld(&bar[XB_TMO])) break; if (sp > XB_SPIN_CAP) { atomicAdd(&bar[XB_TMO], 1u); break; } }
    }
    nloc = mine > 0u ? mine : 1u; nx = cnt > 0u ? cnt : 1u;
}

__device__ __forceinline__ void xcd_barrier(const XcdBarrier& b) {
    asm volatile("s_waitcnt vmcnt(0)" ::: "memory");
    __syncthreads();
    if (threadIdx.x == 0) {
        unsigned* bar = b.bar;
        __builtin_amdgcn_s_waitcnt(0);
        unsigned nloc = b.st[0], nx = b.st[1];
        if (nloc == 0u) { xcd_barrier_complete(bar, b.x, nloc, nx); b.st[0] = nloc; b.st[1] = nx; }
        const unsigned old = xb_add(&bar[XB_XSUB(b.x)], 1u);
        const unsigned gen = old / nloc;
        if (old + 1u == (gen + 1u) * nloc) {
            __builtin_amdgcn_fence(__ATOMIC_RELEASE, "agent");
            asm volatile("s_waitcnt vmcnt(0)" ::: "memory");
            const unsigned og = xb_add(&bar[XB_TOP], 1u);
            const unsigned tg = og / nx;
            if (og + 1u == (tg + 1u) * nx) xb_add(&bar[XB_TOPGEN], 1u);
            else XB_SPIN(xb_ld(&bar[XB_TOPGEN]) == tg, bar);
            __builtin_amdgcn_fence(__ATOMIC_ACQUIRE, "agent");
            xb_add(&bar[XB_XGEN(b.x)], 1u);
            asm volatile("s_waitcnt vmcnt(0)" ::: "memory");
        } else {
            XB_SPIN(xb_ld(&bar[XB_XGEN(b.x)]) == gen, bar);
            __builtin_amdgcn_fence(__ATOMIC_ACQUIRE, "agent");
            asm volatile("s_waitcnt vmcnt(0)" ::: "memory");
        }
    }
    __syncthreads();
}

typedef short s16x4 __attribute__((ext_vector_type(4)));
typedef float f32x16 __attribute__((ext_vector_type(16)));
typedef unsigned u32x2v __attribute__((ext_vector_type(2)));
__device__ __forceinline__ unsigned cvtpk(float lo, float hi) { typedef float f2_t __attribute__((ext_vector_type(2))); typedef __bf16 b2_t __attribute__((ext_vector_type(2)));
    const f2_t v = {lo, hi}; const b2_t b = __builtin_convertvector(v, b2_t); return __builtin_bit_cast(unsigned, b); }
__device__ __forceinline__ float bf2f(unsigned short v) { return __uint_as_float((unsigned)v << 16); }
__device__ __forceinline__ float bflo(unsigned w) { return __uint_as_float(w << 16); }
__device__ __forceinline__ float bfhi(unsigned w) { return __uint_as_float(w & 0xffff0000u); }
__device__ __forceinline__ float wave_sum(float v) {
#pragma unroll
    for (int o = 1; o < 64; o <<= 1) v += __shfl_xor(v, o);
    return v;
}
__device__ __forceinline__ float sum16(float v) {
#pragma unroll
    for (int o = 1; o < 16; o <<= 1) v += __shfl_xor(v, o);
    return v;
}
__device__ __forceinline__ float sum32(float v) {
#pragma unroll
    for (int o = 1; o < 32; o <<= 1) v += __shfl_xor(v, o);
    return v;
}

struct Args { const float* in[10]; float* out; unsigned char* ws; int ph_lo, ph_hi, li, pad; };
struct Frame {
    LAS unsigned char* lds; volatile LAS unsigned* MISC; gu32* ctl; int tid, lane, wave, G, bid;
    const Args* A;
    float* out; unsigned char* ws;
};

__device__ __forceinline__ int fresh_tid() { int t = threadIdx.x; asm volatile("; LAUNDER" : "+v"(t)); return t; }
__device__ __forceinline__ int dst_col(int c) {
    const int g = c >> 10, j = c & 1023;
    if (g < 4) { const int th = j >> 6, cc = j & 63, wc = cc >> 4, fq = (cc >> 2) & 3, e = cc & 3, bj = g >> 1, n = g & 1; return 256 * th + 128 * bj + 32 * wc + 8 * fq + 4 * n + e; }
    if (g == 5 || g == 6) { const int d = j & 63, i = d & 31, hf = d >> 5; return g * 1024 + (j & ~63) + 2 * i + hf; }
    return c;
}
template <bool PERMUTE>
__device__ __forceinline__ void p0_transpose_item(const float* W, int K, int N, bf16* WT, LAS float* scr, int item, int lane) {
    const int nblk = N / 32, kb = item / nblk, nb = item % nblk, k0 = 64 * kb, n0 = 32 * nb;
#pragma unroll 8
    for (int i = 0; i < 32; ++i) { const int kk = 2 * i + (lane >> 5); scr[kk * 33 + (lane & 31)] = W[(size_t)(k0 + kk) * N + n0 + (lane & 31)]; }
    LDS_WAIT(); asm volatile("" ::: "memory");
    const int c = lane & 7;
#pragma unroll
    for (int j = 0; j < 4; ++j) { const int n = (lane >> 3) + 8 * j; const LAS float* s = scr + (8 * c) * 33 + n;
        v4u o; o.x = pk2(s[0 * 33], s[1 * 33]); o.y = pk2(s[2 * 33], s[3 * 33]); o.z = pk2(s[4 * 33], s[5 * 33]); o.w = pk2(s[6 * 33], s[7 * 33]);
        const int drow = PERMUTE ? dst_col(n0 + n) : (n0 + n);
        *(GAS v4u*)(WT + (size_t)drow * K + k0 + 8 * c) = o; }
    LDS_WAIT(); asm volatile("" ::: "memory");
}
__device__ __forceinline__ void norm_row_to_bf16(int lane, const float* xrow, const float* g, bf16* orow, int ncopy, size_t cstride) {
    const GAS f32x4* xr = (const GAS f32x4*)xrow + lane; const GAS f32x4* gr = (const GAS f32x4*)g + lane;
    f32x4 v[4]; float s = 0.f;
#pragma unroll
    for (int j = 0; j < 4; ++j) { v[j] = xr[64 * j]; s += (v[j].x * v[j].x + v[j].y * v[j].y) + (v[j].z * v[j].z + v[j].w * v[j].w); }
    const float rs = 1.0f / sqrtf(wave_sum(s) * (1.0f / DM) + NEPS);
    unsigned long long w[4];
#pragma unroll
    for (int j = 0; j < 4; ++j) { const f32x4 gg = gr[64 * j]; w[j] = (unsigned long long)pk2(v[j].x * rs * gg.x, v[j].y * rs * gg.y) | ((unsigned long long)pk2(v[j].z * rs * gg.z, v[j].w * rs * gg.w) << 32); }
    for (int c = 0; c < ncopy; ++c) { GAS unsigned long long* o8 = (GAS unsigned long long*)(orow + (size_t)c * cstride) + lane;
#pragma unroll
        for (int j = 0; j < 4; ++j) o8[64 * j] = w[j]; }
}
__device__ __forceinline__ void p0_prologue(Frame& F) {
    const int tid = fresh_tid(), lane = tid & 63, wave = __builtin_amdgcn_readfirstlane(tid >> 6);
    LAS float* scr = (LAS float*)(F.lds + wave * 16384);
    const int gw = F.bid * NWAVES + wave, NGW = F.G * NWAVES;
    constexpr int I_IN = (DM / 64) * (INW / 32), I_OUT = (2048 / 64) * (DM / 32);
    constexpr int NITEMS = 2 * (I_IN + I_OUT);
    bf16* win = (bf16*)(F.ws + WS_WIN); bf16* wout = (bf16*)(F.ws + WS_WOUT);
    for (int it = gw; it < NITEMS; it += NGW) {
        int r = it; const int l = r / (I_IN + I_OUT); r -= l * (I_IN + I_OUT);
        if (r < I_IN) p0_transpose_item<true>(F.A->in[3] + (size_t)l * DM * INW, DM, INW, win + (size_t)l * INW * DM, scr, r, lane);
        else p0_transpose_item<false>(F.A->in[8] + (size_t)l * 2048 * DM, 2048, DM, wout + (size_t)l * DM * 2048, scr, r - I_IN, lane);
    }
    { float* rope = (float*)(F.ws + WS_ROPE);
      for (int idx = F.bid * NTHREADS + tid; idx < LTOK * 32; idx += F.G * NTHREADS) { const int t = idx >> 5, i = idx & 31;
          const float inv = powf(10000.0f, -(float)(2 * i) / 64.0f), ang = (float)t * inv; rope[2 * idx] = cosf(ang); rope[2 * idx + 1] = sinf(ang); } }
    bf16* U = (bf16*)(F.ws + WS_U);
    for (int m = gw; m < NBATCH * SEQ + NMETA; m += NGW) {
        if (m < NBATCH * SEQ) { const int half = m >> 13; norm_row_to_bf16(lane, F.A->in[0] + (size_t)m * DM, F.A->in[2], U + ((size_t)m + half * 256) * DM, 1, 0); }
        else { const int j = m - NBATCH * SEQ;
            norm_row_to_bf16(lane, F.A->in[1] + (size_t)j * DM, F.A->in[2], U + ((size_t)8192 + j) * DM, 4, (size_t)16 * DM);
            norm_row_to_bf16(lane, F.A->in[1] + (size_t)j * DM, F.A->in[2], U + ((size_t)HROWS + 8192 + j) * DM, 4, (size_t)16 * DM); }
    }
}

constexpr int SC_PITCH = 272;
constexpr int SC_TILE = 16 * SC_PITCH;
constexpr int SC_BUF = 4 * SC_TILE;
__device__ __forceinline__ s16x4 tr16(const LAS unsigned char* p) {
    typedef short v4i16_t __attribute__((ext_vector_type(4)));
    return __builtin_bit_cast(s16x4, __builtin_amdgcn_ds_read_tr16_b64_v4i16((LAS v4i16_t*)p));
}
__device__ __forceinline__ int scan_rowbase(int bl, int c) { return c == 0 ? 8192 + bl * 16 : bl * 2048 + 16 * (c - 1); }

__device__ __forceinline__ void hgrn_scan_item(Frame& F, size_t gq_half, int bl, int hd, int layer) {
    int tid_l = F.tid; asm volatile("; LAUNDER" : "+v"(tid_l));
    const int tid = tid_l, lane = tid & 63, wave = __builtin_amdgcn_readfirstlane(tid >> 6), dir = wave >> 2, vs = wave & 3, g = lane >> 4, i16 = lane & 15;
    LAS unsigned char* lds = F.lds;
    unsigned char* const ws = F.ws;
    bf16* QD = (bf16*)(ws + (dir == 0 ? WS_QDF : WS_QDB)); const bf16* KT = (const bf16*)(ws + (dir == 0 ? WS_KTF : WS_KTB)); const float* DEC = (const float*)(ws + (dir == 0 ? WS_DECF : WS_DECB));
    const int hcol = hd * 128;
    const int s_which = tid >> 7, s_idx = tid & 127, s_row = s_idx >> 3, s_piece = s_idx & 7;
    const bf16* s_src = (const bf16*)(ws + (s_which == 0 ? WS_KTF : (s_which == 1 ? WS_KTB : WS_VH))) + hcol + s_piece * 16;
    const int s_dir = (s_which == 0 || s_which == 2) ? 0 : 1;
    const int s_ldsoff = s_which * SC_TILE + s_row * SC_PITCH + s_piece * 32;
    f32x4 S[8][2];
#pragma unroll
    for (int kb = 0; kb < 8; ++kb) { S[kb][0] = (f32x4){0.f, 0.f, 0.f, 0.f}; S[kb][1] = (f32x4){0.f, 0.f, 0.f, 0.f}; }
    bf16x8 qd[4], kt[4], st0, st1;
#define SC_LOAD_FRAGS(step) do { const int c_ = dir == 0 ? (step) : 128 - (step); const size_t ro_ = (size_t)(scan_rowbase(bl, c_) + i16) * 1024 + hcol + 4 * g; \
        _Pragma("unroll") for (int kk = 0; kk < 4; ++kk) { \
            const u32x2v a0 = *(const GAS u32x2v*)(QD + ro_ + 32 * kk), a1 = *(const GAS u32x2v*)(QD + ro_ + 32 * kk + 16); \
            const u32x2v b0 = *(const GAS u32x2v*)(KT + ro_ + 32 * kk), b1 = *(const GAS u32x2v*)(KT + ro_ + 32 * kk + 16); \
            qd[kk] = __builtin_bit_cast(bf16x8, (v4u){a0.x, a0.y, a1.x, a1.y}); kt[kk] = __builtin_bit_cast(bf16x8, (v4u){b0.x, b0.y, b1.x, b1.y}); } } while (0)
#define SC_LOAD_STAGE(step) do { const int c_ = s_dir == 0 ? (step) : 128 - (step); const bf16* p_ = s_src + (size_t)(scan_rowbase(bl, c_) + s_row) * 1024; \
        st0 = *(const GAS bf16x8*)p_; st1 = *(const GAS bf16x8*)(p_ + 8); } while (0)
#define SC_WRITE_STAGE(buf) do { *(LAS bf16x8*)(lds + (buf) * SC_BUF + s_ldsoff) = st0; *(LAS bf16x8*)(lds + (buf) * SC_BUF + s_ldsoff + 16) = st1; } while (0)
    SC_LOAD_STAGE(0); SC_LOAD_FRAGS(0);
    SC_WRITE_STAGE(0);
    __syncthreads();
    for (int step = 0; step < 129; ++step) {
        const int buf = step & 1; const int c = dir == 0 ? step : 128 - step; const int rowb = scan_rowbase(bl, c);
        bf16x8 cqd[4], ckt[4];
#pragma unroll
        for (int kk = 0; kk < 4; ++kk) { cqd[kk] = qd[kk]; ckt[kk] = kt[kk]; }
        if (step + 1 < 129) { SC_LOAD_STAGE(step + 1); SC_LOAD_FRAGS(step + 1); }
        f32x4 dec[8];
        { const float* dp = DEC + (size_t)(rowb >> 4) * 1024 + hcol + 4 * g;
#pragma unroll
          for (int kb = 0; kb < 8; ++kb) dec[kb] = *(const GAS f32x4*)(dp + 16 * kb); }
#ifdef DBG_DEC1
#pragma unroll
        for (int kb = 0; kb < 8; ++kb) dec[kb] = (f32x4){0.5f, 0.5f, 0.5f, 0.5f};
#endif
#ifdef DBG_SFIX
#pragma unroll
        for (int kb = 0; kb < 8; ++kb)
#pragma unroll
            for (int nt = 0; nt < 2; ++nt)
#pragma unroll
                for (int r = 0; r < 4; ++r) S[kb][nt][r] = DBG_SFN(16 * kb + 4 * g + r, 32 * vs + 16 * nt + i16);
#endif
        const LAS unsigned char* tK = lds + buf * SC_BUF + dir * SC_TILE + (4 * g + (i16 >> 2)) * SC_PITCH + (i16 & 3) * 8;
        const LAS unsigned char* tV = lds + buf * SC_BUF + (2 + dir) * SC_TILE + (4 * g + (i16 >> 2)) * SC_PITCH + (i16 & 3) * 8 + vs * 64;
        s16x4 ktT[8], vfr[2];
#pragma unroll
        for (int kb = 0; kb < 8; ++kb) ktT[kb] = tr16(tK + kb * 32);
        vfr[0] = tr16(tV); vfr[1] = tr16(tV + 32);
        f32x4 at = (f32x4){0.f, 0.f, 0.f, 0.f};
#pragma unroll
        for (int kk = 0; kk < 4; ++kk) at = __builtin_amdgcn_mfma_f32_16x16x32_bf16(ckt[kk], cqd[kk], at, 0, 0, 0);
#pragma unroll
        for (int r = 0; r < 4; ++r) { const int s = 4 * g + r; const bool keep = dir == 0 ? (s <= i16) : (s >= i16); at[r] = keep ? at[r] : 0.f; }
        const s16x4 pfr = __builtin_bit_cast(s16x4, (u32x2v){cvtpk(at[0], at[1]), cvtpk(at[2], at[3])});
        f32x4 o[2];
#pragma unroll
        for (int nt = 0; nt < 2; ++nt) {
            const f32x4 oi = __builtin_amdgcn_mfma_f32_16x16x16bf16_1k(pfr, vfr[nt], (f32x4){0.f, 0.f, 0.f, 0.f}, 0, 0, 0);
            f32x4 oe = (f32x4){0.f, 0.f, 0.f, 0.f};
#pragma unroll
            for (int kk = 0; kk < 4; ++kk) {
                const f32x4 s0 = S[2 * kk][nt], s1 = S[2 * kk + 1][nt];
                const bf16x8 sb = __builtin_bit_cast(bf16x8, (v4u){cvtpk(s0[0], s0[1]), cvtpk(s0[2], s0[3]), cvtpk(s1[0], s1[1]), cvtpk(s1[2], s1[3])});
                oe = __builtin_amdgcn_mfma_f32_16x16x32_bf16(cqd[kk], sb, oe, 0, 0, 0);
            }
            o[nt] = oi + oe;
        }
#pragma unroll
        for (int kb = 0; kb < 8; ++kb)
#pragma unroll
            for (int nt = 0; nt < 2; ++nt) { S[kb][nt] = __builtin_amdgcn_mfma_f32_16x16x16bf16_1k(ktT[kb], vfr[nt], S[kb][nt], 0, 0, 0); S[kb][nt] = S[kb][nt] * dec[kb]; }
        if (!(layer == 1 && c == 0)) {
#pragma unroll
            for (int nt = 0; nt < 2; ++nt)
#pragma unroll
                for (int r = 0; r < 4; ++r) QD[(size_t)(rowb + 4 * g + r) * 1024 + hcol + 32 * vs + 16 * nt + i16] = (bf16)(cvtpk(o[nt][r], 0.f) & 0xffffu);
        }
        if (step + 1 < 129) SC_WRITE_STAGE(buf ^ 1);
        __syncthreads();
    }
#undef SC_LOAD_FRAGS
#undef SC_LOAD_STAGE
#undef SC_WRITE_STAGE
#ifdef DBG_NOFINAL
    return;
#endif
    asm volatile("s_waitcnt vmcnt(0)" ::: "memory");
    __syncthreads();
    __builtin_amdgcn_fence(__ATOMIC_ACQUIRE, "agent");
    asm volatile("s_waitcnt vmcnt(0)" ::: "memory");
    __syncthreads();
    const float* gn = F.A->in[5] + layer * 128 + 8 * i16;
    const f32x4 g0 = *(const GAS f32x4*)gn, g1 = *(const GAS f32x4*)(gn + 4);
    const int ntok = layer == 1 ? SEQ : LTOK;
    for (int tk = wave * 4 + g; tk < ntok; tk += NWAVES * 4) {
        const int row = tk < SEQ ? bl * 2048 + tk : 8192 + bl * 16 + (tk - SEQ);
        const size_t ro = (size_t)row * 1024 + hcol + 8 * i16;
        const v4u a = *(const GAS v4u*)((const bf16*)(ws + WS_QDF) + ro), b = *(const GAS v4u*)((const bf16*)(ws + WS_QDB) + ro);
        float v[8];
        v[0] = bflo(a.x) + bflo(b.x); v[1] = bfhi(a.x) + bfhi(b.x); v[2] = bflo(a.y) + bflo(b.y); v[3] = bfhi(a.y) + bfhi(b.y);
        v[4] = bflo(a.z) + bflo(b.z); v[5] = bfhi(a.z) + bfhi(b.z); v[6] = bflo(a.w) + bflo(b.w); v[7] = bfhi(a.w) + bfhi(b.w);
        float ss = 0.f;
#pragma unroll
        for (int e = 0; e < 8; ++e) ss += v[e] * v[e];
        ss = sum16(ss);
        const float rs = 1.0f / sqrtf(ss * (1.0f / 128.0f) + NEPS);
        bf16* gp = (bf16*)(ws + WS_GQ + gq_half) + (size_t)row * 2048 + hcol + 8 * i16;
        const v4u gt = *(const GAS v4u*)gp;
        v4u w;
        w.x = cvtpk(v[0] * rs * g0[0] * bflo(gt.x), v[1] * rs * g0[1] * bfhi(gt.x)); w.y = cvtpk(v[2] * rs * g0[2] * bflo(gt.y), v[3] * rs * g0[3] * bfhi(gt.y));
        w.z = cvtpk(v[4] * rs * g1[0] * bflo(gt.z), v[5] * rs * g1[1] * bfhi(gt.z)); w.w = cvtpk(v[6] * rs * g1[2] * bflo(gt.w), v[7] * rs * g1[3] * bfhi(gt.w));
        *(GAS v4u*)gp = w;
    }
}

constexpr int AT_SHM_V = 64 * 128 * 2, AT_SHM_K = 64 * 128 * 2;
constexpr float AT_THR2 = 11.5f;
#define KSWZ(row, colB) ((row) * 256 + ((colB) ^ (((row) & 7) << 4)))
#define SBAR() __builtin_amdgcn_sched_barrier(0)
__device__ __forceinline__ int crow(int r, int hi) { return (r & 3) + 8 * (r >> 2) + 4 * hi; }
__device__ __forceinline__ int v_st(int k, int c) { const int kk = (k & ~0xC) | ((k & 4) << 1) | ((k & 8) >> 1); return ((kk >> 3) * 4 + (c >> 5)) * 512 + ((kk & 7) * 32 + (c & 31)) * 2; }
__device__ __forceinline__ int v_rd_base(int lane) { return ((lane & 3) << 3) | (((lane >> 2) & 3) << 6) | (((lane >> 4) & 1) << 5) | (((lane >> 5) & 1) << 8); }
constexpr int v_rd_off(int d0, int ks, int half) { return d0 * 512 + ks * 4096 + half * 2048; }
template <int OFF> __device__ __forceinline__ s16x4 tr_read(int vb) {
    s16x4 r; asm volatile("ds_read_b64_tr_b16 %0, %1 offset:%2" : "=&v"(r) : "v"(vb), "i"(OFF) : "memory"); return r;
}
template <int D0> __device__ __forceinline__ void pv_one(f32x16& od, int vb, bf16x8 pa0, bf16x8 pa1, bf16x8 pa2, bf16x8 pa3) {
    const s16x4 l0 = tr_read<v_rd_off(D0, 0, 0)>(vb), h0 = tr_read<v_rd_off(D0, 0, 1)>(vb), l1 = tr_read<v_rd_off(D0, 1, 0)>(vb), h1 = tr_read<v_rd_off(D0, 1, 1)>(vb);
    const s16x4 l2 = tr_read<v_rd_off(D0, 2, 0)>(vb), h2 = tr_read<v_rd_off(D0, 2, 1)>(vb), l3 = tr_read<v_rd_off(D0, 3, 0)>(vb), h3 = tr_read<v_rd_off(D0, 3, 1)>(vb);
    asm volatile("s_waitcnt lgkmcnt(0)" ::: "memory"); SBAR();
#define PK(L, H) (bf16x8){L[0], L[1], L[2], L[3], H[0], H[1], H[2], H[3]}
    od = __builtin_amdgcn_mfma_f32_32x32x16_bf16(pa0, PK(l0, h0), od, 0, 0, 0);
    od = __builtin_amdgcn_mfma_f32_32x32x16_bf16(pa1, PK(l1, h1), od, 0, 0, 0);
    od = __builtin_amdgcn_mfma_f32_32x32x16_bf16(pa2, PK(l2, h2), od, 0, 0, 0);
    od = __builtin_amdgcn_mfma_f32_32x32x16_bf16(pa3, PK(l3, h3), od, 0, 0, 0);
#undef PK
}
__device__ __forceinline__ void attn_tile(f32x16 (&o)[4], float& m_reg, float& l_reg, const LAS unsigned char* Ks  , int vb, const bf16x8 (&qr)[4], bool meta_tile,
                                          LAS float* al_l, int r32, int hi) {
    f32x16 p0 = {}, p1 = {};
#pragma unroll
    for (int d0 = 0; d0 < 4; ++d0) { const int cb = (d0 * 16 + hi * 8) * 2;
        const bf16x8 b0 = *(const LAS bf16x8*)(Ks + KSWZ(r32, cb));
        const bf16x8 b1 = *(const LAS bf16x8*)(Ks + KSWZ(32 + r32, cb));
        p0 = __builtin_amdgcn_mfma_f32_32x32x16_bf16(b0, qr[d0], p0, 0, 0, 0);
        p1 = __builtin_amdgcn_mfma_f32_32x32x16_bf16(b1, qr[d0], p1, 0, 0, 0); }
    if (meta_tile) {
#pragma unroll
        for (int r = 8; r < 16; ++r) p0[r] = -INFINITY;
#pragma unroll
        for (int r = 0; r < 16; ++r) p1[r] = -INFINITY;
    }
    float pmax = p0[0];
#pragma unroll
    for (int r = 1; r < 16; ++r) pmax = fmaxf(pmax, p0[r]);
#pragma unroll
    for (int r = 0; r < 16; ++r) pmax = fmaxf(pmax, p1[r]);
    { auto rr = __builtin_amdgcn_permlane32_swap(__float_as_uint(pmax), __float_as_uint(pmax), false, false);
      pmax = fmaxf(__uint_as_float(rr[0]), __uint_as_float(rr[1])); }
    float alpha = 1.f;
    if (!__all(pmax - m_reg <= AT_THR2)) { const float mn = fmaxf(m_reg, pmax); alpha = __builtin_amdgcn_exp2f(m_reg - mn); m_reg = mn; }
#pragma unroll
    for (int r = 0; r < 16; ++r) { p0[r] = __builtin_amdgcn_exp2f(p0[r] - m_reg); p1[r] = __builtin_amdgcn_exp2f(p1[r] - m_reg); }
    float ps = 0.f;
#pragma unroll
    for (int r = 0; r < 16; ++r) ps += p0[r];
#pragma unroll
    for (int r = 0; r < 16; ++r) ps += p1[r];
    { auto rr = __builtin_amdgcn_permlane32_swap(__float_as_uint(ps), __float_as_uint(ps), false, false);
      ps = __uint_as_float(rr[0]) + __uint_as_float(rr[1]); }
    l_reg = l_reg * alpha + ps;
    if (__any(alpha < 1.f)) {
        if (hi == 0) al_l[r32] = alpha;
        asm volatile("s_waitcnt lgkmcnt(0)" ::: "memory");
#pragma unroll
        for (int d = 0; d < 4; ++d)
#pragma unroll
            for (int r = 0; r < 16; ++r) o[d][r] *= al_l[crow(r, hi)];
    }
    bf16x8 pa0, pa1, pa2, pa3;
#define PK4(P, BASE, OUT) do { unsigned a0 = cvtpk(P[BASE + 0], P[BASE + 1]), a1 = cvtpk(P[BASE + 2], P[BASE + 3]);   \
    unsigned b0_ = cvtpk(P[BASE + 4], P[BASE + 5]), b1_ = cvtpk(P[BASE + 6], P[BASE + 7]);                              \
    auto r0 = __builtin_amdgcn_permlane32_swap(a0, b0_, false, false); auto r1 = __builtin_amdgcn_permlane32_swap(a1, b1_, false, false); \
    v4u w = {r0[0], r1[0], r0[1], r1[1]}; OUT = __builtin_bit_cast(bf16x8, w); } while (0)
    PK4(p0, 0, pa0); PK4(p0, 8, pa1); PK4(p1, 0, pa2); PK4(p1, 8, pa3);
#undef PK4
    pv_one<0>(o[0], vb, pa0, pa1, pa2, pa3); pv_one<1>(o[1], vb, pa0, pa1, pa2, pa3); pv_one<2>(o[2], vb, pa0, pa1, pa2, pa3); pv_one<3>(o[3], vb, pa0, pa1, pa2, pa3);
}
template <bool METAQ>
__device__ __forceinline__ void attn_item(Frame& F, size_t gq_half, int bl, int hd, int qt, int layer) {
    int tid_l = F.tid; asm volatile("; LAUNDER" : "+v"(tid_l));
    const int tid = tid_l, wid = __builtin_amdgcn_readfirstlane(tid >> 6), lane = tid & 63, r32 = lane & 31, hi = lane >> 5, rg = wid & 3, cc = wid >> 2;
    LAS unsigned char* lds = F.lds; unsigned char* const ws = F.ws; bf16* const GQ = (bf16*)(ws + WS_GQ + gq_half);
    LAS unsigned char* V_lds = lds; LAS unsigned char* K_lds = lds + 2 * AT_SHM_V;
    LAS float* wsf = (LAS float*)(lds + 2 * AT_SHM_V + 2 * AT_SHM_K) + wid * 64; LAS float* li_l = wsf; LAS float* al_l = wsf + 32;
    const int qrow0 = METAQ ? (8192 + bl * 16) : (bl * 2048 + qt * 128 + rg * 32);
    const int qrow = METAQ ? (qrow0 + (r32 & 15)) : (qrow0 + r32);
    bf16x8 qr[4];
    { const bf16* Qw = GQ + (size_t)qrow * 2048 + 1024 + hd * 128 + cc * 64 + hi * 8;
#pragma unroll
      for (int d0 = 0; d0 < 4; ++d0) qr[d0] = *(const GAS bf16x8*)(Qw + d0 * 16); }
    const bf16* Kh = (const bf16*)(ws + WS_KA) + hd * 128; const bf16* Vh = (const bf16*)(ws + WS_VA) + hd * 128;
    const int sr = tid >> 4, sc = (tid & 15) * 8, vst0 = v_st(sr, sc), vst1 = v_st(32 + sr, sc);
    const int vb0 = (int)(uintptr_t)V_lds + v_rd_base(lane);
    constexpr int NT = 33;
    bf16x8 vs0, vs1, ks0, ks1;
#define AROW(kt, k) ((kt) < 32 ? (bl * 2048 + (kt) * 64 + (k)) : (8192 + bl * 16 + ((k) & 15)))
#define SLOAD(kt) do { const size_t ra_ = (size_t)AROW(kt, sr) * 1024 + sc, rb_ = (size_t)AROW(kt, 32 + sr) * 1024 + sc; \
        vs0 = *(const GAS bf16x8*)(Vh + ra_); vs1 = *(const GAS bf16x8*)(Vh + rb_); ks0 = *(const GAS bf16x8*)(Kh + ra_); ks1 = *(const GAS bf16x8*)(Kh + rb_); } while (0)
#define SWRITE(b) do { *(LAS bf16x8*)(V_lds + (b) * AT_SHM_V + vst0) = vs0; *(LAS bf16x8*)(V_lds + (b) * AT_SHM_V + vst1) = vs1; const int kc_ = sc * 2; \
        *(LAS bf16x8*)(K_lds + (b) * AT_SHM_K + KSWZ(sr, kc_)) = ks0; *(LAS bf16x8*)(K_lds + (b) * AT_SHM_K + KSWZ(32 + sr, kc_)) = ks1; } while (0)
    float m_reg = -1e30f, l_reg = 0.f;
    f32x16 o[4] = {};
    SLOAD(0); SWRITE(0); SLOAD(1);
    __syncthreads();
    for (int kt = 0; kt < NT; ++kt) {
        const int b = kt & 1;
        if (kt + 1 < NT) { SWRITE(b ^ 1); if (kt + 2 < NT) SLOAD(kt + 2); }
        attn_tile(o, m_reg, l_reg, K_lds + b * AT_SHM_K + cc * 128, vb0 + b * AT_SHM_V, qr, kt == 32, al_l, r32, hi);
        __syncthreads();
    }
#undef SLOAD
#undef SWRITE
#undef AROW
    const float lam_init = 0.8f - 0.6f * expf(-0.3f * (float)layer);
    float lam;
    { const float* lv = F.A->in[6] + layer * 256; const float d1 = wave_sum(lv[lane] * lv[64 + lane]), d2 = wave_sum(lv[128 + lane] * lv[192 + lane]); lam = expf(d1) - expf(d2) + lam_init; }
    if (hi == 0) li_l[r32] = l_reg;
    asm volatile("s_waitcnt lgkmcnt(0)" ::: "memory");
    float ra[16];
#pragma unroll
    for (int r = 0; r < 16; ++r) ra[r] = __builtin_amdgcn_rcpf(li_l[crow(r, hi)]) * (cc == 1 ? lam : 1.0f);
    LAS float* X = (LAS float*)lds + rg * 4096;
    if (cc == 1) {
#pragma unroll
        for (int d = 0; d < 4; ++d)
#pragma unroll
            for (int r = 0; r < 16; ++r) X[(d * 16 + r) * 64 + lane] = o[d][r] * ra[r];
    }
    __syncthreads();
    if (cc == 0) {
#pragma unroll
        for (int r = 0; r < 16; ++r) {
            float ss = 0.f;
#pragma unroll
            for (int d = 0; d < 4; ++d) { const float v = o[d][r] * ra[r] - X[(d * 16 + r) * 64 + lane]; o[d][r] = v; ss += v * v; }
            ss = sum32(ss);
            ra[r] = (1.0f / sqrtf(ss * (1.0f / 128.0f) + NEPS)) * (1.0f - lam_init);
        }
        const float* sg = F.A->in[7] + layer * 128;
        float sgv[4];
#pragma unroll
        for (int d = 0; d < 4; ++d) sgv[d] = sg[32 * d + r32];
        if (!METAQ || rg == 0) {
#pragma unroll
            for (int r = 0; r < 16; ++r) { const int rr = crow(r, hi);
                if (METAQ && rr >= 16) continue;
                const size_t grow = (size_t)(qrow0 + rr);
#pragma unroll
                for (int d = 0; d < 4; ++d) { const int col = hd * 128 + 32 * d + r32;
                    const float gt = bf2f(((const bf16*)(ws + WS_GA))[grow * 1024 + col]);
                    GQ[grow * 2048 + 1024 + col] = (bf16)(cvtpk(o[d][r] * ra[r] * sgv[d] * gt, 0.f) & 0xffffu); }
            }
        }
    }
    __syncthreads();
}
#undef SBAR


#ifdef DBG
namespace nv {
constexpr int D = 1024, BATCH = 8, SEQ = 2048, NMETA = 16, L = SEQ + NMETA, T = BATCH * L;
constexpr int INW = 9216, MIXW = 2048, NH = 8;
constexpr float EPS = 1e-6f, F_FLOOR = 1e-30f;

__device__ __forceinline__ float wave_sum(float v) {
#pragma unroll
    for (int o = 1; o < 64; o <<= 1) v += __shfl_xor(v, o);
    return v;
}
__device__ __forceinline__ float wave_max(float v) {
#pragma unroll
    for (int o = 1; o < 64; o <<= 1) v = fmaxf(v, __shfl_xor(v, o));
    return v;
}
__device__ __forceinline__ float sigmoidf_(float z) { return 1.0f / (1.0f + expf(-z)); }
__device__ __forceinline__ float siluf_(float z) { return z / (1.0f + expf(-z)); }

__global__ void k_build_h(const float* __restrict__ x, const float* __restrict__ meta, float* __restrict__ h) {
    const size_t n4 = (size_t)T * D / 4;
    for (size_t i = blockIdx.x * (size_t)blockDim.x + threadIdx.x; i < n4; i += (size_t)gridDim.x * blockDim.x) {
        const size_t e = i * 4; const int d = (int)(e % D); const size_t row = e / D; const int b = (int)(row / L), t = (int)(row % L);
        const float4 v = t < NMETA ? *(const float4*)(meta + (size_t)t * D + d) : *(const float4*)(x + ((size_t)b * SEQ + (t - NMETA)) * D + d);
        *(float4*)(h + e) = v;
    }
}
__global__ void k_rmsnorm(const float* __restrict__ in, const float* __restrict__ g, float* __restrict__ out, int rows, int drop_meta) {
    const int wave = (blockIdx.x * blockDim.x + threadIdx.x) >> 6, lane = threadIdx.x & 63;
    if (wave >= rows) return;
    int orow = wave;
    if (drop_meta) { const int b = wave / L, t = wave % L; if (t < NMETA) return; orow = b * SEQ + (t - NMETA); }
    const float* r = in + (size_t)wave * D; float v[16]; float s = 0.f;
#pragma unroll
    for (int j = 0; j < 16; ++j) { v[j] = r[lane + 64 * j]; s += v[j] * v[j]; }
    s = wave_sum(s); const float rs = rsqrtf(s * (1.0f / D) + EPS);
#pragma unroll
    for (int j = 0; j < 16; ++j) out[(size_t)orow * D + lane + 64 * j] = v[j] * rs * g[lane + 64 * j];
}
__global__ void __launch_bounds__(256) k_gemm(const float* __restrict__ A, int lda, const float* __restrict__ B, int ldb, float* __restrict__ C, int ldc,
                                              int M, int N, int K, int accumulate) {
    __shared__ float As[16][68], Bs[16][68];
    const int tid = threadIdx.x, tx = tid & 15, ty = tid >> 4, m0 = blockIdx.y * 64, n0 = blockIdx.x * 64;
    float acc[4][4];
#pragma unroll
    for (int i = 0; i < 4; ++i)
#pragma unroll
        for (int j = 0; j < 4; ++j) acc[i][j] = 0.f;
    for (int k0 = 0; k0 < K; k0 += 16) {
        { const int r = tid >> 2, c = (tid & 3) * 4; const int gr = m0 + r; float4 a = make_float4(0.f, 0.f, 0.f, 0.f);
          if (gr < M) a = *(const float4*)(A + (size_t)gr * lda + k0 + c);
          As[c + 0][r] = a.x; As[c + 1][r] = a.y; As[c + 2][r] = a.z; As[c + 3][r] = a.w; }
        { const int r = tid >> 4, c = (tid & 15) * 4; const float4 b = *(const float4*)(B + (size_t)(k0 + r) * ldb + n0 + c);
          Bs[r][c + 0] = b.x; Bs[r][c + 1] = b.y; Bs[r][c + 2] = b.z; Bs[r][c + 3] = b.w; }
        __syncthreads();
#pragma unroll
        for (int kk = 0; kk < 16; ++kk) {
            float a[4], b[4];
#pragma unroll
            for (int i = 0; i < 4; ++i) a[i] = As[kk][ty * 4 + i];
#pragma unroll
            for (int j = 0; j < 4; ++j) b[j] = Bs[kk][tx * 4 + j];
#pragma unroll
            for (int i = 0; i < 4; ++i)
#pragma unroll
                for (int j = 0; j < 4; ++j) acc[i][j] = fmaf(a[i], b[j], acc[i][j]);
        }
        __syncthreads();
    }
#pragma unroll
    for (int i = 0; i < 4; ++i) { const int gr = m0 + ty * 4 + i; if (gr >= M) continue;
        float* cp = C + (size_t)gr * ldc + n0 + tx * 4;
        float4 o = make_float4(acc[i][0], acc[i][1], acc[i][2], acc[i][3]);
        if (accumulate) { const float4 c = *(const float4*)cp; o.x += c.x; o.y += c.y; o.z += c.z; o.w += c.w; }
        *(float4*)cp = o; }
}
__global__ void k_rope(float* __restrict__ p) {
    const int idx = blockIdx.x * blockDim.x + threadIdx.x;
    if (idx >= L * 2 * NH * 2 * 32) return;
    const int i = idx & 31, c = (idx >> 5) & 1, hd = (idx >> 6) & 7, which = (idx >> 9) & 1, t = idx >> 10;
    const float inv = powf(10000.0f, -(float)(2 * i) / 64.0f); const float ang = (float)t * inv;
    const float cs = cosf(ang), sn = sinf(ang);
    float* base = p + (size_t)t * INW + 5120 + which * 1024 + hd * 128 + c * 64;
    const float t1 = base[i], t2 = base[32 + i];
    base[i] = t1 * cs - t2 * sn; base[32 + i] = t2 * cs + t1 * sn;
}
__global__ void __launch_bounds__(256) k_hgrn(const float* __restrict__ p, int ldp, const float* __restrict__ lb_logits  , int layer,
                                              float* __restrict__ o_f, float* __restrict__ o_b) {
    __shared__ float sq[128], sf[128], sk[128], sacc[256];
    const int hd = blockIdx.x, dir = blockIdx.y, tid = threadIdx.x, v = tid & 127, kh = tid >> 7;
    float lb = 0.f;
    if (tid < 128) { if (layer == 1) { const float l0 = lb_logits[(0 * 2 + dir) * 1024 + hd * 128 + tid], l1 = lb_logits[(1 * 2 + dir) * 1024 + hd * 128 + tid];
            const float m = fmaxf(l0, l1); const float e0 = expf(l0 - m), e1 = expf(l1 - m); lb = e1 / (e0 + e1); } }
    float S[64];
#pragma unroll
    for (int k = 0; k < 64; ++k) S[k] = 0.f;
    float* out = dir == 0 ? o_f : o_b;
    for (int step = 0; step < L; ++step) {
        const int t = dir == 0 ? step : L - 1 - step;
        const float* row = p + (size_t)t * ldp;
        if (tid < 128) {
            const float z = row[(dir == 0 ? 1024 : 2048) + hd * 128 + tid];
            const float s = sigmoidf_(z), sn = sigmoidf_(-z);
            sq[tid] = row[hd * 128 + tid]; sf[tid] = lb + (1.0f - lb) * s; sk[tid] = (1.0f - lb) * sn;
        }
        const float vv = row[3072 + hd * 128 + v];
        __syncthreads();
        float acc = 0.f;
#pragma unroll
        for (int k = 0; k < 64; ++k) { const int kk = kh * 64 + k; S[k] = fmaf(sf[kk], S[k], sk[kk] * vv); acc = fmaf(S[k], sq[kk], acc); }
        sacc[tid] = acc;
        __syncthreads();
        if (tid < 128) out[(size_t)t * 1024 + hd * 128 + tid] = sacc[tid] + sacc[tid + 128];
    }
}
__global__ void k_hgrn_final(const float* __restrict__ o_f, const float* __restrict__ o_b, const float* __restrict__ p, const float* __restrict__ g, float* __restrict__ mixed) {
    const int wave = (blockIdx.x * blockDim.x + threadIdx.x) >> 6, lane = threadIdx.x & 63;
    if (wave >= L * NH) return;
    const int t = wave >> 3, hd = wave & 7;
    const size_t off = (size_t)t * 1024 + hd * 128;
    const float a0 = o_f[off + lane] + o_b[off + lane], a1 = o_f[off + 64 + lane] + o_b[off + 64 + lane];
    const float ss = wave_sum(a0 * a0 + a1 * a1); const float rs = rsqrtf(ss * (1.0f / 128.0f) + EPS);
    const float g0 = p[(size_t)t * INW + 4096 + hd * 128 + lane], g1 = p[(size_t)t * INW + 4096 + hd * 128 + 64 + lane];
    mixed[(size_t)t * MIXW + hd * 128 + lane] = a0 * rs * g[lane] * siluf_(g0);
    mixed[(size_t)t * MIXW + hd * 128 + 64 + lane] = a1 * rs * g[64 + lane] * siluf_(g1);
}
constexpr int NKP = ((L + 63) / 64) * 64;
__global__ void __launch_bounds__(128) k_attn(const float* __restrict__ p, const float* __restrict__ lamv  , const float* __restrict__ subg, int layer, float* __restrict__ mixed) {
    __shared__ float sq[2][128]; __shared__ float sp[2][NKP]; __shared__ float st[2][NKP];
    const int wid = threadIdx.x >> 6, lane = threadIdx.x & 63; const int gw = blockIdx.x * 2 + wid;
    const int t = gw >> 3, hd = gw & 7;
    const float lam_init = 0.8f - 0.6f * expf(-0.3f * (float)layer);
    float d1 = lamv[lane] * lamv[64 + lane], d2 = lamv[128 + lane] * lamv[192 + lane];
    d1 = wave_sum(d1); d2 = wave_sum(d2);
    const float lam = expf(d1) - expf(d2) + lam_init;
    const float* qrow = p + (size_t)t * INW + 5120 + hd * 128;
    sq[wid][lane] = qrow[lane]; sq[wid][64 + lane] = qrow[64 + lane];
    __syncthreads();
#pragma unroll 1
    for (int c = 0; c < 2; ++c) {
        float m = -INFINITY;
#pragma unroll 1
        for (int key = lane; key < L; key += 64) {
            const float* kr = p + (size_t)key * INW + 6144 + hd * 128 + c * 64; float a = 0.f;
#pragma unroll 4
            for (int d = 0; d < 64; d += 4) { const float4 k0 = *(const float4*)(kr + d);
                a += sq[wid][c * 64 + d] * k0.x + sq[wid][c * 64 + d + 1] * k0.y + sq[wid][c * 64 + d + 2] * k0.z + sq[wid][c * 64 + d + 3] * k0.w; }
            a *= 0.125f; st[wid][key] = a; m = fmaxf(m, a);
        }
        m = wave_max(m);
        float l = 0.f;
#pragma unroll 1
        for (int key = lane; key < L; key += 64) { const float e = expf(st[wid][key] - m); st[wid][key] = e; l += e; }
        l = wave_sum(l);
        const float sc = c == 0 ? 1.0f / l : -lam / l;
#pragma unroll 1
        for (int key = lane; key < L; key += 64) { const float v = st[wid][key] * sc; sp[wid][key] = c == 0 ? v : sp[wid][key] + v; }
    }
    __syncthreads();
    float o0 = 0.f, o1 = 0.f;
#pragma unroll 4
    for (int key = 0; key < L; ++key) { const float pd = sp[wid][key]; const float* vr = p + (size_t)key * INW + 7168 + hd * 128;
        o0 = fmaf(pd, vr[lane], o0); o1 = fmaf(pd, vr[64 + lane], o1); }
    const float ss = wave_sum(o0 * o0 + o1 * o1); const float rs = rsqrtf(ss * (1.0f / 128.0f) + EPS) * (1.0f - lam_init);
    const float g0 = p[(size_t)t * INW + 8192 + hd * 128 + lane], g1 = p[(size_t)t * INW + 8192 + hd * 128 + 64 + lane];
    mixed[(size_t)t * MIXW + 1024 + hd * 128 + lane] = o0 * rs * subg[lane] * siluf_(g0);
    mixed[(size_t)t * MIXW + 1024 + hd * 128 + 64 + lane] = o1 * rs * subg[64 + lane] * siluf_(g1);
}
}
__device__ __forceinline__ float dbg_bf(const unsigned short* a, size_t i) { return __uint_as_float((unsigned)a[i] << 16); }
__device__ __forceinline__ void dbg_acc(float& d, float& r, float v, float ref) { const float e = fabsf(v - ref); if (!(e == e)) d = 1e30f; d = fmaxf(d, e); r = fmaxf(r, fabsf(ref)); }
__global__ void dbg_check_epi(const float* __restrict__ pb5  , const unsigned char* __restrict__ ws, unsigned* __restrict__ res) {
    const int idx = blockIdx.x * blockDim.x + threadIdx.x; if (idx >= 129 * 1024) return;
    const int c = idx >> 10, ch = idx & 1023;
    const unsigned short *QDF = (const unsigned short*)(ws + WS_QDF), *KTF = (const unsigned short*)(ws + WS_KTF), *QDB = (const unsigned short*)(ws + WS_QDB), *KTB = (const unsigned short*)(ws + WS_KTB);
    const float *DECF = (const float*)(ws + WS_DECF), *DECB = (const float*)(ws + WS_DECB);
    float dq = 0.f, rq = 0.f, dk = 0.f, rk = 0.f, dd = 0.f, rd = 0.f;
    float b = 0.f;
    for (int i = 0; i < 16; ++i) { const float* pr = pb5 + (size_t)(16 * c + i) * 5120; const float q = pr[ch], z = pr[1024 + ch];
        const float f = 1.0f / (1.0f + expf(-z)), kin = 1.0f / (1.0f + expf(z)); b += logf(fmaxf(f, 1e-30f));
        const size_t row = c == 0 ? 8192 + i : 16 * (c - 1) + i;
        dbg_acc(dq, rq, dbg_bf(QDF, row * 1024 + ch), q * expf(b)); dbg_acc(dk, rk, dbg_bf(KTF, row * 1024 + ch) * expf(b), kin); }
    dbg_acc(dd, rd, DECF[(size_t)(c == 0 ? 512 : c - 1) * 1024 + ch], expf(b));
    b = 0.f;
    for (int i = 15; i >= 0; --i) { const float* pr = pb5 + (size_t)(16 * c + i) * 5120; const float q = pr[ch], z = pr[2048 + ch];
        const float f = 1.0f / (1.0f + expf(-z)), kin = 1.0f / (1.0f + expf(z)); b += logf(fmaxf(f, 1e-30f));
        const size_t row = c == 0 ? 8192 + i : 16 * (c - 1) + i;
        dbg_acc(dq, rq, dbg_bf(QDB, row * 1024 + ch), q * expf(b)); dbg_acc(dk, rk, dbg_bf(KTB, row * 1024 + ch) * expf(b), kin); }
    dbg_acc(dd, rd, DECB[(size_t)(c == 0 ? 512 : c - 1) * 1024 + ch], expf(b));
    atomicMax(res + 0, __float_as_uint(dq)); atomicMax(res + 1, __float_as_uint(rq)); atomicMax(res + 2, __float_as_uint(dk)); atomicMax(res + 3, __float_as_uint(rk));
    atomicMax(res + 4, __float_as_uint(dd)); atomicMax(res + 5, __float_as_uint(rd));
}
__global__ void dbg_check_o(const float* __restrict__ of, const float* __restrict__ ob, const unsigned char* __restrict__ ws, unsigned* __restrict__ res) {
    const unsigned short *QDF = (const unsigned short*)(ws + WS_QDF), *QDB = (const unsigned short*)(ws + WS_QDB);
    float df = 0.f, rf = 0.f, db = 0.f, rb = 0.f;
    for (int i = blockIdx.x * blockDim.x + threadIdx.x; i < 2064 * 1024; i += gridDim.x * blockDim.x) { const int t = i >> 10, c = i & 1023; const size_t row = t < 16 ? 8192 + t : t - 16;
        dbg_acc(df, rf, dbg_bf(QDF, row * 1024 + c), of[i]); dbg_acc(db, rb, dbg_bf(QDB, row * 1024 + c), ob[i]); }
    atomicMax(res + 8, __float_as_uint(df)); atomicMax(res + 9, __float_as_uint(rf)); atomicMax(res + 10, __float_as_uint(db)); atomicMax(res + 11, __float_as_uint(rb));
}

__global__ void __launch_bounds__(256) dbg_chunk_oracle(const unsigned char* __restrict__ ws, float* __restrict__ o2f, float* __restrict__ o2b) {
    __shared__ float sQ[16][128], sK[16][128], sV[16][128], sA[16][16], sO[2][16][128], sD[128];
    const int hd = blockIdx.x, dir = blockIdx.y, tid = threadIdx.x, v = tid & 127, kh = tid >> 7;
    const unsigned short* QD = (const unsigned short*)(ws + (dir == 0 ? WS_QDF : WS_QDB)); const unsigned short* KT = (const unsigned short*)(ws + (dir == 0 ? WS_KTF : WS_KTB));
    const unsigned short* VH = (const unsigned short*)(ws + WS_VH); const float* DEC = (const float*)(ws + (dir == 0 ? WS_DECF : WS_DECB));
    float* out = dir == 0 ? o2f : o2b;
    float S[64];
#pragma unroll
    for (int k = 0; k < 64; ++k) S[k] = 0.f;
    for (int step = 0; step < 129; ++step) {
        const int c = dir == 0 ? step : 128 - step; const size_t rowb = c == 0 ? 8192 : 16 * (c - 1);
        for (int i = tid; i < 16 * 128; i += 256) { const int t = i >> 7, k = i & 127; const size_t o = (rowb + t) * 1024 + hd * 128 + k;
            sQ[t][k] = dbg_bf(QD, o); sK[t][k] = dbg_bf(KT, o); sV[t][k] = dbg_bf(VH, o); }
        if (tid < 128) sD[tid] = DEC[(size_t)(c == 0 ? 512 : c - 1) * 1024 + hd * 128 + tid];
#ifdef DBG_DEC1
        if (tid < 128) sD[tid] = 0.5f;
#endif
#ifdef DBG_SFIX
#pragma unroll
        for (int k = 0; k < 64; ++k) S[k] = DBG_SFN(kh * 64 + k, v);
#endif
        __syncthreads();
        { const int t = tid >> 4, s = tid & 15; float a = 0.f; for (int k = 0; k < 128; ++k) a += sQ[t][k] * sK[s][k];
          const bool keep = dir == 0 ? (s <= t) : (s >= t); sA[t][s] = keep ? a : 0.f; }
        __syncthreads();
#pragma unroll 1
        for (int t = 0; t < 16; ++t) { float acc = 0.f;
#ifndef DBG_NOINTRA
            if (kh == 0) {
#pragma unroll 1
                for (int s = 0; s < 16; ++s) acc += sA[t][s] * sV[s][v]; }
#endif
#ifndef DBG_INTRA_ONLY
#pragma unroll
            for (int k = 0; k < 64; ++k) acc += sQ[t][kh * 64 + k] * S[k];
#endif
            sO[kh][t][v] = acc; }
        { float U[64];
#pragma unroll
          for (int k = 0; k < 64; ++k) U[k] = 0.f;
#pragma unroll 1
          for (int s = 0; s < 16; ++s) { const float vs = sV[s][v];
#pragma unroll
              for (int k = 0; k < 64; ++k) U[k] += sK[s][kh * 64 + k] * vs; }
#pragma unroll
          for (int k = 0; k < 64; ++k) S[k] = sD[kh * 64 + k] * (S[k] + U[k]); }
        __syncthreads();
        for (int i = tid; i < 16 * 128; i += 256) { const int t = i >> 7, vv = i & 127; const int tok = c * 16 + t; out[(size_t)tok * 1024 + hd * 128 + vv] = sO[0][t][vv] + sO[1][t][vv]; }
        __syncthreads();
    }
}
__global__ void dbg_check_o2(const float* __restrict__ of, const float* __restrict__ ob, const float* __restrict__ o2f, const float* __restrict__ o2b, unsigned* __restrict__ res) {
    float df = 0.f, rf = 0.f, db = 0.f, rb = 0.f;
    for (int i = blockIdx.x * blockDim.x + threadIdx.x; i < 2064 * 1024; i += gridDim.x * blockDim.x) { dbg_acc(df, rf, o2f[i], of[i]); dbg_acc(db, rb, o2b[i], ob[i]); }
    atomicMax(res + 12, __float_as_uint(df)); atomicMax(res + 13, __float_as_uint(rf)); atomicMax(res + 14, __float_as_uint(db)); atomicMax(res + 15, __float_as_uint(rb));
}
__device__ int dbg_digit(float d, float r) { const float rel = d / fmaxf(r, 1e-20f); if (!(rel == rel) || rel > 1e20f) return 9; int k = (int)floorf(-2.0f * log10f(fmaxf(rel, 1e-12f))); return k < 1 ? 1 : (k > 8 ? 8 : k); }
__global__ void dbg_report(float* __restrict__ out, int n, const unsigned* __restrict__ res, int ia, int ib) {
    for (int i = blockIdx.x * blockDim.x + threadIdx.x; i < n; i += gridDim.x * blockDim.x) out[i] = 0.f;
    if (blockIdx.x == 0 && threadIdx.x == 0) {
        const int d1 = dbg_digit(__uint_as_float(res[ia]), __uint_as_float(res[ia + 1])), d2 = dbg_digit(__uint_as_float(res[ib]), __uint_as_float(res[ib + 1]));
        out[0] = (float)(d1 * 10 + d2) * 1000.0f;
    }
}
#endif

__device__ __forceinline__ void meta_outproj(Frame& F, int task) {
    int tid_l = F.tid; asm volatile("; LAUNDER" : "+v"(tid_l));
    const int rg = task >> 4, cb = task & 15, half = rg >> 2, bl = rg & 3, lane = tid_l & 63, g = lane >> 4, i16 = lane & 15, wave = __builtin_amdgcn_readfirstlane(tid_l >> 6);
    const bf16* A = (const bf16*)(F.ws + WS_GQ) + ((size_t)half * HROWS + 8192 + bl * 16 + i16) * 2048;
    const bf16* B = (const bf16*)(F.ws + WS_WOUT) + (size_t)(cb * 64 + i16) * 2048;
    f32x4 acc[4];
#pragma unroll
    for (int nt = 0; nt < 4; ++nt) acc[nt] = (f32x4){0.f, 0.f, 0.f, 0.f};
#pragma unroll 2
    for (int kk = 0; kk < 8; ++kk) { const int k0 = wave * 256 + kk * 32 + 8 * g;
        const bf16x8 a = *(const GAS bf16x8*)(A + k0);
#pragma unroll
        for (int nt = 0; nt < 4; ++nt) { const bf16x8 b = *(const GAS bf16x8*)(B + (size_t)nt * 16 * 2048 + k0); acc[nt] = __builtin_amdgcn_mfma_f32_16x16x32_bf16(a, b, acc[nt], 0, 0, 0); } }
    LAS f32x4* red = (LAS f32x4*)F.lds;
#pragma unroll
    for (int nt = 0; nt < 4; ++nt) red[(wave * 4 + nt) * 64 + lane] = acc[nt];
    __syncthreads();
    if (wave < 4) { const int nt = wave; f32x4 s = red[nt * 64 + lane];
#pragma unroll
        for (int w = 1; w < 8; ++w) s = s + red[(w * 4 + nt) * 64 + lane];
        float* hm = (float*)(F.ws + WS_HMETA);
#pragma unroll
        for (int r = 0; r < 4; ++r) { const int j = 4 * g + r, col = cb * 64 + 16 * nt + i16; hm[(size_t)(rg * 16 + j) * 1024 + col] = F.A->in[1][(size_t)j * 1024 + col] + s[r]; } }
    __syncthreads();
}
__device__ __forceinline__ void phase_norm_mid(Frame& F) {
    const int tid = fresh_tid(), lane = tid & 63, wave = __builtin_amdgcn_readfirstlane(tid >> 6);
    const int gw = F.bid * NWAVES + wave, NGW = F.G * NWAVES; bf16* U = (bf16*)(F.ws + WS_U);
    const float* g1 = F.A->in[2] + DM; const float* hm = (const float*)(F.ws + WS_HMETA);
    for (int m = gw; m < NBATCH * SEQ + NBATCH * NMETA; m += NGW) {
        if (m < NBATCH * SEQ) { const int half = m >> 13; norm_row_to_bf16(lane, F.out + (size_t)m * DM, g1, U + ((size_t)m + half * 256) * DM, 1, 0); }
        else { const int mm = m - NBATCH * SEQ, b = mm >> 4, j = mm & 15; norm_row_to_bf16(lane, hm + (size_t)mm * DM, g1, U + ((size_t)(b >> 2) * HROWS + 8192 + (b & 3) * 16 + j) * DM, 1, 0); }
    }
}
__device__ __forceinline__ void phase_norm_final(Frame& F) {
    const int tid = fresh_tid(), lane = tid & 63, wave = __builtin_amdgcn_readfirstlane(tid >> 6);
    const int gw = F.bid * NWAVES + wave, NGW = F.G * NWAVES;
    for (int m = gw; m < NBATCH * SEQ; m += NGW) {
        GAS f32x4* xr = (GAS f32x4*)(F.out + (size_t)m * DM) + lane; const GAS f32x4* gr = (const GAS f32x4*)F.A->in[9] + lane;
        f32x4 v[4]; float s = 0.f;
#pragma unroll
        for (int j = 0; j < 4; ++j) { v[j] = xr[64 * j]; s += (v[j].x * v[j].x + v[j].y * v[j].y) + (v[j].z * v[j].z + v[j].w * v[j].w); }
        const float rs = 1.0f / sqrtf(wave_sum(s) * (1.0f / DM) + NEPS);
#pragma unroll
        for (int j = 0; j < 4; ++j) { const f32x4 gg = gr[64 * j]; xr[64 * j] = v[j] * rs * gg; }
    }
}
__device__ __forceinline__ void phase_mix(Frame& F, int layer, int half) {
    const size_t gq_half = (size_t)half * HROWS * 2048 * 2;
    #ifndef NO_SCAN
    if (F.bid < 32) { hgrn_scan_item(F, gq_half, F.bid >> 3, F.bid & 7, layer); __syncthreads(); }
#endif
    const int nmeta = layer == 0 ? 32 : 0, nitems = 512 + nmeta;
    gu32* head = F.ctl + CW_QUEUE + 64 * (2 * layer + half);
#ifndef NO_ATTN
    for (;;) {
        if (F.tid == 0) F.MISC[16] = __hip_atomic_fetch_add(head, 1u, RLX_AGENT);
        __syncthreads();
        const int item = (int)F.MISC[16];
        __syncthreads();
        if (item >= nitems) break;
        if (item < nmeta) attn_item<true>(F, gq_half, item >> 3, item & 7, 0, layer);
        else { const int it = item - nmeta; attn_item<false>(F, gq_half, it >> 7, (it >> 4) & 7, it & 15, layer); }
    }
#endif
}

constexpr int N_PHASES = 13;
#ifndef MK_N_LAUNCHES
#define MK_N_LAUNCHES 1
#endif
__global__ void __launch_bounds__(NTHREADS, 2) hymba_fwd(Args args) {
    extern __shared__ __attribute__((aligned(16))) unsigned char lds[];
    Frame F;
    F.lds = (LAS unsigned char*)lds; F.MISC = (volatile LAS unsigned*)(F.lds + MISC_OFF);
    F.tid = threadIdx.x; F.lane = F.tid & 63; F.wave = __builtin_amdgcn_readfirstlane(F.tid >> 6); F.G = gridDim.x; F.bid = blockIdx.x;
    F.ws = args.ws; F.ctl = (gu32*)(args.ws + WS_CTL); F.out = args.out;
    F.A = &args;
    for (int u = F.tid; u < (LDS_BYTES - LDSCTL_OFF) / 4; u += NTHREADS) ((LAS unsigned*)(F.lds + LDSCTL_OFF))[u] = 0u;
    __syncthreads();
    XcdBarrier bar; bar.bar = (unsigned*)(F.ctl + CW_BAR) + args.li * XCD_BAR_WORDS; bar.x = 0; bar.st = nullptr;
    const int lo = args.ph_lo, hi = args.ph_hi;
    if (hi - lo > 1) bar = xcd_barrier_post((unsigned*)(F.ctl + CW_BAR) + args.li * XCD_BAR_WORDS, F.MISC + 8);
#ifndef TYMASK
#define TYMASK 0xffu
#endif
#define TY(t) ((TYMASK >> (t)) & 1u)
#ifndef PHMASK
#define PHMASK 0xffffffffu
#endif
#define IN(k) (((PHMASK >> (k)) & 1u) && lo <= (k) && (k) < hi)
#define SEAM(k) do { if (IN(k) && IN((k) + 1)) xcd_barrier(bar); } while (0)
    unsigned char* ws = args.ws;
    if (TY(0) && IN(0)) { p0_prologue(F); SEAM(0); }
#pragma unroll 1
    for (int l = 0; l < 2; ++l) {
        const int pb = 1 + 6 * l;
#pragma unroll 1
        for (int half = 0; half < 2; ++half) {
            if (TY(1) && IN(pb + 2 * half)) {
                pg8::Gemm g{(const pg8::bf16_t*)(ws + WS_U) + (size_t)half * HROWS * DM, (const pg8::bf16_t*)(ws + WS_WIN) + (size_t)l * INW * DM, HROWS, INW, DM};
                pg8::OrderIn S; S.init(HROWS, INW, F.G, F.bid);
                pg8::EpiIn E{ws, (size_t)half * HROWS * 2048 * 2, F.A->in[4], l};
                pg8::gemm_phase<pg8::EpiIn, pg8::OrderIn, true, true>(F.lds, g, S, E);
                SEAM(pb + 2 * half);
            }
            if (TY(2) && IN(pb + 2 * half + 1)) { phase_mix(F, l, half); SEAM(pb + 2 * half + 1); }
        }
        if (TY(3) && IN(pb + 4)) {
            pg8::Gemm g{(const pg8::bf16_t*)(ws + WS_GQ), (const pg8::bf16_t*)(ws + WS_WOUT) + (size_t)l * DM * 2048, NBATCH * SEQ, DM, 2048};
            pg8::OrderOut S; S.init(NBATCH * SEQ, DM, F.G, F.bid);
            pg8::EpiOut E{l == 0 ? F.A->in[0] : (const float*)F.out, F.out};
            pg8::gemm_phase<pg8::EpiOut, pg8::OrderOut, false, true>(F.lds, g, S, E);
            if (l == 0) { for (int t = F.bid; t < 128; t += F.G) meta_outproj(F, t); }
            SEAM(pb + 4);
        }
        if (TY(4) && IN(pb + 5)) { if (l == 0) { phase_norm_mid(F); SEAM(pb + 5); } else phase_norm_final(F); }
    }
#undef IN
#undef SEAM
}

extern "C" void kernel_launch(void* const* d_in, const int* in_sizes, int n_in, void* d_out, int out_size, void* d_ws, size_t ws_size, hipStream_t stream) {
    static int grid = 0;
    if (grid == 0) {
        if (n_in != 10 || in_sizes[0] != NBATCH * SEQ * DM || out_size != NBATCH * SEQ * DM || ws_size < WS_END) {
            fprintf(stderr, "kernel_launch: shape/workspace mismatch: n_in %d in0 %d out %d ws %zu (need %zu)\n", n_in, n_in > 0 ? in_sizes[0] : -1, out_size, ws_size, (size_t)WS_END); grid = -1; return; }
        int dev = 0, cus = 0;
        if (hipGetDevice(&dev) != hipSuccess || hipDeviceGetAttribute(&cus, hipDeviceAttributeMultiprocessorCount, dev) != hipSuccess) { grid = -1; return; }
        if (hipFuncSetAttribute((const void*)hymba_fwd, hipFuncAttributeMaxDynamicSharedMemorySize, LDS_BYTES) != hipSuccess) { fprintf(stderr, "kernel_launch: hipFuncSetAttribute failed\n"); grid = -1; return; }
        int per_cu = 0;
        if (hipOccupancyMaxActiveBlocksPerMultiprocessor(&per_cu, (const void*)hymba_fwd, NTHREADS, LDS_BYTES) != hipSuccess || per_cu < 1)
            fprintf(stderr, "kernel_launch: note: occupancy query reports %d workgroups per CU\n", per_cu);
        (void)hipGetLastError();
        grid = cus;
    }
    if (grid < 0) return;
#ifdef DBG
    float* dbg_pb5 = (float*)d_out; float* dbg_of = (float*)((char*)d_ws + WS_GQ + 2 * SZ_HALF); float* dbg_ob = dbg_of + (size_t)2064 * 1024;
    {   using nv::L; using nv::D; using nv::NH;
        float* hb = (float*)((char*)d_ws + WS_U + SZ_HALF); float* ub = hb + (size_t)L * D;
        const float* x = (const float*)d_in[0]; const float* meta = (const float*)d_in[1];
        (void)hipMemcpyAsync(hb, meta, (size_t)16 * D * 4, hipMemcpyDeviceToDevice, stream); (void)hipMemcpyAsync(hb + 16 * D, x, (size_t)nv::SEQ * D * 4, hipMemcpyDeviceToDevice, stream);
        nv::k_rmsnorm<<<(L + 3) / 4, 256, 0, stream>>>(hb, (const float*)d_in[2], ub, L, 0);
        nv::k_gemm<<<dim3(5120 / 64, (L + 63) / 64), 256, 0, stream>>>(ub, D, (const float*)d_in[3], nv::INW, dbg_pb5, 5120, L, 5120, D, 0);
        nv::k_hgrn<<<dim3(NH, 2), 256, 0, stream>>>(dbg_pb5, 5120, (const float*)d_in[4], 0, dbg_of, dbg_ob);
    }
#endif
    if (hipMemsetAsync((char*)d_ws + WS_CTL, 0, CTL_ZERO_BYTES, stream) != hipSuccess) { fprintf(stderr, "kernel_launch: memset failed\n"); return; }
    Args a{};
    for (int i = 0; i < 10; ++i) a.in[i] = (const float*)d_in[i];
    a.out = (float*)d_out; a.ws = (unsigned char*)d_ws;
    constexpr int NL = MK_N_LAUNCHES;
#ifdef DBG
    const int nl_run = 3;
#else
    const int nl_run = NL;
#endif
    for (int li = 0; li < nl_run; ++li) {
        a.ph_lo = NL == 1 ? 0 : li; a.ph_hi = NL == 1 ? N_PHASES : li + 1; a.li = NL == 1 ? 0 : 0;
        hipLaunchKernelGGL(hymba_fwd, dim3(grid), dim3(NTHREADS), LDS_BYTES, stream, a);
        const hipError_t le = hipPeekAtLastError();
        if (le != hipSuccess) { fprintf(stderr, "kernel_launch: launch %d failed: %s\n", li, hipGetErrorName(le)); break; }
#ifdef DBG
        if (li == 1) { dbg_check_epi<<<(129 * 1024 + 255) / 256, 256, 0, stream>>>(dbg_pb5, (const unsigned char*)d_ws, (unsigned*)d_ws + 64);
            float* o2f = (float*)((char*)d_ws + WS_U + SZ_HALF); float* o2b = o2f + (size_t)2064 * 1024;
            dbg_chunk_oracle<<<dim3(8, 2), 256, 0, stream>>>((const unsigned char*)d_ws, o2f, o2b);
            dbg_check_o2<<<1024, 256, 0, stream>>>(dbg_of, dbg_ob, o2f, o2b, (unsigned*)d_ws + 64); }
#endif
    }
#ifdef DBG
#ifdef DBG_VS_O2
    { float* o2f = (float*)((char*)d_ws + WS_U + SZ_HALF); float* o2b = o2f + (size_t)2064 * 1024; dbg_check_o<<<1024, 256, 0, stream>>>(o2f, o2b, (const unsigned char*)d_ws, (unsigned*)d_ws + 64); }
#else
    dbg_check_o<<<1024, 256, 0, stream>>>(dbg_of, dbg_ob, (const unsigned char*)d_ws, (unsigned*)d_ws + 64);
#endif
    dbg_report<<<1024, 256, 0, stream>>>((float*)d_out, out_size, (const unsigned*)d_ws + 64, DBG_IA, DBG_IB);
#endif
}
```

```cpp
#include <hip/hip_runtime.h>
#include <hip/hip_bf16.h>
#include <cstdio>
#include <cstdint>
#include <cmath>
namespace pg8 {
#define PG8_LAS __attribute__((address_space(3)))
typedef unsigned short bf16_t;
typedef short bf16x8 __attribute__((ext_vector_type(8)));
typedef float f32x4 __attribute__((ext_vector_type(4)));
typedef unsigned u32x4 __attribute__((ext_vector_type(4)));
constexpr int BM = 256, BK = 64, HALF = 128, HTB = HALF * BK * 2  , STAGE_BYTES = 8 * HTB, NXCD = 8, WGM = 8;

__host__ __device__ __forceinline__ int lds_byte(int r, int c) { const int st = (r >> 4) * 2 + (c >> 5), rr = r & 15, cc = c & 31, ob = rr * 64 + cc * 2; return st * 1024 + (ob ^ (((ob >> 9) & 1) << 5)); }
__host__ __device__ __forceinline__ void stage_rc(int b, int& R, int& C) { const int st = b / 1024, sb = b % 1024, swz = sb ^ (((sb >> 9) & 1) << 5); R = (st >> 1) * 16 + swz / 64; C = (st & 1) * 32 + (swz % 64) / 2; }
__host__ __device__ __forceinline__ int perm32(int rho) { const int n = rho >> 4, i = rho & 15; return 8 * (i >> 2) + 4 * n + (i & 3); }

struct Unit { int pm, pn; };
struct Gemm { const bf16_t* A; const bf16_t* Bt; int M, N, K; };

struct StaticOrder {
    int nM, nN, nwg, G, c;
    __host__ __device__ void init(int M, int N, int G_, int c_) { nM = M / BM; nN = N / BM; nwg = nM * nN; G = G_; c = c_; }
    __host__ __device__ bool next(int i, Unit& u) const {
        const long L = (long)i * G + c; if (L >= nwg) return false;
        int wgid = (int)L; { const int q = nwg / NXCD, r = nwg % NXCD, xcd = wgid % NXCD, off = wgid / NXCD; wgid = (xcd < r ? xcd * (q + 1) : r * (q + 1) + (xcd - r) * q) + off; }
        const int nig = WGM * nN, gid = wgid / nig, fm = gid * WGM, gsz = (nM - fm) < WGM ? (nM - fm) : WGM;
        u.pm = fm + ((wgid % nig) % gsz); u.pn = (wgid % nig) / gsz; return true;
    }
    __device__ __forceinline__ void a_ready(const Unit&) const {}
    __device__ __forceinline__ void done(const Unit&) const {}
};

__device__ __forceinline__ unsigned cvt_pk_bf16(float lo, float hi) { unsigned r; asm volatile("v_cvt_pk_bf16_f32 %0, %1, %2" : "=v"(r) : "v"(lo), "v"(hi)); return r; }
}
constexpr int DM = 1024, NBATCH = 8, SEQ = 2048, NMETA = 16, LTOK = SEQ + NMETA, NHEAD = 8, INW = 9216;
constexpr int HROWS = 8448;
constexpr int NWAVES = 8, NTHREADS = 512;
constexpr float NEPS = 1e-6f;
constexpr size_t MiB = 1u << 20;
constexpr size_t WS_CTL = 0, CTL_ZERO_BYTES = 1 * MiB;
constexpr size_t WS_ROPE = 1 * MiB;
constexpr size_t WS_HMETA = 2 * MiB;
constexpr size_t WS_WIN = 3 * MiB;
constexpr size_t WS_WOUT = WS_WIN + 36 * MiB;
constexpr size_t WS_U = WS_WOUT + 8 * MiB;
constexpr size_t SZ_HALF = (size_t)HROWS * 1024 * 2;
constexpr size_t WS_GQ = WS_U + 2 * SZ_HALF;
constexpr size_t WS_QDF = WS_GQ + 4 * SZ_HALF, WS_KTF = WS_QDF + SZ_HALF, WS_QDB = WS_KTF + SZ_HALF, WS_KTB = WS_QDB + SZ_HALF, WS_VH = WS_KTB + SZ_HALF;
constexpr size_t WS_KA = WS_VH + SZ_HALF, WS_VA = WS_KA + SZ_HALF, WS_GA = WS_VA + SZ_HALF;
constexpr size_t SZ_DEC = (size_t)(HROWS / 16) * 1024 * 4;
constexpr size_t WS_DECF = WS_GA + SZ_HALF, WS_DECB = WS_DECF + SZ_DEC, WS_END = WS_DECB + SZ_DEC;
static_assert(WS_END <= 288 * MiB, "workspace map must fit 4 x largest tensor");
constexpr int CW_BAR = 4096;
constexpr int CW_QUEUE = 16384;
constexpr int RING_BYTES = 131072, LDSCTL_OFF = RING_BYTES, MISC_OFF = LDSCTL_OFF + 320, LDS_BYTES = 147456;


namespace pg8 {
typedef unsigned u32x2 __attribute__((ext_vector_type(2)));
__device__ __forceinline__ float fexp(float x) { return __builtin_amdgcn_exp2f(x * 1.4426950408889634f); }
__device__ __forceinline__ float flog(float x) { return __builtin_amdgcn_logf(x) * 0.6931471805599453f; }
__device__ __forceinline__ float frcp(float x) { return __builtin_amdgcn_rcpf(x); }
__device__ __forceinline__ float fsilu(float z) { const float zc = fminf(fmaxf(z, -80.f), 80.f); return z * frcp(1.0f + fexp(-zc)); }
__device__ __forceinline__ float scan16(float x) {
    x += __builtin_bit_cast(float, __builtin_amdgcn_update_dpp(0, __builtin_bit_cast(int, x), 0x111, 0xf, 0xf, true));
    x += __builtin_bit_cast(float, __builtin_amdgcn_update_dpp(0, __builtin_bit_cast(int, x), 0x112, 0xf, 0xf, true));
    x += __builtin_bit_cast(float, __builtin_amdgcn_update_dpp(0, __builtin_bit_cast(int, x), 0x114, 0xf, 0xf, true));
    x += __builtin_bit_cast(float, __builtin_amdgcn_update_dpp(0, __builtin_bit_cast(int, x), 0x118, 0xf, 0xf, true));
    return x;
}
constexpr float QSCALE = 0.125f * 1.4426950408889634f;

struct EpiIn {
    static constexpr bool PERM = true, AFTER_DRAIN = false;
    unsigned char* ws;
    size_t gq_half;
    const float* lbl;
    int layer;
    __device__ __forceinline__ void operator()(const f32x4 (&acc)[2][2][4][2], const Unit& u, int wr, int wc, int fr, int fq) const {
        const int rowb = u.pm * BM + wr * 64 + fr;
        if (u.pn < 16) {
            const int ch0 = u.pn * 64 + wc * 16 + fq * 4;
            float lbf[4], lbb[4];
#pragma unroll
            for (int e = 0; e < 4; ++e) { lbf[e] = 0.f; lbb[e] = 0.f; }
            if (layer == 1) {
#pragma unroll
                for (int e = 0; e < 4; ++e) {
                    lbf[e] = frcp(1.0f + fexp(lbl[0 * 1024 + ch0 + e] - lbl[2048 + 0 * 1024 + ch0 + e]));
                    lbb[e] = frcp(1.0f + fexp(lbl[1 * 1024 + ch0 + e] - lbl[2048 + 1 * 1024 + ch0 + e]));
                }
            }
#pragma unroll
            for (int ai = 0; ai < 2; ++ai)
#pragma unroll
                for (int m = 0; m < 4; ++m) {
                    const int row = rowb + ai * HALF + m * 16; const int chunk = row >> 4;
                    const f32x4 q = acc[ai][0][m][0], zf = acc[ai][0][m][1], zb = acc[ai][1][m][0], vi = acc[ai][1][m][1];
                    float qdf[4], ktf[4], qdb[4], ktb[4], dcf[4], dcb[4];
#pragma unroll
                    for (int e = 0; e < 4; ++e) {
                        {   const float z = fminf(fmaxf(zf[e], -80.f), 80.f);
                            const float t = fexp(-z), s = frcp(1.0f + t);
                            const float f = lbf[e] + (1.0f - lbf[e]) * s, kin = (1.0f - lbf[e]) * t * s;
                            const float a = flog(fmaxf(f, 1e-30f));
                            const float b = scan16(a);
                            const float E = fexp(b);
                            qdf[e] = q[e] * E; ktf[e] = kin * fexp(fminf(-b, 80.f)); dcf[e] = E; }
                        {   const float z = fminf(fmaxf(zb[e], -80.f), 80.f);
                            const float t = fexp(-z), s = frcp(1.0f + t);
                            const float f = lbb[e] + (1.0f - lbb[e]) * s, kin = (1.0f - lbb[e]) * t * s;
                            const float a = flog(fmaxf(f, 1e-30f));
                            const float b = scan16(a);
                            const float tot = __shfl(b, 15, 16);
                            const float bb = tot - b + a;
                            const float E = fexp(bb);
                            qdb[e] = q[e] * E; ktb[e] = kin * fexp(fminf(-bb, 80.f)); dcb[e] = E; }
                    }
                    unsigned char* o = ws + ((size_t)row * 1024 + ch0) * 2;
                    *(u32x2*)(o + WS_QDF) = (u32x2){cvt_pk_bf16(qdf[0], qdf[1]), cvt_pk_bf16(qdf[2], qdf[3])};
                    *(u32x2*)(o + WS_KTF) = (u32x2){cvt_pk_bf16(ktf[0], ktf[1]), cvt_pk_bf16(ktf[2], ktf[3])};
                    *(u32x2*)(o + WS_QDB) = (u32x2){cvt_pk_bf16(qdb[0], qdb[1]), cvt_pk_bf16(qdb[2], qdb[3])};
                    *(u32x2*)(o + WS_KTB) = (u32x2){cvt_pk_bf16(ktb[0], ktb[1]), cvt_pk_bf16(ktb[2], ktb[3])};
                    *(u32x2*)(o + WS_VH)  = (u32x2){cvt_pk_bf16(vi[0], vi[1]), cvt_pk_bf16(vi[2], vi[3])};
                    if (fr == 15 || fr == 0) { const bool fw = fr == 15;
                        *(f32x4*)(ws + (fw ? WS_DECF : WS_DECB) + ((size_t)chunk * 1024 + ch0) * 4) = fw ? (f32x4){dcf[0], dcf[1], dcf[2], dcf[3]} : (f32x4){dcb[0], dcb[1], dcb[2], dcb[3]}; }
                    asm volatile("" ::: "memory");
                }
        } else if (u.pn >= 20 && u.pn < 28) {
            const bool isq = u.pn < 24;
            const int colt = (u.pn - (isq ? 20 : 24)) * BM + wc * 32 + 8 * fq;
            const float sc = isq ? QSCALE : 1.0f;
            unsigned char* base = ws + (isq ? (WS_GQ + gq_half + 2048) : WS_KA); const int ld = isq ? 2048 : 1024;
#pragma unroll
            for (int ai = 0; ai < 2; ++ai)
#pragma unroll
                for (int m = 0; m < 4; ++m) {
                    const int row = rowb + ai * HALF + m * 16;
                    const int tpos = row < 8192 ? 16 + (row & 2047) : ((row - 8192) & 15);
                    const float* rp = (const float*)(ws + WS_ROPE) + (size_t)tpos * 64;
#pragma unroll
                    for (int bj = 0; bj < 2; ++bj) {
                        const int col = colt + bj * HALF;
                        const int i0 = (col & 63) >> 1;
                        const f32x4 cs0 = *(const f32x4*)(rp + 2 * i0), cs1 = *(const f32x4*)(rp + 2 * i0 + 4);
                        const f32x4 a = acc[ai][bj][m][0], b = acc[ai][bj][m][1];
                        const float o0 = a[0] * cs0[0] - a[1] * cs0[1], o1 = a[1] * cs0[0] + a[0] * cs0[1];
                        const float o2 = a[2] * cs0[2] - a[3] * cs0[3], o3 = a[3] * cs0[2] + a[2] * cs0[3];
                        const float o4 = b[0] * cs1[0] - b[1] * cs1[1], o5 = b[1] * cs1[0] + b[0] * cs1[1];
                        const float o6 = b[2] * cs1[2] - b[3] * cs1[3], o7 = b[3] * cs1[2] + b[2] * cs1[3];
                        u32x4 w; w.x = cvt_pk_bf16(o0 * sc, o1 * sc); w.y = cvt_pk_bf16(o2 * sc, o3 * sc); w.z = cvt_pk_bf16(o4 * sc, o5 * sc); w.w = cvt_pk_bf16(o6 * sc, o7 * sc);
                        *(u32x4*)(base + ((size_t)row * ld + col) * 2) = w;
                    }
                    asm volatile("" ::: "memory");
                }
        } else {
            const bool isg = u.pn < 20, isv = (u.pn >= 28 && u.pn < 32);
            const int colt = (u.pn - (isg ? 16 : (isv ? 28 : 32))) * BM + wc * 32 + 8 * fq;
            unsigned char* base = ws + (isg ? (WS_GQ + gq_half) : (isv ? WS_VA : WS_GA)); const int ld = isg ? 2048 : 1024;
#pragma unroll
            for (int ai = 0; ai < 2; ++ai)
#pragma unroll
                for (int m = 0; m < 4; ++m) {
                    const int row = rowb + ai * HALF + m * 16;
#pragma unroll
                    for (int bj = 0; bj < 2; ++bj) {
                        f32x4 a = acc[ai][bj][m][0], b = acc[ai][bj][m][1];
                        if (!isv) {
#pragma unroll
                            for (int e = 0; e < 4; ++e) { a[e] = fsilu(a[e]); b[e] = fsilu(b[e]); }
                        }
                        u32x4 w; w.x = cvt_pk_bf16(a[0], a[1]); w.y = cvt_pk_bf16(a[2], a[3]); w.z = cvt_pk_bf16(b[0], b[1]); w.w = cvt_pk_bf16(b[2], b[3]);
                        *(u32x4*)(base + ((size_t)row * ld + colt + bj * HALF) * 2) = w;
                    }
                    asm volatile("" ::: "memory");
                }
        }
    }
};
struct EpiOut {
    static constexpr bool PERM = false, AFTER_DRAIN = false;
    const float* hin; float* hout;
    __device__ __forceinline__ void operator()(const f32x4 (&acc)[2][2][4][2], const Unit& u, int wr, int wc, int fr, int fq) const {
        const int rowb = u.pm * BM + wr * 64 + fr, colb = u.pn * BM + wc * 32 + 4 * fq;
#pragma unroll
        for (int ai = 0; ai < 2; ++ai)
#pragma unroll
            for (int m = 0; m < 4; ++m) {
                const size_t ro = (size_t)(rowb + ai * HALF + m * 16) * 1024;
#pragma unroll
                for (int bj = 0; bj < 2; ++bj)
#pragma unroll
                    for (int n = 0; n < 2; ++n) {
                        const size_t o = ro + colb + bj * HALF + n * 16;
                        const f32x4 hv = *(const f32x4*)(hin + o);
                        *(f32x4*)(hout + o) = hv + acc[ai][bj][m][n];
                    }
            }
    }
};
struct OrderIn : StaticOrder { __device__ __forceinline__ size_t arow(int pm) const { return (size_t)pm * BM; } };
struct OrderOut : StaticOrder { __device__ __forceinline__ size_t arow(int pm) const { return (size_t)(pm >> 5) * 8448 + (size_t)(pm & 31) * BM; } };

template <class Epi, class Sched, bool ALIGN_EPI = false, bool SP2 = false>
__device__ __forceinline__ void gemm_phase(PG8_LAS unsigned char* lds, const Gemm g, const Sched& S, const Epi& E) {
    int tid_l = threadIdx.x; asm volatile("; LAUNDER" : "+v"(tid_l));
    const int tid = tid_l, wid = __builtin_amdgcn_readfirstlane(tid >> 6), lane = tid & 63, wr = wid >> 2, wc = wid & 3, fr = lane & 15, fq = lane >> 4;
    const int K = g.K, nt = K / BK;
    unsigned voffA[2], voffB[2];
#pragma unroll
    for (int i = 0; i < 2; ++i) { int R, C; stage_rc(tid * 16 + i * 8192, R, C); const int Rb = Epi::PERM ? ((R & ~31) + perm32(R & 31)) : R;
        voffA[i] = (unsigned)(R * K + C) * 2u; voffB[i] = (unsigned)(Rb * K + C) * 2u; }
    const size_t kstep = (size_t)(BK * 2);
    const size_t hstep = (size_t)HALF * K * 2;
    const size_t tstep = 2 * hstep;
    const unsigned ldsw = (unsigned)wid * 1024u;
    const int aoff = lds_byte(wr * 64 + fr, fq * 8), boff = lds_byte(wc * 32 + fr, fq * 8);
#define PG8_SA(b, h) (((b) * 2 + (h)) * HTB)
#define PG8_SB(b, h) ((4 + (b) * 2 + (h)) * HTB)
#define PG8_STAGE(bufoff, gbase, voff) do { _Pragma("unroll") for (int _i = 0; _i < 2; ++_i) \
        __builtin_amdgcn_global_load_lds((const unsigned*)((const char*)(gbase) + (voff)[_i]), (PG8_LAS unsigned*)(lds + (bufoff) + ldsw + _i * 8192), 16, 0, 0); } while (0)
#define PG8_LDA(dst, b, h) do { _Pragma("unroll") for (int m = 0; m < 4; ++m) _Pragma("unroll") for (int k = 0; k < 2; ++k) dst[m][k] = *(const PG8_LAS bf16x8*)(lds + PG8_SA(b, h) + aoff + m * 2048 + k * 1024); } while (0)
#define PG8_LDB(dst, b, h) do { _Pragma("unroll") for (int n = 0; n < 2; ++n) _Pragma("unroll") for (int k = 0; k < 2; ++k) dst[n][k] = *(const PG8_LAS bf16x8*)(lds + PG8_SB(b, h) + boff + n * 2048 + k * 1024); } while (0)
#define PG8_MMA(ai, bj, At, Bt) do { __builtin_amdgcn_s_setprio(1); _Pragma("unroll") for (int m = 0; m < 4; ++m) _Pragma("unroll") for (int n = 0; n < 2; ++n) _Pragma("unroll") for (int k = 0; k < 2; ++k) \
        acc[ai][bj][m][n] = __builtin_amdgcn_mfma_f32_16x16x32_bf16(Bt[n][k], At[m][k], acc[ai][bj][m][n], 0, 0, 0); __builtin_amdgcn_s_setprio(0); } while (0)
#define PG8_WAIT_V(n) asm volatile("s_waitcnt vmcnt(" #n ")" ::: "memory")
#define PG8_WAIT_L(n) asm volatile("s_waitcnt lgkmcnt(" #n ")" ::: "memory")
#define PG8_BAR __builtin_amdgcn_s_barrier()
#define PG8_SCHED __builtin_amdgcn_sched_barrier(0)
    Unit cur, nxt; int ui = 0;
    if (!S.next(0, cur)) return;
    f32x4 acc[2][2][4][2];
#pragma unroll
    for (int a = 0; a < 2; ++a)
#pragma unroll
        for (int b = 0; b < 2; ++b)
#pragma unroll
            for (int m = 0; m < 4; ++m)
#pragma unroll
                for (int n = 0; n < 2; ++n) acc[a][b][m][n] = (f32x4){0.f, 0.f, 0.f, 0.f};
    bf16x8 At[4][2], B0[2][2], B1[2][2];
    const char* cA = (const char*)g.A + S.arow(cur.pm) * (size_t)(K * 2); const char* cB = (const char*)g.Bt + (size_t)cur.pn * tstep;
    S.a_ready(cur);
    if constexpr (SP2) {
        PG8_STAGE(PG8_SB(0, 0), cB, voffB); PG8_STAGE(PG8_SB(0, 1), cB + hstep, voffB); PG8_STAGE(PG8_SA(0, 0), cA, voffA); PG8_STAGE(PG8_SA(0, 1), cA + hstep, voffA);
        if (wr == 1) PG8_BAR;
        PG8_WAIT_V(2); PG8_BAR;
        PG8_STAGE(PG8_SB(1, 0), cB + kstep, voffB); PG8_STAGE(PG8_SA(1, 0), cA + kstep, voffA); PG8_STAGE(PG8_SB(1, 1), cB + hstep + kstep, voffB);
        PG8_WAIT_V(6); PG8_BAR;
    } else {
        PG8_STAGE(PG8_SB(0, 0), cB, voffB); PG8_STAGE(PG8_SA(0, 0), cA, voffA); PG8_STAGE(PG8_SB(0, 1), cB + hstep, voffB); PG8_STAGE(PG8_SA(0, 1), cA + hstep, voffA);
        if (wr == 1) PG8_BAR;
        PG8_WAIT_V(4); PG8_BAR;
        PG8_STAGE(PG8_SB(1, 0), cB + kstep, voffB); PG8_STAGE(PG8_SA(1, 0), cA + kstep, voffA); PG8_STAGE(PG8_SB(1, 1), cB + hstep + kstep, voffB);
        PG8_WAIT_V(6); PG8_BAR;
    }
    for (;;) {
        const bool has_next = S.next(ui + 1, nxt);
        const char* nA = has_next ? (const char*)g.A + S.arow(nxt.pm) * (size_t)(K * 2) : cA; const char* nB = has_next ? (const char*)g.Bt + (size_t)nxt.pn * tstep : cB;
        for (int t = 0; t < nt; t += 2) {
            const bool last = (t == nt - 2);
            const char* a1 = cA + (size_t)(t + 1) * kstep;
            const char* a2 = last ? nA : cA + (size_t)(t + 2) * kstep; const char* b2 = last ? nB : cB + (size_t)(t + 2) * kstep;
            const char* a3 = a2 + kstep; const char* b3 = b2 + kstep;
            if (last && has_next) S.a_ready(nxt);
            if constexpr (SP2) {
            PG8_LDB(B0, 0, 0); PG8_LDB(B1, 0, 1); PG8_SCHED; PG8_LDA(At, 0, 0); PG8_STAGE(PG8_SA(1, 1), a1 + hstep, voffA);
            PG8_WAIT_V(8); PG8_WAIT_L(0); PG8_BAR; PG8_MMA(0, 0, At, B0); PG8_MMA(0, 1, At, B1); PG8_BAR; PG8_SCHED;
            PG8_LDA(At, 0, 1); PG8_STAGE(PG8_SB(0, 0), b2, voffB); PG8_STAGE(PG8_SB(0, 1), b2 + hstep, voffB); PG8_STAGE(PG8_SA(0, 0), a2, voffA);
            PG8_WAIT_V(8); PG8_WAIT_L(0); PG8_BAR; PG8_MMA(1, 0, At, B0); PG8_MMA(1, 1, At, B1); PG8_BAR; PG8_SCHED;
            PG8_LDB(B0, 1, 0); PG8_LDB(B1, 1, 1); PG8_SCHED; PG8_LDA(At, 1, 0); PG8_STAGE(PG8_SA(0, 1), a2 + hstep, voffA);
            PG8_WAIT_V(8); PG8_WAIT_L(0); PG8_BAR; PG8_MMA(0, 0, At, B0); PG8_MMA(0, 1, At, B1); PG8_BAR; PG8_SCHED;
            PG8_LDA(At, 1, 1); PG8_STAGE(PG8_SB(1, 0), b3, voffB); PG8_STAGE(PG8_SB(1, 1), b3 + hstep, voffB); PG8_STAGE(PG8_SA(1, 0), a3, voffA);
            PG8_WAIT_V(8); PG8_WAIT_L(0); PG8_BAR; PG8_MMA(1, 0, At, B0); PG8_MMA(1, 1, At, B1); PG8_BAR; PG8_SCHED;
            } else {
            PG8_LDB(B0, 0, 0); PG8_SCHED; PG8_LDA(At, 0, 0); PG8_STAGE(PG8_SA(1, 1), a1 + hstep, voffA);
            PG8_WAIT_L(8); PG8_BAR; PG8_WAIT_L(0); PG8_MMA(0, 0, At, B0); PG8_BAR; PG8_SCHED;
            PG8_LDB(B1, 0, 1); PG8_STAGE(PG8_SB(0, 0), b2, voffB);
            PG8_BAR; PG8_WAIT_L(0); PG8_MMA(0, 1, At, B1); PG8_BAR;
            PG8_LDA(At, 0, 1); PG8_STAGE(PG8_SA(0, 0), a2, voffA);
            PG8_BAR; PG8_WAIT_L(0); PG8_MMA(1, 0, At, B0); PG8_BAR; PG8_SCHED;
            PG8_STAGE(PG8_SB(0, 1), b2 + hstep, voffB);
            PG8_WAIT_V(6); PG8_BAR; PG8_MMA(1, 1, At, B1); PG8_BAR;
            PG8_LDB(B0, 1, 0); PG8_SCHED; PG8_LDA(At, 1, 0); PG8_STAGE(PG8_SA(0, 1), a2 + hstep, voffA);
            PG8_WAIT_L(8); PG8_BAR; PG8_WAIT_L(0); PG8_MMA(0, 0, At, B0); PG8_BAR; PG8_SCHED;
            PG8_LDB(B1, 1, 1); PG8_STAGE(PG8_SB(1, 0), b3, voffB);
            PG8_BAR; PG8_WAIT_L(0); PG8_MMA(0, 1, At, B1); PG8_BAR;
            PG8_LDA(At, 1, 1); PG8_STAGE(PG8_SA(1, 0), a3, voffA);
            PG8_BAR; PG8_WAIT_L(0); PG8_MMA(1, 0, At, B0); PG8_BAR; PG8_SCHED;
            PG8_STAGE(PG8_SB(1, 1), b3 + hstep, voffB);
            PG8_WAIT_V(6); PG8_BAR; PG8_MMA(1, 1, At, B1); PG8_BAR;
            }
        }
        if constexpr (ALIGN_EPI) { if (wr == 0) PG8_BAR; }
        if constexpr (!Epi::AFTER_DRAIN) { E(acc, cur, wr, wc, fr, fq); S.done(cur); }
        if (!has_next) break;
#pragma unroll
        for (int a = 0; a < 2; ++a)
#pragma unroll
            for (int b = 0; b < 2; ++b)
#pragma unroll
                for (int m = 0; m < 4; ++m)
#pragma unroll
                    for (int n = 0; n < 2; ++n) acc[a][b][m][n] = (f32x4){0.f, 0.f, 0.f, 0.f};
        cur = nxt; cA = nA; cB = nB; ++ui;
        if constexpr (ALIGN_EPI) { if (wr == 1) PG8_BAR; }
    }
    PG8_WAIT_V(0);
    if constexpr (!ALIGN_EPI) { if (wr == 0) PG8_BAR; }
    PG8_BAR;
    if constexpr (Epi::AFTER_DRAIN) { E.fused(acc, cur, wr, wc, fr, fq, lds, wid, lane); S.done(cur); }
#undef PG8_SA
#undef PG8_SB
#undef PG8_STAGE
#undef PG8_LDA
#undef PG8_LDB
#undef PG8_MMA
#undef PG8_WAIT_V
#undef PG8_WAIT_L
#undef PG8_BAR
#undef PG8_SCHED
}
}

#define GAS __attribute__((address_space(1)))
#define LAS __attribute__((address_space(3)))
typedef unsigned short bf16;
typedef unsigned v4u __attribute__((ext_vector_type(4)));
typedef float f32x4 __attribute__((ext_vector_type(4)));
typedef short bf16x8 __attribute__((ext_vector_type(8)));
typedef GAS unsigned gu32;
typedef GAS unsigned long long gu64;
#define RLX_AGENT __ATOMIC_RELAXED, __HIP_MEMORY_SCOPE_AGENT
#define LDS_WAIT() asm volatile("s_waitcnt lgkmcnt(0)" ::: "memory")
#define VM_WAIT() asm volatile("s_waitcnt vmcnt(0)" ::: "memory")
__device__ __forceinline__ unsigned long long rt() { return __builtin_amdgcn_s_memrealtime(); }
__device__ __forceinline__ unsigned f2bf(float f) { unsigned u = __builtin_bit_cast(unsigned, f); return (u + 0x7fffu + ((u >> 16) & 1u)) >> 16; }
__device__ __forceinline__ unsigned pk2(float lo, float hi) { return f2bf(lo) | (f2bf(hi) << 16); }

#define XB_TMO      128
#define XB_XCNT(j)  (256  + 64 * (j))
#define XB_XSUB(j)  (1280 + 64 * (j))
#define XB_XGEN(j)  (2304 + 64 * (j))
#define XB_TOP      3328
#define XB_TOPGEN   3392
#define XCD_BAR_WORDS 3456
#define XB_SPIN_CAP (1u << 18)

__device__ __forceinline__ unsigned xb_ld(unsigned* p)              { return __hip_atomic_load(p, __ATOMIC_RELAXED, __HIP_MEMORY_SCOPE_AGENT); }
__device__ __forceinline__ unsigned xb_add(unsigned* p, unsigned v) { return __hip_atomic_fetch_add(p, v, __ATOMIC_RELAXED, __HIP_MEMORY_SCOPE_AGENT); }
__device__ __forceinline__ unsigned xb_xcc_id() { return (unsigned)__builtin_amdgcn_s_getreg((3 << 11) | 20) & 0xFu; }
#define XB_SPIN(cond, bar) do { unsigned _sp = 0; while (cond) { __builtin_amdgcn_s_sleep(1); \
    if ((++_sp & 255u) == 0u) { if (xb_ld(&(bar)[XB_TMO])) break; if (_sp > XB_SPIN_CAP) { atomicAdd(&(bar)[XB_TMO], 1u); break; } } } } while (0)

struct XcdBarrier {
    unsigned* bar; unsigned x;
    volatile LAS unsigned* st;
};

__device__ __forceinline__ XcdBarrier xcd_barrier_post(unsigned* bar, volatile LAS unsigned* st) {
    XcdBarrier b; b.bar = bar; b.x = xb_xcc_id(); b.st = st;
    if (threadIdx.x == 0) (void)xb_add(&bar[XB_XCNT(b.x)], 1u);
    return b;
}
__device__ __forceinline__ void xcd_barrier_complete(unsigned* bar, unsigned x, unsigned& nloc, unsigned& nx) {
    const unsigned G = gridDim.x * gridDim.y * gridDim.z;
    unsigned sum, cnt, mine, sp = 0u;
    for (;;) {
        sum = 0u; cnt = 0u; mine = 0u;
#pragma unroll
        for (unsigned j = 0; j < 16; ++j) { const unsigned c = xb_ld(&bar[XB_XCNT(j)]); sum += c; cnt += (c > 0u) ? 1u : 0u; mine = (j == x) ? c : mine; }
        if (sum == G) break;
        __builtin_amdgcn_s_sleep(1);
        if ((++sp & 255u) == 0u) { if (xb_ld(&bar[XB_TMO])) break; if (sp > XB_SPIN_CAP) { atomicAdd(&bar[XB_TMO], 1u); break; } }
    }
    nloc = mine > 0u ? mine : 1u; nx = cnt > 0u ? cnt : 1u;
}

__device__ __forceinline__ void xcd_barrier(const XcdBarrier& b) {
    asm volatile("s_waitcnt vmcnt(0)" ::: "memory");
    __syncthreads();
    if (threadIdx.x == 0) {
        unsigned* bar = b.bar;
        __builtin_amdgcn_s_waitcnt(0);
        unsigned nloc = b.st[0], nx = b.st[1];
        if (nloc == 0u) { xcd_barrier_complete(bar, b.x, nloc, nx); b.st[0] = nloc; b.st[1] = nx; }
        const unsigned old = xb_add(&bar[XB_XSUB(b.x)], 1u);
        const unsigned gen = old / nloc;
        if (old + 1u == (gen + 1u) * nloc) {
            __builtin_amdgcn_fence(__ATOMIC_RELEASE, "agent");
            asm volatile("s_waitcnt vmcnt(0)" ::: "memory");
            const unsigned og = xb_add(&bar[XB_TOP], 1u);
            const unsigned tg = og / nx;
            if (og + 1u == (tg + 1u) * nx) xb_add(&bar[XB_TOPGEN], 1u);
            else XB_SPIN(xb_ld(&bar[XB_TOPGEN]) == tg, bar);
            __builtin_amdgcn_fence(__ATOMIC_ACQUIRE, "agent");
            xb_add(&bar[XB_XGEN(b.x)], 1u);
            asm volatile("s_waitcnt vmcnt(0)" ::: "memory");
        } else {
            XB_SPIN(xb_ld(&bar[XB_XGEN(b.x)]) == gen, bar);
            __builtin_amdgcn_fence(__ATOMIC_ACQUIRE, "agent");
            asm volatile("s_waitcnt vmcnt(0)" ::: "memory");
        }
    }
    __syncthreads();
}

typedef short s16x4 __attribute__((ext_vector_type(4)));
typedef float f32x16 __attribute__((ext_vector_type(16)));
typedef unsigned u32x2v __attribute__((ext_vector_type(2)));
__device__ __forceinline__ unsigned cvtpk(float lo, float hi) { typedef float f2_t __attribute__((ext_vector_type(2))); typedef __bf16 b2_t __attribute__((ext_vector_type(2)));
    const f2_t v = {lo, hi}; const b2_t b = __builtin_convertvector(v, b2_t); return __builtin_bit_cast(unsigned, b); }
__device__ __forceinline__ float bf2f(unsigned short v) { return __uint_as_float((unsigned)v << 16); }
__device__ __forceinline__ float bflo(unsigned w) { return __uint_as_float(w << 16); }
__device__ __forceinline__ float bfhi(unsigned w) { return __uint_as_float(w & 0xffff0000u); }
__device__ __forceinline__ float wave_sum(float v) {
#pragma unroll
    for (int o = 1; o < 64; o <<= 1) v += __shfl_xor(v, o);
    return v;
}
__device__ __forceinline__ float sum16(float v) {
#pragma unroll
    for (int o = 1; o < 16; o <<= 1) v += __shfl_xor(v, o);
    return v;
}
__device__ __forceinline__ float sum32(float v) {
#pragma unroll
    for (int o = 1; o < 32; o <<= 1) v += __shfl_xor(v, o);
    return v;
}

struct Args { const float* in[10]; float* out; unsigned char* ws; int ph_lo, ph_hi, li, pad; };
struct Frame {
    LAS unsigned char* lds; volatile LAS unsigned* MISC; gu32* ctl; int tid, lane, wave, G, bid;
    const Args* A;
    float* out; unsigned char* ws;
};

__device__ __forceinline__ int fresh_tid() { int t = threadIdx.x; asm volatile("; LAUNDER" : "+v"(t)); return t; }
__device__ __forceinline__ int dst_col(int c) {
    const int g = c >> 10, j = c & 1023;
    if (g < 4) { const int th = j >> 6, cc = j & 63, wc = cc >> 4, fq = (cc >> 2) & 3, e = cc & 3, bj = g >> 1, n = g & 1; return 256 * th + 128 * bj + 32 * wc + 8 * fq + 4 * n + e; }
    if (g == 5 || g == 6) { const int d = j & 63, i = d & 31, hf = d >> 5; return g * 1024 + (j & ~63) + 2 * i + hf; }
    return c;
}
template <bool PERMUTE>
__device__ __forceinline__ void p0_transpose_item(const float* W, int K, int N, bf16* WT, LAS float* scr, int item, int lane) {
    const int nblk = N / 32, kb = item / nblk, nb = item % nblk, k0 = 64 * kb, n0 = 32 * nb;
#pragma unroll 8
    for (int i = 0; i < 32; ++i) { const int kk = 2 * i + (lane >> 5); scr[kk * 33 + (lane & 31)] = W[(size_t)(k0 + kk) * N + n0 + (lane & 31)]; }
    LDS_WAIT(); asm volatile("" ::: "memory");
    const int c = lane & 7;
#pragma unroll
    for (int j = 0; j < 4; ++j) { const int n = (lane >> 3) + 8 * j; const LAS float* s = scr + (8 * c) * 33 + n;
        v4u o; o.x = pk2(s[0 * 33], s[1 * 33]); o.y = pk2(s[2 * 33], s[3 * 33]); o.z = pk2(s[4 * 33], s[5 * 33]); o.w = pk2(s[6 * 33], s[7 * 33]);
        const int drow = PERMUTE ? dst_col(n0 + n) : (n0 + n);
        *(GAS v4u*)(WT + (size_t)drow * K + k0 + 8 * c) = o; }
    LDS_WAIT(); asm volatile("" ::: "memory");
}
__device__ __forceinline__ void norm_row_to_bf16(int lane, const float* xrow, const float* g, bf16* orow, int ncopy, size_t cstride) {
    const GAS f32x4* xr = (const GAS f32x4*)xrow + lane; const GAS f32x4* gr = (const GAS f32x4*)g + lane;
    f32x4 v[4]; float s = 0.f;
#pragma unroll
    for (int j = 0; j < 4; ++j) { v[j] = xr[64 * j]; s += (v[j].x * v[j].x + v[j].y * v[j].y) + (v[j].z * v[j].z + v[j].w * v[j].w); }
    const float rs = 1.0f / sqrtf(wave_sum(s) * (1.0f / DM) + NEPS);
    unsigned long long w[4];
#pragma unroll
    for (int j = 0; j < 4; ++j) { const f32x4 gg = gr[64 * j]; w[j] = (unsigned long long)pk2(v[j].x * rs * gg.x, v[j].y * rs * gg.y) | ((unsigned long long)pk2(v[j].z * rs * gg.z, v[j].w * rs * gg.w) << 32); }
    for (int c = 0; c < ncopy; ++c) { GAS unsigned long long* o8 = (GAS unsigned long long*)(orow + (size_t)c * cstride) + lane;
#pragma unroll
        for (int j = 0; j < 4; ++j) o8[64 * j] = w[j]; }
}
__device__ __forceinline__ void p0_prologue(Frame& F) {
    const int tid = fresh_tid(), lane = tid & 63, wave = __builtin_amdgcn_readfirstlane(tid >> 6);
    LAS float* scr = (LAS float*)(F.lds + wave * 16384);
    const int gw = F.bid * NWAVES + wave, NGW = F.G * NWAVES;
    constexpr int I_IN = (DM / 64) * (INW / 32), I_OUT = (2048 / 64) * (DM / 32);
    constexpr int NITEMS = 2 * (I_IN + I_OUT);
    bf16* win = (bf16*)(F.ws + WS_WIN); bf16* wout = (bf16*)(F.ws + WS_WOUT);
    for (int it = gw; it < NITEMS; it += NGW) {
        int r = it; const int l = r / (I_IN + I_OUT); r -= l * (I_IN + I_OUT);
        if (r < I_IN) p0_transpose_item<true>(F.A->in[3] + (size_t)l * DM * INW, DM, INW, win + (size_t)l * INW * DM, scr, r, lane);
        else p0_transpose_item<false>(F.A->in[8] + (size_t)l * 2048 * DM, 2048, DM, wout + (size_t)l * DM * 2048, scr, r - I_IN, lane);
    }
    { float* rope = (float*)(F.ws + WS_ROPE);
      for (int idx = F.bid * NTHREADS + tid; idx < LTOK * 32; idx += F.G * NTHREADS) { const int t = idx >> 5, i = idx & 31;
          const float inv = powf(10000.0f, -(float)(2 * i) / 64.0f), ang = (float)t * inv; rope[2 * idx] = cosf(ang); rope[2 * idx + 1] = sinf(ang); } }
    bf16* U = (bf16*)(F.ws + WS_U);
    for (int m = gw; m < NBATCH * SEQ + NMETA; m += NGW) {
        if (m < NBATCH * SEQ) { const int half = m >> 13; norm_row_to_bf16(lane, F.A->in[0] + (size_t)m * DM, F.A->in[2], U + ((size_t)m + half * 256) * DM, 1, 0); }
        else { const int j = m - NBATCH * SEQ;
            norm_row_to_bf16(lane, F.A->in[1] + (size_t)j * DM, F.A->in[2], U + ((size_t)8192 + j) * DM, 4, (size_t)16 * DM);
            norm_row_to_bf16(lane, F.A->in[1] + (size_t)j * DM, F.A->in[2], U + ((size_t)HROWS + 8192 + j) * DM, 4, (size_t)16 * DM); }
    }
}

constexpr int SC_PITCH = 272;
constexpr int SC_TILE = 16 * SC_PITCH;
constexpr int SC_DEC = 6 * SC_TILE;
constexpr int SC_BUF = SC_DEC + 1024;
__device__ __forceinline__ s16x4 tr16(const LAS unsigned char* p) {
    typedef short v4i16_t __attribute__((ext_vector_type(4)));
    return __builtin_bit_cast(s16x4, __builtin_amdgcn_ds_read_tr16_b64_v4i16((LAS v4i16_t*)p));
}
__device__ __forceinline__ int scan_rowbase(int bl, int c) { return c == 0 ? 8192 + bl * 16 : bl * 2048 + 16 * (c - 1); }
struct ScanSet { bf16x8 a, b, c; f32x4 d; };

__device__ __forceinline__ void hgrn_scan_item(Frame& F, size_t gq_half, int bl, int hd, int layer, bool dry = false) {
    int tid_l = F.tid; asm volatile("; LAUNDER" : "+v"(tid_l));
    const int tid = tid_l, lane = tid & 63, wave = __builtin_amdgcn_readfirstlane(tid >> 6), dir = wave >> 2, vs = wave & 3, g = lane >> 4, i16 = lane & 15;
    LAS unsigned char* lds = F.lds;
    unsigned char* const ws = F.ws;
    bf16* QD = (bf16*)(ws + (dir == 0 ? WS_QDF : WS_QDB));
    const int hcol = hd * 128;
    const int sd = tid >> 8, s_row = (tid & 255) >> 4, s_c16 = tid & 15;
    const bf16* srcQ = (const bf16*)(ws + (sd == 0 ? WS_QDF : WS_QDB)) + hcol + s_c16 * 8;
    const bf16* srcK = (const bf16*)(ws + (sd == 0 ? WS_KTF : WS_KTB)) + hcol + s_c16 * 8;
    const bf16* srcV = (const bf16*)(ws + WS_VH) + hcol + s_c16 * 8;
    const bool s_dec = (tid & 255) < 32;
    const float* srcD = (const float*)(ws + (sd == 0 ? WS_DECF : WS_DECB)) + hcol + (tid & 31) * 4;
    const int s_off = sd * SC_TILE + s_row * SC_PITCH + s_c16 * 16;
    const int s_doff = SC_DEC + sd * 512 + (tid & 31) * 16;
#define SC_LOAD(SET, step) do { const int c_ = sd == 0 ? (step) : 128 - (step); const int rb_ = scan_rowbase(bl, c_); const size_t ro_ = (size_t)(rb_ + s_row) * 1024; \
        SET.a = *(const GAS bf16x8*)(srcQ + ro_); SET.b = *(const GAS bf16x8*)(srcK + ro_); SET.c = *(const GAS bf16x8*)(srcV + ro_); \
        if (s_dec) SET.d = *(const GAS f32x4*)(srcD + (size_t)(rb_ >> 4) * 1024); } while (0)
#define SC_WRITE(SET, buf) do { LAS unsigned char* b_ = lds + (buf) * SC_BUF; *(LAS bf16x8*)(b_ + s_off) = SET.a; *(LAS bf16x8*)(b_ + 2 * SC_TILE + s_off) = SET.b; \
        *(LAS bf16x8*)(b_ + 4 * SC_TILE + s_off) = SET.c; if (s_dec) *(LAS f32x4*)(b_ + s_doff) = SET.d; } while (0)
    f32x4 S[8][2];
#pragma unroll
    for (int kb = 0; kb < 8; ++kb) { S[kb][0] = (f32x4){0.f, 0.f, 0.f, 0.f}; S[kb][1] = (f32x4){0.f, 0.f, 0.f, 0.f}; }
    const int o_frag = i16 * SC_PITCH + 8 * g;
    const int o_tr = (4 * g + (i16 >> 2)) * SC_PITCH + (i16 & 3) * 8;
#define SC_STEP(step, LOADSET, NEXT) do { \
        const int buf = (step) & 1; const int c = dir == 0 ? (step) : 128 - (step); const int rowb = scan_rowbase(bl, c); \
        if ((step) + 3 < 129) SC_LOAD(LOADSET, (step) + 3); \
        const LAS unsigned char* B = lds + buf * SC_BUF; \
        bf16x8 cqd[4], ckt[4]; \
        _Pragma("unroll") for (int kk = 0; kk < 4; ++kk) { \
            const u32x2v a0 = *(const LAS u32x2v*)(B + dir * SC_TILE + o_frag + 64 * kk), a1 = *(const LAS u32x2v*)(B + dir * SC_TILE + o_frag + 64 * kk + 32); \
            const u32x2v b0 = *(const LAS u32x2v*)(B + (2 + dir) * SC_TILE + o_frag + 64 * kk), b1 = *(const LAS u32x2v*)(B + (2 + dir) * SC_TILE + o_frag + 64 * kk + 32); \
            cqd[kk] = __builtin_bit_cast(bf16x8, (v4u){a0.x, a0.y, a1.x, a1.y}); ckt[kk] = __builtin_bit_cast(bf16x8, (v4u){b0.x, b0.y, b1.x, b1.y}); } \
        s16x4 ktT[8], vfr[2]; \
        _Pragma("unroll") for (int kb = 0; kb < 8; ++kb) ktT[kb] = tr16(B + (2 + dir) * SC_TILE + o_tr + kb * 32); \
        vfr[0] = tr16(B + (4 + dir) * SC_TILE + o_tr + vs * 64); vfr[1] = tr16(B + (4 + dir) * SC_TILE + o_tr + vs * 64 + 32); \
          \
        f32x4 at = (f32x4){0.f, 0.f, 0.f, 0.f}; \
        _Pragma("unroll") for (int kk = 0; kk < 4; ++kk) at = __builtin_amdgcn_mfma_f32_16x16x32_bf16(ckt[kk], cqd[kk], at, 0, 0, 0); \
        _Pragma("unroll") for (int r = 0; r < 4; ++r) { const int s_ = 4 * g + r; const bool keep = dir == 0 ? (s_ <= i16) : (s_ >= i16); at[r] = keep ? at[r] : 0.f; } \
        const s16x4 pfr = __builtin_bit_cast(s16x4, (u32x2v){cvtpk(at[0], at[1]), cvtpk(at[2], at[3])}); \
          \
        f32x4 o[2]; \
        _Pragma("unroll") for (int nt = 0; nt < 2; ++nt) { \
            const f32x4 oi = __builtin_amdgcn_mfma_f32_16x16x16bf16_1k(pfr, vfr[nt], (f32x4){0.f, 0.f, 0.f, 0.f}, 0, 0, 0); \
            f32x4 oe = (f32x4){0.f, 0.f, 0.f, 0.f}; \
            _Pragma("unroll") for (int kk = 0; kk < 4; ++kk) { \
                const f32x4 s0 = S[2 * kk][nt], s1 = S[2 * kk + 1][nt]; \
                const bf16x8 sb = __builtin_bit_cast(bf16x8, (v4u){cvtpk(s0[0], s0[1]), cvtpk(s0[2], s0[3]), cvtpk(s1[0], s1[1]), cvtpk(s1[2], s1[3])}); \
                oe = __builtin_amdgcn_mfma_f32_16x16x32_bf16(cqd[kk], sb, oe, 0, 0, 0); } \
            o[nt] = oi + oe; } \
          \
        _Pragma("unroll") for (int kb = 0; kb < 8; ++kb) { const f32x4 dec = *(const LAS f32x4*)(B + SC_DEC + dir * 512 + (16 * kb + 4 * g) * 4); \
            _Pragma("unroll") for (int nt = 0; nt < 2; ++nt) { S[kb][nt] = __builtin_amdgcn_mfma_f32_16x16x16bf16_1k(ktT[kb], vfr[nt], S[kb][nt], 0, 0, 0); S[kb][nt] = S[kb][nt] * dec; } } \
          \
        if (!(layer == 1 && c == 0) && !dry) { \
            _Pragma("unroll") for (int nt = 0; nt < 2; ++nt) _Pragma("unroll") for (int r = 0; r < 4; ++r) \
                QD[(size_t)(rowb + 4 * g + r) * 1024 + hcol + 32 * vs + 16 * nt + i16] = (bf16)(cvtpk(o[nt][r], 0.f) & 0xffffu); } \
        if ((step) + 1 < 129) SC_WRITE(NEXT, buf ^ 1); \
        __syncthreads(); } while (0)
    ScanSet R0, R1, R2;
    SC_LOAD(R0, 0); SC_LOAD(R1, 1); SC_LOAD(R2, 2);
    SC_WRITE(R0, 0);
    __syncthreads();
#pragma unroll 1
    for (int st = 0; st < 129; st += 3) {
        SC_STEP(st, R0, R1);
        SC_STEP(st + 1, R1, R2);
        SC_STEP(st + 2, R2, R0);
    }
#undef SC_LOAD
#undef SC_WRITE
#undef SC_STEP
#ifdef DBG_NOFINAL
    return;
#endif
    asm volatile("s_waitcnt vmcnt(0)" ::: "memory");
    __syncthreads();
    __builtin_amdgcn_fence(__ATOMIC_ACQUIRE, "agent");
    asm volatile("s_waitcnt vmcnt(0)" ::: "memory");
    __syncthreads();
    const float* gn = F.A->in[5] + layer * 128 + 8 * i16;
    const f32x4 g0 = *(const GAS f32x4*)gn, g1 = *(const GAS f32x4*)(gn + 4);
    const int ntok = layer == 1 ? SEQ : LTOK;
    for (int tk = wave * 4 + g; tk < ntok; tk += NWAVES * 4) {
        const int row = tk < SEQ ? bl * 2048 + tk : 8192 + bl * 16 + (tk - SEQ);
        const size_t ro = (size_t)row * 1024 + hcol + 8 * i16;
        const v4u a = *(const GAS v4u*)((const bf16*)(ws + WS_QDF) + ro), b = *(const GAS v4u*)((const bf16*)(ws + WS_QDB) + ro);
        float v[8];
        v[0] = bflo(a.x) + bflo(b.x); v[1] = bfhi(a.x) + bfhi(b.x); v[2] = bflo(a.y) + bflo(b.y); v[3] = bfhi(a.y) + bfhi(b.y);
        v[4] = bflo(a.z) + bflo(b.z); v[5] = bfhi(a.z) + bfhi(b.z); v[6] = bflo(a.w) + bflo(b.w); v[7] = bfhi(a.w) + bfhi(b.w);
        float ss = 0.f;
#pragma unroll
        for (int e = 0; e < 8; ++e) ss += v[e] * v[e];
        ss = sum16(ss);
        const float rs = 1.0f / sqrtf(ss * (1.0f / 128.0f) + NEPS);
        bf16* gp = (bf16*)(ws + WS_GQ + gq_half) + (size_t)row * 2048 + hcol + 8 * i16;
        const v4u gt = *(const GAS v4u*)gp;
        v4u w;
        w.x = cvtpk(v[0] * rs * g0[0] * bflo(gt.x), v[1] * rs * g0[1] * bfhi(gt.x)); w.y = cvtpk(v[2] * rs * g0[2] * bflo(gt.y), v[3] * rs * g0[3] * bfhi(gt.y));
        w.z = cvtpk(v[4] * rs * g1[0] * bflo(gt.z), v[5] * rs * g1[1] * bfhi(gt.z)); w.w = cvtpk(v[6] * rs * g1[2] * bflo(gt.w), v[7] * rs * g1[3] * bfhi(gt.w));
        if (!dry) *(GAS v4u*)gp = w;
    }
}

constexpr int AT_SHM_V = 64 * 128 * 2, AT_SHM_K = 64 * 128 * 2;
constexpr float AT_THR2 = 11.5f;
#define KSWZ(row, colB) ((row) * 256 + ((colB) ^ (((row) & 7) << 4)))
#define SBAR() __builtin_amdgcn_sched_barrier(0)
__device__ __forceinline__ int crow(int r, int hi) { return (r & 3) + 8 * (r >> 2) + 4 * hi; }
__device__ __forceinline__ int v_st(int k, int c) { const int kk = (k & ~0xC) | ((k & 4) << 1) | ((k & 8) >> 1); return ((kk >> 3) * 4 + (c >> 5)) * 512 + ((kk & 7) * 32 + (c & 31)) * 2; }
__device__ __forceinline__ int v_rd_base(int lane) { return ((lane & 3) << 3) | (((lane >> 2) & 3) << 6) | (((lane >> 4) & 1) << 5) | (((lane >> 5) & 1) << 8); }
constexpr int v_rd_off(int d0, int ks, int half) { return d0 * 512 + ks * 4096 + half * 2048; }
template <int OFF> __device__ __forceinline__ s16x4 tr_read(int vb) {
    s16x4 r; asm volatile("ds_read_b64_tr_b16 %0, %1 offset:%2" : "=&v"(r) : "v"(vb), "i"(OFF) : "memory"); return r;
}
template <int D0> __device__ __forceinline__ void pv_one(f32x16& od, int vb, bf16x8 pa0, bf16x8 pa1, bf16x8 pa2, bf16x8 pa3) {
    const s16x4 l0 = tr_read<v_rd_off(D0, 0, 0)>(vb), h0 = tr_read<v_rd_off(D0, 0, 1)>(vb), l1 = tr_read<v_rd_off(D0, 1, 0)>(vb), h1 = tr_read<v_rd_off(D0, 1, 1)>(vb);
    const s16x4 l2 = tr_read<v_rd_off(D0, 2, 0)>(vb), h2 = tr_read<v_rd_off(D0, 2, 1)>(vb), l3 = tr_read<v_rd_off(D0, 3, 0)>(vb), h3 = tr_read<v_rd_off(D0, 3, 1)>(vb);
    asm volatile("s_waitcnt lgkmcnt(0)" ::: "memory"); SBAR();
#define PK(L, H) (bf16x8){L[0], L[1], L[2], L[3], H[0], H[1], H[2], H[3]}
    od = __builtin_amdgcn_mfma_f32_32x32x16_bf16(pa0, PK(l0, h0), od, 0, 0, 0);
    od = __builtin_amdgcn_mfma_f32_32x32x16_bf16(pa1, PK(l1, h1), od, 0, 0, 0);
    od = __builtin_amdgcn_mfma_f32_32x32x16_bf16(pa2, PK(l2, h2), od, 0, 0, 0);
    od = __builtin_amdgcn_mfma_f32_32x32x16_bf16(pa3, PK(l3, h3), od, 0, 0, 0);
#undef PK
}
__device__ __forceinline__ void attn_tile(f32x16 (&o)[4], float& m_reg, float& l_reg, const LAS unsigned char* Ks  , int vb, const bf16x8 (&qr)[4], bool meta_tile,
                                          LAS float* al_l, int r32, int hi) {
    f32x16 p0 = {}, p1 = {};
#pragma unroll
    for (int d0 = 0; d0 < 4; ++d0) { const int cb = (d0 * 16 + hi * 8) * 2;
        const bf16x8 b0 = *(const LAS bf16x8*)(Ks + KSWZ(r32, cb));
        const bf16x8 b1 = *(const LAS bf16x8*)(Ks + KSWZ(32 + r32, cb));
        p0 = __builtin_amdgcn_mfma_f32_32x32x16_bf16(b0, qr[d0], p0, 0, 0, 0);
        p1 = __builtin_amdgcn_mfma_f32_32x32x16_bf16(b1, qr[d0], p1, 0, 0, 0); }
    if (meta_tile) {
#pragma unroll
        for (int r = 8; r < 16; ++r) p0[r] = -INFINITY;
#pragma unroll
        for (int r = 0; r < 16; ++r) p1[r] = -INFINITY;
    }
    float pmax = p0[0];
#pragma unroll
    for (int r = 1; r < 16; ++r) pmax = fmaxf(pmax, p0[r]);
#pragma unroll
    for (int r = 0; r < 16; ++r) pmax = fmaxf(pmax, p1[r]);
    { auto rr = __builtin_amdgcn_permlane32_swap(__float_as_uint(pmax), __float_as_uint(pmax), false, false);
      pmax = fmaxf(__uint_as_float(rr[0]), __uint_as_float(rr[1])); }
    float alpha = 1.f;
    if (!__all(pmax - m_reg <= AT_THR2)) { const float mn = fmaxf(m_reg, pmax); alpha = __builtin_amdgcn_exp2f(m_reg - mn); m_reg = mn; }
#pragma unroll
    for (int r = 0; r < 16; ++r) { p0[r] = __builtin_amdgcn_exp2f(p0[r] - m_reg); p1[r] = __builtin_amdgcn_exp2f(p1[r] - m_reg); }
    float ps = 0.f;
#pragma unroll
    for (int r = 0; r < 16; ++r) ps += p0[r];
#pragma unroll
    for (int r = 0; r < 16; ++r) ps += p1[r];
    { auto rr = __builtin_amdgcn_permlane32_swap(__float_as_uint(ps), __float_as_uint(ps), false, false);
      ps = __uint_as_float(rr[0]) + __uint_as_float(rr[1]); }
    l_reg = l_reg * alpha + ps;
    if (__any(alpha < 1.f)) {
        if (hi == 0) al_l[r32] = alpha;
        asm volatile("s_waitcnt lgkmcnt(0)" ::: "memory");
#pragma unroll
        for (int d = 0; d < 4; ++d)
#pragma unroll
            for (int r = 0; r < 16; ++r) o[d][r] *= al_l[crow(r, hi)];
    }
    bf16x8 pa0, pa1, pa2, pa3;
#define PK4(P, BASE, OUT) do { unsigned a0 = cvtpk(P[BASE + 0], P[BASE + 1]), a1 = cvtpk(P[BASE + 2], P[BASE + 3]);   \
    unsigned b0_ = cvtpk(P[BASE + 4], P[BASE + 5]), b1_ = cvtpk(P[BASE + 6], P[BASE + 7]);                              \
    auto r0 = __builtin_amdgcn_permlane32_swap(a0, b0_, false, false); auto r1 = __builtin_amdgcn_permlane32_swap(a1, b1_, false, false); \
    v4u w = {r0[0], r1[0], r0[1], r1[1]}; OUT = __builtin_bit_cast(bf16x8, w); } while (0)
    PK4(p0, 0, pa0); PK4(p0, 8, pa1); PK4(p1, 0, pa2); PK4(p1, 8, pa3);
#undef PK4
    pv_one<0>(o[0], vb, pa0, pa1, pa2, pa3); pv_one<1>(o[1], vb, pa0, pa1, pa2, pa3); pv_one<2>(o[2], vb, pa0, pa1, pa2, pa3); pv_one<3>(o[3], vb, pa0, pa1, pa2, pa3);
}
template <bool METAQ>
__device__ __forceinline__ void attn_item(Frame& F, size_t gq_half, int bl, int hd, int qt, int layer, bool dry = false) {
    int tid_l = F.tid; asm volatile("; LAUNDER" : "+v"(tid_l));
    const int tid = tid_l, wid = __builtin_amdgcn_readfirstlane(tid >> 6), lane = tid & 63, r32 = lane & 31, hi = lane >> 5, rg = wid & 3, cc = wid >> 2;
    LAS unsigned char* lds = F.lds; unsigned char* const ws = F.ws; bf16* const GQ = (bf16*)(ws + WS_GQ + gq_half);
    LAS unsigned char* V_lds = lds; LAS unsigned char* K_lds = lds + 2 * AT_SHM_V;
    LAS float* wsf = (LAS float*)(lds + 2 * AT_SHM_V + 2 * AT_SHM_K) + wid * 64; LAS float* li_l = wsf; LAS float* al_l = wsf + 32;
    const int qrow0 = METAQ ? (8192 + bl * 16) : (bl * 2048 + qt * 128 + rg * 32);
    const int qrow = METAQ ? (qrow0 + (r32 & 15)) : (qrow0 + r32);
    bf16x8 qr[4];
    { const bf16* Qw = GQ + (size_t)qrow * 2048 + 1024 + hd * 128 + cc * 64 + hi * 8;
#pragma unroll
      for (int d0 = 0; d0 < 4; ++d0) qr[d0] = *(const GAS bf16x8*)(Qw + d0 * 16); }
    const bf16* Kh = (const bf16*)(ws + WS_KA) + hd * 128; const bf16* Vh = (const bf16*)(ws + WS_VA) + hd * 128;
    const int sr = tid >> 4, sc = (tid & 15) * 8, vst0 = v_st(sr, sc), vst1 = v_st(32 + sr, sc);
    const int vb0 = (int)(uintptr_t)V_lds + v_rd_base(lane);
    constexpr int NT = 33;
    bf16x8 vs0, vs1, ks0, ks1;
#define AROW(kt, k) ((kt) < 32 ? (bl * 2048 + (kt) * 64 + (k)) : (8192 + bl * 16 + ((k) & 15)))
#define SLOAD(kt) do { const size_t ra_ = (size_t)AROW(kt, sr) * 1024 + sc, rb_ = (size_t)AROW(kt, 32 + sr) * 1024 + sc; \
        vs0 = *(const GAS bf16x8*)(Vh + ra_); vs1 = *(const GAS bf16x8*)(Vh + rb_); ks0 = *(const GAS bf16x8*)(Kh + ra_); ks1 = *(const GAS bf16x8*)(Kh + rb_); } while (0)
#define SWRITE(b) do { *(LAS bf16x8*)(V_lds + (b) * AT_SHM_V + vst0) = vs0; *(LAS bf16x8*)(V_lds + (b) * AT_SHM_V + vst1) = vs1; const int kc_ = sc * 2; \
        *(LAS bf16x8*)(K_lds + (b) * AT_SHM_K + KSWZ(sr, kc_)) = ks0; *(LAS bf16x8*)(K_lds + (b) * AT_SHM_K + KSWZ(32 + sr, kc_)) = ks1; } while (0)
    float m_reg = -1e30f, l_reg = 0.f;
    f32x16 o[4] = {};
    SLOAD(0); SWRITE(0); SLOAD(1);
    __syncthreads();
    for (int kt = 0; kt < NT; ++kt) {
        const int b = kt & 1;
        if (kt + 1 < NT) { SWRITE(b ^ 1); if (kt + 2 < NT) SLOAD(kt + 2); }
        attn_tile(o, m_reg, l_reg, K_lds + b * AT_SHM_K + cc * 128, vb0 + b * AT_SHM_V, qr, kt == 32, al_l, r32, hi);
        __syncthreads();
    }
#undef SLOAD
#undef SWRITE
#undef AROW
    const float lam_init = 0.8f - 0.6f * expf(-0.3f * (float)layer);
    float lam;
    { const float* lv = F.A->in[6] + layer * 256; const float d1 = wave_sum(lv[lane] * lv[64 + lane]), d2 = wave_sum(lv[128 + lane] * lv[192 + lane]); lam = expf(d1) - expf(d2) + lam_init; }
    if (hi == 0) li_l[r32] = l_reg;
    asm volatile("s_waitcnt lgkmcnt(0)" ::: "memory");
    float ra[16];
#pragma unroll
    for (int r = 0; r < 16; ++r) ra[r] = __builtin_amdgcn_rcpf(li_l[crow(r, hi)]) * (cc == 1 ? lam : 1.0f);
    LAS float* X = (LAS float*)lds + rg * 4096;
    if (cc == 1) {
#pragma unroll
        for (int d = 0; d < 4; ++d)
#pragma unroll
            for (int r = 0; r < 16; ++r) X[(d * 16 + r) * 64 + lane] = o[d][r] * ra[r];
    }
    __syncthreads();
    if (cc == 0) {
#pragma unroll
        for (int r = 0; r < 16; ++r) {
            float ss = 0.f;
#pragma unroll
            for (int d = 0; d < 4; ++d) { const float v = o[d][r] * ra[r] - X[(d * 16 + r) * 64 + lane]; o[d][r] = v; ss += v * v; }
            ss = sum32(ss);
            ra[r] = (1.0f / sqrtf(ss * (1.0f / 128.0f) + NEPS)) * (1.0f - lam_init);
        }
        const float* sg = F.A->in[7] + layer * 128;
        float sgv[4];
#pragma unroll
        for (int d = 0; d < 4; ++d) sgv[d] = sg[32 * d + r32];
        if ((!METAQ || rg == 0) && !dry) {
#pragma unroll
            for (int r = 0; r < 16; ++r) { const int rr = crow(r, hi);
                if (METAQ && rr >= 16) continue;
                const size_t grow = (size_t)(qrow0 + rr);
#pragma unroll
                for (int d = 0; d < 4; ++d) { const int col = hd * 128 + 32 * d + r32;
                    const float gt = bf2f(((const bf16*)(ws + WS_GA))[grow * 1024 + col]);
                    GQ[grow * 2048 + 1024 + col] = (bf16)(cvtpk(o[d][r] * ra[r] * sgv[d] * gt, 0.f) & 0xffffu); }
            }
        }
    }
    __syncthreads();
}
#undef SBAR


#ifdef DBG
namespace nv {
constexpr int D = 1024, BATCH = 8, SEQ = 2048, NMETA = 16, L = SEQ + NMETA, T = BATCH * L;
constexpr int INW = 9216, MIXW = 2048, NH = 8;
constexpr float EPS = 1e-6f, F_FLOOR = 1e-30f;

__device__ __forceinline__ float wave_sum(float v) {
#pragma unroll
    for (int o = 1; o < 64; o <<= 1) v += __shfl_xor(v, o);
    return v;
}
__device__ __forceinline__ float wave_max(float v) {
#pragma unroll
    for (int o = 1; o < 64; o <<= 1) v = fmaxf(v, __shfl_xor(v, o));
    return v;
}
__device__ __forceinline__ float sigmoidf_(float z) { return 1.0f / (1.0f + expf(-z)); }
__device__ __forceinline__ float siluf_(float z) { return z / (1.0f + expf(-z)); }

__global__ void k_build_h(const float* __restrict__ x, const float* __restrict__ meta, float* __restrict__ h) {
    const size_t n4 = (size_t)T * D / 4;
    for (size_t i = blockIdx.x * (size_t)blockDim.x + threadIdx.x; i < n4; i += (size_t)gridDim.x * blockDim.x) {
        const size_t e = i * 4; const int d = (int)(e % D); const size_t row = e / D; const int b = (int)(row / L), t = (int)(row % L);
        const float4 v = t < NMETA ? *(const float4*)(meta + (size_t)t * D + d) : *(const float4*)(x + ((size_t)b * SEQ + (t - NMETA)) * D + d);
        *(float4*)(h + e) = v;
    }
}
__global__ void k_rmsnorm(const float* __restrict__ in, const float* __restrict__ g, float* __restrict__ out, int rows, int drop_meta) {
    const int wave = (blockIdx.x * blockDim.x + threadIdx.x) >> 6, lane = threadIdx.x & 63;
    if (wave >= rows) return;
    int orow = wave;
    if (drop_meta) { const int b = wave / L, t = wave % L; if (t < NMETA) return; orow = b * SEQ + (t - NMETA); }
    const float* r = in + (size_t)wave * D; float v[16]; float s = 0.f;
#pragma unroll
    for (int j = 0; j < 16; ++j) { v[j] = r[lane + 64 * j]; s += v[j] * v[j]; }
    s = wave_sum(s); const float rs = rsqrtf(s * (1.0f / D) + EPS);
#pragma unroll
    for (int j = 0; j < 16; ++j) out[(size_t)orow * D + lane + 64 * j] = v[j] * rs * g[lane + 64 * j];
}
__global__ void __launch_bounds__(256) k_gemm(const float* __restrict__ A, int lda, const float* __restrict__ B, int ldb, float* __restrict__ C, int ldc,
                                              int M, int N, int K, int accumulate) {
    __shared__ float As[16][68], Bs[16][68];
    const int tid = threadIdx.x, tx = tid & 15, ty = tid >> 4, m0 = blockIdx.y * 64, n0 = blockIdx.x * 64;
    float acc[4][4];
#pragma unroll
    for (int i = 0; i < 4; ++i)
#pragma unroll
        for (int j = 0; j < 4; ++j) acc[i][j] = 0.f;
    for (int k0 = 0; k0 < K; k0 += 16) {
        { const int r = tid >> 2, c = (tid & 3) * 4; const int gr = m0 + r; float4 a = make_float4(0.f, 0.f, 0.f, 0.f);
          if (gr < M) a = *(const float4*)(A + (size_t)gr * lda + k0 + c);
          As[c + 0][r] = a.x; As[c + 1][r] = a.y; As[c + 2][r] = a.z; As[c + 3][r] = a.w; }
        { const int r = tid >> 4, c = (tid & 15) * 4; const float4 b = *(const float4*)(B + (size_t)(k0 + r) * ldb + n0 + c);
          Bs[r][c + 0] = b.x; Bs[r][c + 1] = b.y; Bs[r][c + 2] = b.z; Bs[r][c + 3] = b.w; }
        __syncthreads();
#pragma unroll
        for (int kk = 0; kk < 16; ++kk) {
            float a[4], b[4];
#pragma unroll
            for (int i = 0; i < 4; ++i) a[i] = As[kk][ty * 4 + i];
#pragma unroll
            for (int j = 0; j < 4; ++j) b[j] = Bs[kk][tx * 4 + j];
#pragma unroll
            for (int i = 0; i < 4; ++i)
#pragma unroll
                for (int j = 0; j < 4; ++j) acc[i][j] = fmaf(a[i], b[j], acc[i][j]);
        }
        __syncthreads();
    }
#pragma unroll
    for (int i = 0; i < 4; ++i) { const int gr = m0 + ty * 4 + i; if (gr >= M) continue;
        float* cp = C + (size_t)gr * ldc + n0 + tx * 4;
        float4 o = make_float4(acc[i][0], acc[i][1], acc[i][2], acc[i][3]);
        if (accumulate) { const float4 c = *(const float4*)cp; o.x += c.x; o.y += c.y; o.z += c.z; o.w += c.w; }
        *(float4*)cp = o; }
}
__global__ void k_rope(float* __restrict__ p) {
    const int idx = blockIdx.x * blockDim.x + threadIdx.x;
    if (idx >= L * 2 * NH * 2 * 32) return;
    const int i = idx & 31, c = (idx >> 5) & 1, hd = (idx >> 6) & 7, which = (idx >> 9) & 1, t = idx >> 10;
    const float inv = powf(10000.0f, -(float)(2 * i) / 64.0f); const float ang = (float)t * inv;
    const float cs = cosf(ang), sn = sinf(ang);
    float* base = p + (size_t)t * INW + 5120 + which * 1024 + hd * 128 + c * 64;
    const float t1 = base[i], t2 = base[32 + i];
    base[i] = t1 * cs - t2 * sn; base[32 + i] = t2 * cs + t1 * sn;
}
__global__ void __launch_bounds__(256) k_hgrn(const float* __restrict__ p, int ldp, const float* __restrict__ lb_logits  , int layer,
                                              float* __restrict__ o_f, float* __restrict__ o_b) {
    __shared__ float sq[128], sf[128], sk[128], sacc[256];
    const int hd = blockIdx.x, dir = blockIdx.y, tid = threadIdx.x, v = tid & 127, kh = tid >> 7;
    float lb = 0.f;
    if (tid < 128) { if (layer == 1) { const float l0 = lb_logits[(0 * 2 + dir) * 1024 + hd * 128 + tid], l1 = lb_logits[(1 * 2 + dir) * 1024 + hd * 128 + tid];
            const float m = fmaxf(l0, l1); const float e0 = expf(l0 - m), e1 = expf(l1 - m); lb = e1 / (e0 + e1); } }
    float S[64];
#pragma unroll
    for (int k = 0; k < 64; ++k) S[k] = 0.f;
    float* out = dir == 0 ? o_f : o_b;
    for (int step = 0; step < L; ++step) {
        const int t = dir == 0 ? step : L - 1 - step;
        const float* row = p + (size_t)t * ldp;
        if (tid < 128) {
            const float z = row[(dir == 0 ? 1024 : 2048) + hd * 128 + tid];
            const float s = sigmoidf_(z), sn = sigmoidf_(-z);
            sq[tid] = row[hd * 128 + tid]; sf[tid] = lb + (1.0f - lb) * s; sk[tid] = (1.0f - lb) * sn;
        }
        const float vv = row[3072 + hd * 128 + v];
        __syncthreads();
        float acc = 0.f;
#pragma unroll
        for (int k = 0; k < 64; ++k) { const int kk = kh * 64 + k; S[k] = fmaf(sf[kk], S[k], sk[kk] * vv); acc = fmaf(S[k], sq[kk], acc); }
        sacc[tid] = acc;
        __syncthreads();
        if (tid < 128) out[(size_t)t * 1024 + hd * 128 + tid] = sacc[tid] + sacc[tid + 128];
    }
}
__global__ void k_hgrn_final(const float* __restrict__ o_f, const float* __restrict__ o_b, const float* __restrict__ p, const float* __restrict__ g, float* __restrict__ mixed) {
    const int wave = (blockIdx.x * blockDim.x + threadIdx.x) >> 6, lane = threadIdx.x & 63;
    if (wave >= L * NH) return;
    const int t = wave >> 3, hd = wave & 7;
    const size_t off = (size_t)t * 1024 + hd * 128;
    const float a0 = o_f[off + lane] + o_b[off + lane], a1 = o_f[off + 64 + lane] + o_b[off + 64 + lane];
    const float ss = wave_sum(a0 * a0 + a1 * a1); const float rs = rsqrtf(ss * (1.0f / 128.0f) + EPS);
    const float g0 = p[(size_t)t * INW + 4096 + hd * 128 + lane], g1 = p[(size_t)t * INW + 4096 + hd * 128 + 64 + lane];
    mixed[(size_t)t * MIXW + hd * 128 + lane] = a0 * rs * g[lane] * siluf_(g0);
    mixed[(size_t)t * MIXW + hd * 128 + 64 + lane] = a1 * rs * g[64 + lane] * siluf_(g1);
}
constexpr int NKP = ((L + 63) / 64) * 64;
__global__ void __launch_bounds__(128) k_attn(const float* __restrict__ p, const float* __restrict__ lamv  , const float* __restrict__ subg, int layer, float* __restrict__ mixed) {
    __shared__ float sq[2][128]; __shared__ float sp[2][NKP]; __shared__ float st[2][NKP];
    const int wid = threadIdx.x >> 6, lane = threadIdx.x & 63; const int gw = blockIdx.x * 2 + wid;
    const int t = gw >> 3, hd = gw & 7;
    const float lam_init = 0.8f - 0.6f * expf(-0.3f * (float)layer);
    float d1 = lamv[lane] * lamv[64 + lane], d2 = lamv[128 + lane] * lamv[192 + lane];
    d1 = wave_sum(d1); d2 = wave_sum(d2);
    const float lam = expf(d1) - expf(d2) + lam_init;
    const float* qrow = p + (size_t)t * INW + 5120 + hd * 128;
    sq[wid][lane] = qrow[lane]; sq[wid][64 + lane] = qrow[64 + lane];
    __syncthreads();
#pragma unroll 1
    for (int c = 0; c < 2; ++c) {
        float m = -INFINITY;
#pragma unroll 1
        for (int key = lane; key < L; key += 64) {
            const float* kr = p + (size_t)key * INW + 6144 + hd * 128 + c * 64; float a = 0.f;
#pragma unroll 4
            for (int d = 0; d < 64; d += 4) { const float4 k0 = *(const float4*)(kr + d);
                a += sq[wid][c * 64 + d] * k0.x + sq[wid][c * 64 + d + 1] * k0.y + sq[wid][c * 64 + d + 2] * k0.z + sq[wid][c * 64 + d + 3] * k0.w; }
            a *= 0.125f; st[wid][key] = a; m = fmaxf(m, a);
        }
        m = wave_max(m);
        float l = 0.f;
#pragma unroll 1
        for (int key = lane; key < L; key += 64) { const float e = expf(st[wid][key] - m); st[wid][key] = e; l += e; }
        l = wave_sum(l);
        const float sc = c == 0 ? 1.0f / l : -lam / l;
#pragma unroll 1
        for (int key = lane; key < L; key += 64) { const float v = st[wid][key] * sc; sp[wid][key] = c == 0 ? v : sp[wid][key] + v; }
    }
    __syncthreads();
    float o0 = 0.f, o1 = 0.f;
#pragma unroll 4
    for (int key = 0; key < L; ++key) { const float pd = sp[wid][key]; const float* vr = p + (size_t)key * INW + 7168 + hd * 128;
        o0 = fmaf(pd, vr[lane], o0); o1 = fmaf(pd, vr[64 + lane], o1); }
    const float ss = wave_sum(o0 * o0 + o1 * o1); const float rs = rsqrtf(ss * (1.0f / 128.0f) + EPS) * (1.0f - lam_init);
    const float g0 = p[(size_t)t * INW + 8192 + hd * 128 + lane], g1 = p[(size_t)t * INW + 8192 + hd * 128 + 64 + lane];
    mixed[(size_t)t * MIXW + 1024 + hd * 128 + lane] = o0 * rs * subg[lane] * siluf_(g0);
    mixed[(size_t)t * MIXW + 1024 + hd * 128 + 64 + lane] = o1 * rs * subg[64 + lane] * siluf_(g1);
}
}
__device__ __forceinline__ float dbg_bf(const unsigned short* a, size_t i) { return __uint_as_float((unsigned)a[i] << 16); }
__device__ __forceinline__ void dbg_acc(float& d, float& r, float v, float ref) { const float e = fabsf(v - ref); if (!(e == e)) d = 1e30f; d = fmaxf(d, e); r = fmaxf(r, fabsf(ref)); }
__global__ void dbg_check_epi(const float* __restrict__ pb5  , const unsigned char* __restrict__ ws, unsigned* __restrict__ res) {
    const int idx = blockIdx.x * blockDim.x + threadIdx.x; if (idx >= 129 * 1024) return;
    const int c = idx >> 10, ch = idx & 1023;
    const unsigned short *QDF = (const unsigned short*)(ws + WS_QDF), *KTF = (const unsigned short*)(ws + WS_KTF), *QDB = (const unsigned short*)(ws + WS_QDB), *KTB = (const unsigned short*)(ws + WS_KTB);
    const float *DECF = (const float*)(ws + WS_DECF), *DECB = (const float*)(ws + WS_DECB);
    float dq = 0.f, rq = 0.f, dk = 0.f, rk = 0.f, dd = 0.f, rd = 0.f;
    float b = 0.f;
    for (int i = 0; i < 16; ++i) { const float* pr = pb5 + (size_t)(16 * c + i) * 5120; const float q = pr[ch], z = pr[1024 + ch];
        const float f = 1.0f / (1.0f + expf(-z)), kin = 1.0f / (1.0f + expf(z)); b += logf(fmaxf(f, 1e-30f));
        const size_t row = c == 0 ? 8192 + i : 16 * (c - 1) + i;
        dbg_acc(dq, rq, dbg_bf(QDF, row * 1024 + ch), q * expf(b)); dbg_acc(dk, rk, dbg_bf(KTF, row * 1024 + ch) * expf(b), kin); }
    dbg_acc(dd, rd, DECF[(size_t)(c == 0 ? 512 : c - 1) * 1024 + ch], expf(b));
    b = 0.f;
    for (int i = 15; i >= 0; --i) { const float* pr = pb5 + (size_t)(16 * c + i) * 5120; const float q = pr[ch], z = pr[2048 + ch];
        const float f = 1.0f / (1.0f + expf(-z)), kin = 1.0f / (1.0f + expf(z)); b += logf(fmaxf(f, 1e-30f));
        const size_t row = c == 0 ? 8192 + i : 16 * (c - 1) + i;
        dbg_acc(dq, rq, dbg_bf(QDB, row * 1024 + ch), q * expf(b)); dbg_acc(dk, rk, dbg_bf(KTB, row * 1024 + ch) * expf(b), kin); }
    dbg_acc(dd, rd, DECB[(size_t)(c == 0 ? 512 : c - 1) * 1024 + ch], expf(b));
    atomicMax(res + 0, __float_as_uint(dq)); atomicMax(res + 1, __float_as_uint(rq)); atomicMax(res + 2, __float_as_uint(dk)); atomicMax(res + 3, __float_as_uint(rk));
    atomicMax(res + 4, __float_as_uint(dd)); atomicMax(res + 5, __float_as_uint(rd));
}
__global__ void dbg_check_o(const float* __restrict__ of, const float* __restrict__ ob, const unsigned char* __restrict__ ws, unsigned* __restrict__ res) {
    const unsigned short *QDF = (const unsigned short*)(ws + WS_QDF), *QDB = (const unsigned short*)(ws + WS_QDB);
    float df = 0.f, rf = 0.f, db = 0.f, rb = 0.f;
    for (int i = blockIdx.x * blockDim.x + threadIdx.x; i < 2064 * 1024; i += gridDim.x * blockDim.x) { const int t = i >> 10, c = i & 1023; const size_t row = t < 16 ? 8192 + t : t - 16;
        dbg_acc(df, rf, dbg_bf(QDF, row * 1024 + c), of[i]); dbg_acc(db, rb, dbg_bf(QDB, row * 1024 + c), ob[i]); }
    atomicMax(res + 8, __float_as_uint(df)); atomicMax(res + 9, __float_as_uint(rf)); atomicMax(res + 10, __float_as_uint(db)); atomicMax(res + 11, __float_as_uint(rb));
}

__global__ void __launch_bounds__(256) dbg_chunk_oracle(const unsigned char* __restrict__ ws, float* __restrict__ o2f, float* __restrict__ o2b) {
    __shared__ float sQ[16][128], sK[16][128], sV[16][128], sA[16][16], sO[2][16][128], sD[128];
    const int hd = blockIdx.x, dir = blockIdx.y, tid = threadIdx.x, v = tid & 127, kh = tid >> 7;
    const unsigned short* QD = (const unsigned short*)(ws + (dir == 0 ? WS_QDF : WS_QDB)); const unsigned short* KT = (const unsigned short*)(ws + (dir == 0 ? WS_KTF : WS_KTB));
    const unsigned short* VH = (const unsigned short*)(ws + WS_VH); const float* DEC = (const float*)(ws + (dir == 0 ? WS_DECF : WS_DECB));
    float* out = dir == 0 ? o2f : o2b;
    float S[64];
#pragma unroll
    for (int k = 0; k < 64; ++k) S[k] = 0.f;
    for (int step = 0; step < 129; ++step) {
        const int c = dir == 0 ? step : 128 - step; const size_t rowb = c == 0 ? 8192 : 16 * (c - 1);
        for (int i = tid; i < 16 * 128; i += 256) { const int t = i >> 7, k = i & 127; const size_t o = (rowb + t) * 1024 + hd * 128 + k;
            sQ[t][k] = dbg_bf(QD, o); sK[t][k] = dbg_bf(KT, o); sV[t][k] = dbg_bf(VH, o); }
        if (tid < 128) sD[tid] = DEC[(size_t)(c == 0 ? 512 : c - 1) * 1024 + hd * 128 + tid];
#ifdef DBG_DEC1
        if (tid < 128) sD[tid] = 0.5f;
#endif
#ifdef DBG_SFIX
#pragma unroll
        for (int k = 0; k < 64; ++k) S[k] = DBG_SFN(kh * 64 + k, v);
#endif
        __syncthreads();
        { const int t = tid >> 4, s = tid & 15; float a = 0.f; for (int k = 0; k < 128; ++k) a += sQ[t][k] * sK[s][k];
          const bool keep = dir == 0 ? (s <= t) : (s >= t); sA[t][s] = keep ? a : 0.f; }
        __syncthreads();
#pragma unroll 1
        for (int t = 0; t < 16; ++t) { float acc = 0.f;
#ifndef DBG_NOINTRA
            if (kh == 0) {
#pragma unroll 1
                for (int s = 0; s < 16; ++s) acc += sA[t][s] * sV[s][v]; }
#endif
#ifndef DBG_INTRA_ONLY
#pragma unroll
            for (int k = 0; k < 64; ++k) acc += sQ[t][kh * 64 + k] * S[k];
#endif
            sO[kh][t][v] = acc; }
        { float U[64];
#pragma unroll
          for (int k = 0; k < 64; ++k) U[k] = 0.f;
#pragma unroll 1
          for (int s = 0; s < 16; ++s) { const float vs = sV[s][v];
#pragma unroll
              for (int k = 0; k < 64; ++k) U[k] += sK[s][kh * 64 + k] * vs; }
#pragma unroll
          for (int k = 0; k < 64; ++k) S[k] = sD[kh * 64 + k] * (S[k] + U[k]); }
        __syncthreads();
        for (int i = tid; i < 16 * 128; i += 256) { const int t = i >> 7, vv = i & 127; const int tok = c * 16 + t; out[(size_t)tok * 1024 + hd * 128 + vv] = sO[0][t][vv] + sO[1][t][vv]; }
        __syncthreads();
    }
}
__global__ void dbg_check_o2(const float* __restrict__ of, const float* __restrict__ ob, const float* __restrict__ o2f, const float* __restrict__ o2b, unsigned* __restrict__ res) {
    float df = 0.f, rf = 0.f, db = 0.f, rb = 0.f;
    for (int i = blockIdx.x * blockDim.x + threadIdx.x; i < 2064 * 1024; i += gridDim.x * blockDim.x) { dbg_acc(df, rf, o2f[i], of[i]); dbg_acc(db, rb, o2b[i], ob[i]); }
    atomicMax(res + 12, __float_as_uint(df)); atomicMax(res + 13, __float_as_uint(rf)); atomicMax(res + 14, __float_as_uint(db)); atomicMax(res + 15, __float_as_uint(rb));
}
__device__ int dbg_digit(float d, float r) { const float rel = d / fmaxf(r, 1e-20f); if (!(rel == rel) || rel > 1e20f) return 9; int k = (int)floorf(-2.0f * log10f(fmaxf(rel, 1e-12f))); return k < 1 ? 1 : (k > 8 ? 8 : k); }
__global__ void dbg_report(float* __restrict__ out, int n, const unsigned* __restrict__ res, int ia, int ib) {
    for (int i = blockIdx.x * blockDim.x + threadIdx.x; i < n; i += gridDim.x * blockDim.x) out[i] = 0.f;
    if (blockIdx.x == 0 && threadIdx.x == 0) {
        const int d1 = dbg_digit(__uint_as_float(res[ia]), __uint_as_float(res[ia + 1])), d2 = dbg_digit(__uint_as_float(res[ib]), __uint_as_float(res[ib + 1]));
        out[0] = (float)(d1 * 10 + d2) * 1000.0f;
    }
}
#endif

#ifndef TYMASK
#define TYMASK 0xffu
#endif
#define TY(t) ((TYMASK >> (t)) & 1u)
#ifndef REPMASK
#define REPMASK 0u
#endif
#define NREP(t) (1 + (int)((REPMASK >> (t)) & 1u))
#ifndef PHMASK
#define PHMASK 0xffffffffu
#endif
__device__ __forceinline__ void meta_outproj(Frame& F, int task) {
    int tid_l = F.tid; asm volatile("; LAUNDER" : "+v"(tid_l));
    const int rg = task >> 4, cb = task & 15, half = rg >> 2, bl = rg & 3, lane = tid_l & 63, g = lane >> 4, i16 = lane & 15, wave = __builtin_amdgcn_readfirstlane(tid_l >> 6);
    const bf16* A = (const bf16*)(F.ws + WS_GQ) + ((size_t)half * HROWS + 8192 + bl * 16 + i16) * 2048;
    const bf16* B = (const bf16*)(F.ws + WS_WOUT) + (size_t)(cb * 64 + i16) * 2048;
    f32x4 acc[4];
#pragma unroll
    for (int nt = 0; nt < 4; ++nt) acc[nt] = (f32x4){0.f, 0.f, 0.f, 0.f};
#pragma unroll 2
    for (int kk = 0; kk < 8; ++kk) { const int k0 = wave * 256 + kk * 32 + 8 * g;
        const bf16x8 a = *(const GAS bf16x8*)(A + k0);
#pragma unroll
        for (int nt = 0; nt < 4; ++nt) { const bf16x8 b = *(const GAS bf16x8*)(B + (size_t)nt * 16 * 2048 + k0); acc[nt] = __builtin_amdgcn_mfma_f32_16x16x32_bf16(a, b, acc[nt], 0, 0, 0); } }
    LAS f32x4* red = (LAS f32x4*)F.lds;
#pragma unroll
    for (int nt = 0; nt < 4; ++nt) red[(wave * 4 + nt) * 64 + lane] = acc[nt];
    __syncthreads();
    if (wave < 4) { const int nt = wave; f32x4 s = red[nt * 64 + lane];
#pragma unroll
        for (int w = 1; w < 8; ++w) s = s + red[(w * 4 + nt) * 64 + lane];
        float* hm = (float*)(F.ws + WS_HMETA);
#pragma unroll
        for (int r = 0; r < 4; ++r) { const int j = 4 * g + r, col = cb * 64 + 16 * nt + i16; hm[(size_t)(rg * 16 + j) * 1024 + col] = F.A->in[1][(size_t)j * 1024 + col] + s[r]; } }
    __syncthreads();
}
__device__ __forceinline__ void phase_norm_mid(Frame& F) {
    const int tid = fresh_tid(), lane = tid & 63, wave = __builtin_amdgcn_readfirstlane(tid >> 6);
    const int gw = F.bid * NWAVES + wave, NGW = F.G * NWAVES; bf16* U = (bf16*)(F.ws + WS_U);
    const float* g1 = F.A->in[2] + DM; const float* hm = (const float*)(F.ws + WS_HMETA);
    for (int m = gw; m < NBATCH * SEQ + NBATCH * NMETA; m += NGW) {
        if (m < NBATCH * SEQ) { const int half = m >> 13; norm_row_to_bf16(lane, F.out + (size_t)m * DM, g1, U + ((size_t)m + half * 256) * DM, 1, 0); }
        else { const int mm = m - NBATCH * SEQ, b = mm >> 4, j = mm & 15; norm_row_to_bf16(lane, hm + (size_t)mm * DM, g1, U + ((size_t)(b >> 2) * HROWS + 8192 + (b & 3) * 16 + j) * DM, 1, 0); }
    }
}
__device__ __forceinline__ void phase_norm_final(Frame& F) {
    const int tid = fresh_tid(), lane = tid & 63, wave = __builtin_amdgcn_readfirstlane(tid >> 6);
    const int gw = F.bid * NWAVES + wave, NGW = F.G * NWAVES;
    for (int m = gw; m < NBATCH * SEQ; m += NGW) {
        GAS f32x4* xr = (GAS f32x4*)(F.out + (size_t)m * DM) + lane; const GAS f32x4* gr = (const GAS f32x4*)F.A->in[9] + lane;
        f32x4 v[4]; float s = 0.f;
#pragma unroll
        for (int j = 0; j < 4; ++j) { v[j] = xr[64 * j]; s += (v[j].x * v[j].x + v[j].y * v[j].y) + (v[j].z * v[j].z + v[j].w * v[j].w); }
        const float rs = 1.0f / sqrtf(wave_sum(s) * (1.0f / DM) + NEPS);
#pragma unroll
        for (int j = 0; j < 4; ++j) { const f32x4 gg = gr[64 * j]; xr[64 * j] = v[j] * rs * gg; }
    }
}
__device__ __forceinline__ void phase_mix(Frame& F, int layer, int half) {
    const size_t gq_half = (size_t)half * HROWS * 2048 * 2;
    #ifndef NO_SCAN
    if (F.bid < 32) { if (NREP(5) > 1) { const bool odry = __hip_atomic_load(F.ctl + 8, RLX_AGENT) == 0u;   hgrn_scan_item(F, gq_half, F.bid >> 3, F.bid & 7, layer, odry); __syncthreads(); } hgrn_scan_item(F, gq_half, F.bid >> 3, F.bid & 7, layer); __syncthreads(); }
#endif
    const int nmeta = layer == 0 ? 32 : 0, nitems = 512 + nmeta;
#ifndef NO_ATTN
    for (int rep = NREP(6) - 1; rep >= 0; --rep) {
    const bool dry = rep > 0 && __hip_atomic_load(F.ctl + 8, RLX_AGENT) == 0u; gu32* head = F.ctl + CW_QUEUE + 64 * (2 * layer + half) + (dry ? 1024 : 0);
    for (;;) {
        if (F.tid == 0) F.MISC[16] = __hip_atomic_fetch_add(head, 1u, RLX_AGENT);
        __syncthreads();
        const int item = (int)F.MISC[16];
        __syncthreads();
        if (item >= nitems) break;
        if (item < nmeta) attn_item<true>(F, gq_half, item >> 3, item & 7, 0, layer, dry);
        else { const int it = item - nmeta; attn_item<false>(F, gq_half, it >> 7, (it >> 4) & 7, it & 15, layer, dry); }
    }
    }
#endif
}

constexpr int N_PHASES = 13;
#ifndef MK_N_LAUNCHES
#define MK_N_LAUNCHES 1
#endif
__global__ void __launch_bounds__(NTHREADS, 2) hymba_fwd(Args args) {
    extern __shared__ __attribute__((aligned(16))) unsigned char lds[];
    Frame F;
    F.lds = (LAS unsigned char*)lds; F.MISC = (volatile LAS unsigned*)(F.lds + MISC_OFF);
    F.tid = threadIdx.x; F.lane = F.tid & 63; F.wave = __builtin_amdgcn_readfirstlane(F.tid >> 6); F.G = gridDim.x; F.bid = blockIdx.x;
    F.ws = args.ws; F.ctl = (gu32*)(args.ws + WS_CTL); F.out = args.out;
    F.A = &args;
    for (int u = F.tid; u < (LDS_BYTES - LDSCTL_OFF) / 4; u += NTHREADS) ((LAS unsigned*)(F.lds + LDSCTL_OFF))[u] = 0u;
    __syncthreads();
    XcdBarrier bar; bar.bar = (unsigned*)(F.ctl + CW_BAR) + args.li * XCD_BAR_WORDS; bar.x = 0; bar.st = nullptr;
    const int lo = args.ph_lo, hi = args.ph_hi;
    if (hi - lo > 1) bar = xcd_barrier_post((unsigned*)(F.ctl + CW_BAR) + args.li * XCD_BAR_WORDS, F.MISC + 8);
#define IN(k) (((PHMASK >> (k)) & 1u) && lo <= (k) && (k) < hi)
#define SEAM(k) do { if (IN(k) && IN((k) + 1)) xcd_barrier(bar); } while (0)
    unsigned char* ws = args.ws;
    if (TY(0) && IN(0)) { for (int rep = 0; rep < NREP(0); ++rep) { p0_prologue(F); if (rep + 1 < NREP(0)) xcd_barrier(bar); } SEAM(0); }
#pragma unroll 1
    for (int l = 0; l < 2; ++l) {
        const int pb = 1 + 6 * l;
#pragma unroll 1
        for (int half = 0; half < 2; ++half) {
            if (TY(1) && IN(pb + 2 * half)) {
                pg8::Gemm g{(const pg8::bf16_t*)(ws + WS_U) + (size_t)half * HROWS * DM, (const pg8::bf16_t*)(ws + WS_WIN) + (size_t)l * INW * DM, HROWS, INW, DM};
                pg8::OrderIn S; S.init(HROWS, INW, F.G, F.bid);
                pg8::EpiIn E{ws, (size_t)half * HROWS * 2048 * 2, F.A->in[4], l};
                for (int rep = 0; rep < NREP(1); ++rep) { pg8::gemm_phase<pg8::EpiIn, pg8::OrderIn, true, true>(F.lds, g, S, E); if (rep + 1 < NREP(1)) xcd_barrier(bar); }
                SEAM(pb + 2 * half);
            }
            if (TY(2) && IN(pb + 2 * half + 1)) { phase_mix(F, l, half); SEAM(pb + 2 * half + 1); }
        }
        if (TY(3) && IN(pb + 4)) {
            pg8::Gemm g{(const pg8::bf16_t*)(ws + WS_GQ), (const pg8::bf16_t*)(ws + WS_WOUT) + (size_t)l * DM * 2048, NBATCH * SEQ, DM, 2048};
            pg8::OrderOut S; S.init(NBATCH * SEQ, DM, F.G, F.bid);
            pg8::EpiOut E{l == 0 ? F.A->in[0] : (const float*)F.out, F.out};
            for (int rep = 0; rep < (l == 0 ? NREP(3) : 1); ++rep) { pg8::gemm_phase<pg8::EpiOut, pg8::OrderOut, false, true>(F.lds, g, S, E);
            if (l == 0) { for (int t = F.bid; t < 128; t += F.G) meta_outproj(F, t); } if (rep + 1 < (l == 0 ? NREP(3) : 1)) xcd_barrier(bar); }
            SEAM(pb + 4);
        }
        if (TY(4) && IN(pb + 5)) { if (l == 0) { for (int rep = 0; rep < NREP(4); ++rep) { phase_norm_mid(F); if (rep + 1 < NREP(4)) xcd_barrier(bar); } SEAM(pb + 5); } else phase_norm_final(F); }
    }
#undef IN
#undef SEAM
}

extern "C" void kernel_launch(void* const* d_in, const int* in_sizes, int n_in, void* d_out, int out_size, void* d_ws, size_t ws_size, hipStream_t stream) {
    static int grid = 0;
    if (grid == 0) {
        if (n_in != 10 || in_sizes[0] != NBATCH * SEQ * DM || out_size != NBATCH * SEQ * DM || ws_size < WS_END) {
            fprintf(stderr, "kernel_launch: shape/workspace mismatch: n_in %d in0 %d out %d ws %zu (need %zu)\n", n_in, n_in > 0 ? in_sizes[0] : -1, out_size, ws_size, (size_t)WS_END); grid = -1; return; }
        int dev = 0, cus = 0;
        if (hipGetDevice(&dev) != hipSuccess || hipDeviceGetAttribute(&cus, hipDeviceAttributeMultiprocessorCount, dev) != hipSuccess) { grid = -1; return; }
        if (hipFuncSetAttribute((const void*)hymba_fwd, hipFuncAttributeMaxDynamicSharedMemorySize, LDS_BYTES) != hipSuccess) { fprintf(stderr, "kernel_launch: hipFuncSetAttribute failed\n"); grid = -1; return; }
        int per_cu = 0;
        if (hipOccupancyMaxActiveBlocksPerMultiprocessor(&per_cu, (const void*)hymba_fwd, NTHREADS, LDS_BYTES) != hipSuccess || per_cu < 1)
            fprintf(stderr, "kernel_launch: note: occupancy query reports %d workgroups per CU\n", per_cu);
        (void)hipGetLastError();
        grid = cus;
    }
    if (grid < 0) return;
#ifdef DBG
    float* dbg_pb5 = (float*)d_out; float* dbg_of = (float*)((char*)d_ws + WS_GQ + 2 * SZ_HALF); float* dbg_ob = dbg_of + (size_t)2064 * 1024;
    {   using nv::L; using nv::D; using nv::NH;
        float* hb = (float*)((char*)d_ws + WS_U + SZ_HALF); float* ub = hb + (size_t)L * D;
        const float* x = (const float*)d_in[0]; const float* meta = (const float*)d_in[1];
        (void)hipMemcpyAsync(hb, meta, (size_t)16 * D * 4, hipMemcpyDeviceToDevice, stream); (void)hipMemcpyAsync(hb + 16 * D, x, (size_t)nv::SEQ * D * 4, hipMemcpyDeviceToDevice, stream);
        nv::k_rmsnorm<<<(L + 3) / 4, 256, 0, stream>>>(hb, (const float*)d_in[2], ub, L, 0);
        nv::k_gemm<<<dim3(5120 / 64, (L + 63) / 64), 256, 0, stream>>>(ub, D, (const float*)d_in[3], nv::INW, dbg_pb5, 5120, L, 5120, D, 0);
        nv::k_hgrn<<<dim3(NH, 2), 256, 0, stream>>>(dbg_pb5, 5120, (const float*)d_in[4], 0, dbg_of, dbg_ob);
    }
#endif
    if (hipMemsetAsync((char*)d_ws + WS_CTL, 0, CTL_ZERO_BYTES, stream) != hipSuccess) { fprintf(stderr, "kernel_launch: memset failed\n"); return; }
    Args a{};
    for (int i = 0; i < 10; ++i) a.in[i] = (const float*)d_in[i];
    a.out = (float*)d_out; a.ws = (unsigned char*)d_ws;
    constexpr int NL = MK_N_LAUNCHES;
#ifdef DBG
    const int nl_run = 3;
#else
    const int nl_run = NL;
#endif
    for (int li = 0; li < nl_run; ++li) {
        a.ph_lo = NL == 1 ? 0 : li; a.ph_hi = NL == 1 ? N_PHASES : li + 1; a.li = NL == 1 ? 0 : 0;
        hipLaunchKernelGGL(hymba_fwd, dim3(grid), dim3(NTHREADS), LDS_BYTES, stream, a);
        const hipError_t le = hipPeekAtLastError();
        if (le != hipSuccess) { fprintf(stderr, "kernel_launch: launch %d failed: %s\n", li, hipGetErrorName(le)); break; }
#ifdef DBG
        if (li == 1) { dbg_check_epi<<<(129 * 1024 + 255) / 256, 256, 0, stream>>>(dbg_pb5, (const unsigned char*)d_ws, (unsigned*)d_ws + 64);
            float* o2f = (float*)((char*)d_ws + WS_U + SZ_HALF); float* o2b = o2f + (size_t)2064 * 1024;
            dbg_chunk_oracle<<<dim3(8, 2), 256, 0, stream>>>((const unsigned char*)d_ws, o2f, o2b);
            dbg_check_o2<<<1024, 256, 0, stream>>>(dbg_of, dbg_ob, o2f, o2b, (unsigned*)d_ws + 64); }
#endif
    }
#ifdef DBG
#ifdef DBG_VS_O2
    { float* o2f = (float*)((char*)d_ws + WS_U + SZ_HALF); float* o2b = o2f + (size_t)2064 * 1024; dbg_check_o<<<1024, 256, 0, stream>>>(o2f, o2b, (const unsigned char*)d_ws, (unsigned*)d_ws + 64); }
#else
    dbg_check_o<<<1024, 256, 0, stream>>>(dbg_of, dbg_ob, (const unsigned char*)d_ws, (unsigned*)d_ws + 64);
#endif
    dbg_report<<<1024, 256, 0, stream>>>((float*)d_out, out_size, (const unsigned*)d_ws + 64, DBG_IA, DBG_IB);
#endif
}
```

```cpp
#include <hip/hip_runtime.h>
#include <hip/hip_bf16.h>
#include <cstdio>
#include <cstdint>
#include <cmath>
namespace pg8 {
#define PG8_LAS __attribute__((address_space(3)))
typedef unsigned short bf16_t;
typedef short bf16x8 __attribute__((ext_vector_type(8)));
typedef float f32x4 __attribute__((ext_vector_type(4)));
typedef unsigned u32x4 __attribute__((ext_vector_type(4)));
constexpr int BM = 256, BK = 64, HALF = 128, HTB = HALF * BK * 2  , STAGE_BYTES = 8 * HTB, NXCD = 8, WGM = 8;

__host__ __device__ __forceinline__ int lds_byte(int r, int c) { const int st = (r >> 4) * 2 + (c >> 5), rr = r & 15, cc = c & 31, ob = rr * 64 + cc * 2; return st * 1024 + (ob ^ (((ob >> 9) & 1) << 5)); }
__host__ __device__ __forceinline__ void stage_rc(int b, int& R, int& C) { const int st = b / 1024, sb = b % 1024, swz = sb ^ (((sb >> 9) & 1) << 5); R = (st >> 1) * 16 + swz / 64; C = (st & 1) * 32 + (swz % 64) / 2; }
__host__ __device__ __forceinline__ int perm32(int rho) { const int n = rho >> 4, i = rho & 15; return 8 * (i >> 2) + 4 * n + (i & 3); }

struct Unit { int pm, pn; };
struct Gemm { const bf16_t* A; const bf16_t* Bt; int M, N, K; };

struct StaticOrder {
    int nM, nN, nwg, G, c;
    __host__ __device__ void init(int M, int N, int G_, int c_) { nM = M / BM; nN = N / BM; nwg = nM * nN; G = G_; c = c_; }
    __host__ __device__ bool next(int i, Unit& u) const {
        const long L = (long)i * G + c; if (L >= nwg) return false;
        int wgid = (int)L; { const int q = nwg / NXCD, r = nwg % NXCD, xcd = wgid % NXCD, off = wgid / NXCD; wgid = (xcd < r ? xcd * (q + 1) : r * (q + 1) + (xcd - r) * q) + off; }
        const int nig = WGM * nN, gid = wgid / nig, fm = gid * WGM, gsz = (nM - fm) < WGM ? (nM - fm) : WGM;
        u.pm = fm + ((wgid % nig) % gsz); u.pn = (wgid % nig) / gsz; return true;
    }
    __device__ __forceinline__ void a_ready(const Unit&) const {}
    __device__ __forceinline__ void done(const Unit&) const {}
};

__device__ __forceinline__ unsigned cvt_pk_bf16(float lo, float hi) { unsigned r; asm volatile("v_cvt_pk_bf16_f32 %0, %1, %2" : "=v"(r) : "v"(lo), "v"(hi)); return r; }
}
constexpr int DM = 1024, NBATCH = 8, SEQ = 2048, NMETA = 16, LTOK = SEQ + NMETA, NHEAD = 8, INW = 9216;
constexpr int HROWS = 8448;
constexpr int NWAVES = 8, NTHREADS = 512;
constexpr float NEPS = 1e-6f;
constexpr size_t MiB = 1u << 20;
constexpr size_t WS_CTL = 0, CTL_ZERO_BYTES = 1 * MiB;
constexpr size_t WS_ROPE = 1 * MiB;
constexpr size_t WS_HMETA = 2 * MiB;
constexpr size_t WS_WIN = 3 * MiB;
constexpr size_t WS_WOUT = WS_WIN + 36 * MiB;
constexpr size_t WS_U = WS_WOUT + 8 * MiB;
constexpr size_t SZ_HALF = (size_t)HROWS * 1024 * 2;
constexpr size_t WS_GQ = WS_U + 2 * SZ_HALF;
constexpr size_t WS_QDF = WS_GQ + 4 * SZ_HALF, WS_KTF = WS_QDF + SZ_HALF, WS_QDB = WS_KTF + SZ_HALF, WS_KTB = WS_QDB + SZ_HALF, WS_VH = WS_KTB + SZ_HALF;
constexpr size_t WS_KA = WS_VH + SZ_HALF, WS_VA = WS_KA + SZ_HALF, WS_GA = WS_VA + SZ_HALF;
constexpr size_t SZ_DEC = (size_t)(HROWS / 16) * 1024 * 4;
constexpr size_t WS_DECF = WS_GA + SZ_HALF, WS_DECB = WS_DECF + SZ_DEC, WS_END = WS_DECB + SZ_DEC;
static_assert(WS_END <= 288 * MiB, "workspace map must fit 4 x largest tensor");
constexpr int CW_BAR = 4096;
constexpr int CW_QUEUE = 16384;
constexpr int RING_BYTES = 131072, LDSCTL_OFF = RING_BYTES, MISC_OFF = LDSCTL_OFF + 320, LDS_BYTES = 147456;


namespace pg8 {
typedef unsigned u32x2 __attribute__((ext_vector_type(2)));
__device__ __forceinline__ float fexp(float x) { return __builtin_amdgcn_exp2f(x * 1.4426950408889634f); }
__device__ __forceinline__ float flog(float x) { return __builtin_amdgcn_logf(x) * 0.6931471805599453f; }
__device__ __forceinline__ float frcp(float x) { return __builtin_amdgcn_rcpf(x); }
__device__ __forceinline__ float fsilu(float z) { const float zc = fminf(fmaxf(z, -80.f), 80.f); return z * frcp(1.0f + fexp(-zc)); }
__device__ __forceinline__ float scan16(float x) {
    x += __builtin_bit_cast(float, __builtin_amdgcn_update_dpp(0, __builtin_bit_cast(int, x), 0x111, 0xf, 0xf, true));
    x += __builtin_bit_cast(float, __builtin_amdgcn_update_dpp(0, __builtin_bit_cast(int, x), 0x112, 0xf, 0xf, true));
    x += __builtin_bit_cast(float, __builtin_amdgcn_update_dpp(0, __builtin_bit_cast(int, x), 0x114, 0xf, 0xf, true));
    x += __builtin_bit_cast(float, __builtin_amdgcn_update_dpp(0, __builtin_bit_cast(int, x), 0x118, 0xf, 0xf, true));
    return x;
}
constexpr float QSCALE = 0.125f * 1.4426950408889634f;

struct EpiIn {
    static constexpr bool PERM = true, AFTER_DRAIN = false;
    unsigned char* ws;
    size_t gq_half;
    const float* lbl;
    int layer;
    __device__ __forceinline__ void operator()(const f32x4 (&acc)[2][2][4][2], const Unit& u, int wr, int wc, int fr, int fq) const {
        const int rowb = u.pm * BM + wr * 64 + fr;
        if (u.pn < 16) {
            const int ch0 = u.pn * 64 + wc * 16 + fq * 4;
            float lbf[4], lbb[4];
#pragma unroll
            for (int e = 0; e < 4; ++e) { lbf[e] = 0.f; lbb[e] = 0.f; }
            if (layer == 1) {
#pragma unroll
                for (int e = 0; e < 4; ++e) {
                    lbf[e] = frcp(1.0f + fexp(lbl[0 * 1024 + ch0 + e] - lbl[2048 + 0 * 1024 + ch0 + e]));
                    lbb[e] = frcp(1.0f + fexp(lbl[1 * 1024 + ch0 + e] - lbl[2048 + 1 * 1024 + ch0 + e]));
                }
            }
#pragma unroll
            for (int ai = 0; ai < 2; ++ai)
#pragma unroll
                for (int m = 0; m < 4; ++m) {
                    const int row = rowb + ai * HALF + m * 16; const int chunk = row >> 4;
                    const f32x4 q = acc[ai][0][m][0], zf = acc[ai][0][m][1], zb = acc[ai][1][m][0], vi = acc[ai][1][m][1];
                    float qdf[4], ktf[4], qdb[4], ktb[4], dcf[4], dcb[4];
#pragma unroll
                    for (int e = 0; e < 4; ++e) {
                        {   const float z = fminf(fmaxf(zf[e], -80.f), 80.f);
                            const float t = fexp(-z), s = frcp(1.0f + t);
                            const float f = lbf[e] + (1.0f - lbf[e]) * s, kin = (1.0f - lbf[e]) * t * s;
                            const float a = flog(fmaxf(f, 1e-30f));
                            const float b = scan16(a);
                            const float E = fexp(b);
                            qdf[e] = q[e] * E; ktf[e] = kin * fexp(fminf(-b, 80.f)); dcf[e] = E; }
                        {   const float z = fminf(fmaxf(zb[e], -80.f), 80.f);
                            const float t = fexp(-z), s = frcp(1.0f + t);
                            const float f = lbb[e] + (1.0f - lbb[e]) * s, kin = (1.0f - lbb[e]) * t * s;
                            const float a = flog(fmaxf(f, 1e-30f));
                            const float b = scan16(a);
                            const float tot = __shfl(b, 15, 16);
                            const float bb = tot - b + a;
                            const float E = fexp(bb);
                            qdb[e] = q[e] * E; ktb[e] = kin * fexp(fminf(-bb, 80.f)); dcb[e] = E; }
                    }
                    unsigned char* o = ws + ((size_t)row * 1024 + ch0) * 2;
                    *(u32x2*)(o + WS_QDF) = (u32x2){cvt_pk_bf16(qdf[0], qdf[1]), cvt_pk_bf16(qdf[2], qdf[3])};
                    *(u32x2*)(o + WS_KTF) = (u32x2){cvt_pk_bf16(ktf[0], ktf[1]), cvt_pk_bf16(ktf[2], ktf[3])};
                    *(u32x2*)(o + WS_QDB) = (u32x2){cvt_pk_bf16(qdb[0], qdb[1]), cvt_pk_bf16(qdb[2], qdb[3])};
                    *(u32x2*)(o + WS_KTB) = (u32x2){cvt_pk_bf16(ktb[0], ktb[1]), cvt_pk_bf16(ktb[2], ktb[3])};
                    *(u32x2*)(o + WS_VH)  = (u32x2){cvt_pk_bf16(vi[0], vi[1]), cvt_pk_bf16(vi[2], vi[3])};
                    if (fr == 15 || fr == 0) { const bool fw = fr == 15;
                        *(f32x4*)(ws + (fw ? WS_DECF : WS_DECB) + ((size_t)chunk * 1024 + ch0) * 4) = fw ? (f32x4){dcf[0], dcf[1], dcf[2], dcf[3]} : (f32x4){dcb[0], dcb[1], dcb[2], dcb[3]}; }
                    asm volatile("" ::: "memory");
                }
        } else if (u.pn >= 20 && u.pn < 28) {
            const bool isq = u.pn < 24;
            const int colt = (u.pn - (isq ? 20 : 24)) * BM + wc * 32 + 8 * fq;
            const float sc = isq ? QSCALE : 1.0f;
            unsigned char* base = ws + (isq ? (WS_GQ + gq_half + 2048) : WS_KA); const int ld = isq ? 2048 : 1024;
#pragma unroll
            for (int ai = 0; ai < 2; ++ai)
#pragma unroll
                for (int m = 0; m < 4; ++m) {
                    const int row = rowb + ai * HALF + m * 16;
                    const int tpos = row < 8192 ? 16 + (row & 2047) : ((row - 8192) & 15);
                    const float* rp = (const float*)(ws + WS_ROPE) + (size_t)tpos * 64;
#pragma unroll
                    for (int bj = 0; bj < 2; ++bj) {
                        const int col = colt + bj * HALF;
                        const int i0 = (col & 63) >> 1;
                        const f32x4 cs0 = *(const f32x4*)(rp + 2 * i0), cs1 = *(const f32x4*)(rp + 2 * i0 + 4);
                        const f32x4 a = acc[ai][bj][m][0], b = acc[ai][bj][m][1];
                        const float o0 = a[0] * cs0[0] - a[1] * cs0[1], o1 = a[1] * cs0[0] + a[0] * cs0[1];
                        const float o2 = a[2] * cs0[2] - a[3] * cs0[3], o3 = a[3] * cs0[2] + a[2] * cs0[3];
                        const float o4 = b[0] * cs1[0] - b[1] * cs1[1], o5 = b[1] * cs1[0] + b[0] * cs1[1];
                        const float o6 = b[2] * cs1[2] - b[3] * cs1[3], o7 = b[3] * cs1[2] + b[2] * cs1[3];
                        u32x4 w; w.x = cvt_pk_bf16(o0 * sc, o1 * sc); w.y = cvt_pk_bf16(o2 * sc, o3 * sc); w.z = cvt_pk_bf16(o4 * sc, o5 * sc); w.w = cvt_pk_bf16(o6 * sc, o7 * sc);
                        *(u32x4*)(base + ((size_t)row * ld + col) * 2) = w;
                    }
                    asm volatile("" ::: "memory");
                }
        } else {
            const bool isg = u.pn < 20, isv = (u.pn >= 28 && u.pn < 32);
            const int colt = (u.pn - (isg ? 16 : (isv ? 28 : 32))) * BM + wc * 32 + 8 * fq;
            unsigned char* base = ws + (isg ? (WS_GQ + gq_half) : (isv ? WS_VA : WS_GA)); const int ld = isg ? 2048 : 1024;
#pragma unroll
            for (int ai = 0; ai < 2; ++ai)
#pragma unroll
                for (int m = 0; m < 4; ++m) {
                    const int row = rowb + ai * HALF + m * 16;
#pragma unroll
                    for (int bj = 0; bj < 2; ++bj) {
                        f32x4 a = acc[ai][bj][m][0], b = acc[ai][bj][m][1];
                        if (!isv) {
#pragma unroll
                            for (int e = 0; e < 4; ++e) { a[e] = fsilu(a[e]); b[e] = fsilu(b[e]); }
                        }
                        u32x4 w; w.x = cvt_pk_bf16(a[0], a[1]); w.y = cvt_pk_bf16(a[2], a[3]); w.z = cvt_pk_bf16(b[0], b[1]); w.w = cvt_pk_bf16(b[2], b[3]);
                        *(u32x4*)(base + ((size_t)row * ld + colt + bj * HALF) * 2) = w;
                    }
                    asm volatile("" ::: "memory");
                }
        }
    }
};
struct EpiOut {
    static constexpr bool PERM = false, AFTER_DRAIN = false;
    const float* hin; float* hout;
    __device__ __forceinline__ void operator()(const f32x4 (&acc)[2][2][4][2], const Unit& u, int wr, int wc, int fr, int fq) const {
        const int rowb = u.pm * BM + wr * 64 + fr, colb = u.pn * BM + wc * 32 + 4 * fq;
#pragma unroll
        for (int ai = 0; ai < 2; ++ai)
#pragma unroll
            for (int m = 0; m < 4; ++m) {
                const size_t ro = (size_t)(rowb + ai * HALF + m * 16) * 1024;
#pragma unroll
                for (int bj = 0; bj < 2; ++bj)
#pragma unroll
                    for (int n = 0; n < 2; ++n) {
                        const size_t o = ro + colb + bj * HALF + n * 16;
                        const f32x4 hv = *(const f32x4*)(hin + o);
                        *(f32x4*)(hout + o) = hv + acc[ai][bj][m][n];
                    }
            }
    }
};
struct OrderIn : StaticOrder { __device__ __forceinline__ size_t arow(int pm) const { return (size_t)pm * BM; } };
struct OrderOut : StaticOrder { __device__ __forceinline__ size_t arow(int pm) const { return (size_t)(pm >> 5) * 8448 + (size_t)(pm & 31) * BM; } };

template <class Epi, class Sched, bool ALIGN_EPI = false, bool SP2 = false>
__device__ __forceinline__ void gemm_phase(PG8_LAS unsigned char* lds, const Gemm g, const Sched& S, const Epi& E) {
    int tid_l = threadIdx.x; asm volatile("; LAUNDER" : "+v"(tid_l));
    const int tid = tid_l, wid = __builtin_amdgcn_readfirstlane(tid >> 6), lane = tid & 63, wr = wid >> 2, wc = wid & 3, fr = lane & 15, fq = lane >> 4;
    const int K = g.K, nt = K / BK;
    unsigned voffA[2], voffB[2];
#pragma unroll
    for (int i = 0; i < 2; ++i) { int R, C; stage_rc(tid * 16 + i * 8192, R, C); const int Rb = Epi::PERM ? ((R & ~31) + perm32(R & 31)) : R;
        voffA[i] = (unsigned)(R * K + C) * 2u; voffB[i] = (unsigned)(Rb * K + C) * 2u; }
    const size_t kstep = (size_t)(BK * 2);
    const size_t hstep = (size_t)HALF * K * 2;
    const size_t tstep = 2 * hstep;
    const unsigned ldsw = (unsigned)wid * 1024u;
    const int aoff = lds_byte(wr * 64 + fr, fq * 8), boff = lds_byte(wc * 32 + fr, fq * 8);
#define PG8_SA(b, h) (((b) * 2 + (h)) * HTB)
#define PG8_SB(b, h) ((4 + (b) * 2 + (h)) * HTB)
#define PG8_STAGE(bufoff, gbase, voff) do { _Pragma("unroll") for (int _i = 0; _i < 2; ++_i) \
        __builtin_amdgcn_global_load_lds((const unsigned*)((const char*)(gbase) + (voff)[_i]), (PG8_LAS unsigned*)(lds + (bufoff) + ldsw + _i * 8192), 16, 0, 0); } while (0)
#define PG8_LDA(dst, b, h) do { _Pragma("unroll") for (int m = 0; m < 4; ++m) _Pragma("unroll") for (int k = 0; k < 2; ++k) dst[m][k] = *(const PG8_LAS bf16x8*)(lds + PG8_SA(b, h) + aoff + m * 2048 + k * 1024); } while (0)
#define PG8_LDB(dst, b, h) do { _Pragma("unroll") for (int n = 0; n < 2; ++n) _Pragma("unroll") for (int k = 0; k < 2; ++k) dst[n][k] = *(const PG8_LAS bf16x8*)(lds + PG8_SB(b, h) + boff + n * 2048 + k * 1024); } while (0)
#define PG8_MMA(ai, bj, At, Bt) do { __builtin_amdgcn_s_setprio(1); _Pragma("unroll") for (int m = 0; m < 4; ++m) _Pragma("unroll") for (int n = 0; n < 2; ++n) _Pragma("unroll") for (int k = 0; k < 2; ++k) \
        acc[ai][bj][m][n] = __builtin_amdgcn_mfma_f32_16x16x32_bf16(Bt[n][k], At[m][k], acc[ai][bj][m][n], 0, 0, 0); __builtin_amdgcn_s_setprio(0); } while (0)
#define PG8_WAIT_V(n) asm volatile("s_waitcnt vmcnt(" #n ")" ::: "memory")
#define PG8_WAIT_L(n) asm volatile("s_waitcnt lgkmcnt(" #n ")" ::: "memory")
#define PG8_BAR __builtin_amdgcn_s_barrier()
#define PG8_SCHED __builtin_amdgcn_sched_barrier(0)
    Unit cur, nxt; int ui = 0;
    if (!S.next(0, cur)) return;
    f32x4 acc[2][2][4][2];
#pragma unroll
    for (int a = 0; a < 2; ++a)
#pragma unroll
        for (int b = 0; b < 2; ++b)
#pragma unroll
            for (int m = 0; m < 4; ++m)
#pragma unroll
                for (int n = 0; n < 2; ++n) acc[a][b][m][n] = (f32x4){0.f, 0.f, 0.f, 0.f};
    bf16x8 At[4][2], B0[2][2], B1[2][2];
    const char* cA = (const char*)g.A + S.arow(cur.pm) * (size_t)(K * 2); const char* cB = (const char*)g.Bt + (size_t)cur.pn * tstep;
    S.a_ready(cur);
    if constexpr (SP2) {
        PG8_STAGE(PG8_SB(0, 0), cB, voffB); PG8_STAGE(PG8_SB(0, 1), cB + hstep, voffB); PG8_STAGE(PG8_SA(0, 0), cA, voffA); PG8_STAGE(PG8_SA(0, 1), cA + hstep, voffA);
        if (wr == 1) PG8_BAR;
        PG8_WAIT_V(2); PG8_BAR;
        PG8_STAGE(PG8_SB(1, 0), cB + kstep, voffB); PG8_STAGE(PG8_SA(1, 0), cA + kstep, voffA); PG8_STAGE(PG8_SB(1, 1), cB + hstep + kstep, voffB);
        PG8_WAIT_V(6); PG8_BAR;
    } else {
        PG8_STAGE(PG8_SB(0, 0), cB, voffB); PG8_STAGE(PG8_SA(0, 0), cA, voffA); PG8_STAGE(PG8_SB(0, 1), cB + hstep, voffB); PG8_STAGE(PG8_SA(0, 1), cA + hstep, voffA);
        if (wr == 1) PG8_BAR;
        PG8_WAIT_V(4); PG8_BAR;
        PG8_STAGE(PG8_SB(1, 0), cB + kstep, voffB); PG8_STAGE(PG8_SA(1, 0), cA + kstep, voffA); PG8_STAGE(PG8_SB(1, 1), cB + hstep + kstep, voffB);
        PG8_WAIT_V(6); PG8_BAR;
    }
    for (;;) {
        const bool has_next = S.next(ui + 1, nxt);
        const char* nA = has_next ? (const char*)g.A + S.arow(nxt.pm) * (size_t)(K * 2) : cA; const char* nB = has_next ? (const char*)g.Bt + (size_t)nxt.pn * tstep : cB;
        for (int t = 0; t < nt; t += 2) {
            const bool last = (t == nt - 2);
            const char* a1 = cA + (size_t)(t + 1) * kstep;
            const char* a2 = last ? nA : cA + (size_t)(t + 2) * kstep; const char* b2 = last ? nB : cB + (size_t)(t + 2) * kstep;
            const char* a3 = a2 + kstep; const char* b3 = b2 + kstep;
            if (last && has_next) S.a_ready(nxt);
            if constexpr (SP2) {
            PG8_LDB(B0, 0, 0); PG8_LDB(B1, 0, 1); PG8_SCHED; PG8_LDA(At, 0, 0); PG8_STAGE(PG8_SA(1, 1), a1 + hstep, voffA);
            PG8_WAIT_V(8); PG8_WAIT_L(0); PG8_BAR; PG8_MMA(0, 0, At, B0); PG8_MMA(0, 1, At, B1); PG8_BAR; PG8_SCHED;
            PG8_LDA(At, 0, 1); PG8_STAGE(PG8_SB(0, 0), b2, voffB); PG8_STAGE(PG8_SB(0, 1), b2 + hstep, voffB); PG8_STAGE(PG8_SA(0, 0), a2, voffA);
            PG8_WAIT_V(8); PG8_WAIT_L(0); PG8_BAR; PG8_MMA(1, 0, At, B0); PG8_MMA(1, 1, At, B1); PG8_BAR; PG8_SCHED;
            PG8_LDB(B0, 1, 0); PG8_LDB(B1, 1, 1); PG8_SCHED; PG8_LDA(At, 1, 0); PG8_STAGE(PG8_SA(0, 1), a2 + hstep, voffA);
            PG8_WAIT_V(8); PG8_WAIT_L(0); PG8_BAR; PG8_MMA(0, 0, At, B0); PG8_MMA(0, 1, At, B1); PG8_BAR; PG8_SCHED;
            PG8_LDA(At, 1, 1); PG8_STAGE(PG8_SB(1, 0), b3, voffB); PG8_STAGE(PG8_SB(1, 1), b3 + hstep, voffB); PG8_STAGE(PG8_SA(1, 0), a3, voffA);
            PG8_WAIT_V(8); PG8_WAIT_L(0); PG8_BAR; PG8_MMA(1, 0, At, B0); PG8_MMA(1, 1, At, B1); PG8_BAR; PG8_SCHED;
            } else {
            PG8_LDB(B0, 0, 0); PG8_SCHED; PG8_LDA(At, 0, 0); PG8_STAGE(PG8_SA(1, 1), a1 + hstep, voffA);
            PG8_WAIT_L(8); PG8_BAR; PG8_WAIT_L(0); PG8_MMA(0, 0, At, B0); PG8_BAR; PG8_SCHED;
            PG8_LDB(B1, 0, 1); PG8_STAGE(PG8_SB(0, 0), b2, voffB);
            PG8_BAR; PG8_WAIT_L(0); PG8_MMA(0, 1, At, B1); PG8_BAR;
            PG8_LDA(At, 0, 1); PG8_STAGE(PG8_SA(0, 0), a2, voffA);
            PG8_BAR; PG8_WAIT_L(0); PG8_MMA(1, 0, At, B0); PG8_BAR; PG8_SCHED;
            PG8_STAGE(PG8_SB(0, 1), b2 + hstep, voffB);
            PG8_WAIT_V(6); PG8_BAR; PG8_MMA(1, 1, At, B1); PG8_BAR;
            PG8_LDB(B0, 1, 0); PG8_SCHED; PG8_LDA(At, 1, 0); PG8_STAGE(PG8_SA(0, 1), a2 + hstep, voffA);
            PG8_WAIT_L(8); PG8_BAR; PG8_WAIT_L(0); PG8_MMA(0, 0, At, B0); PG8_BAR; PG8_SCHED;
            PG8_LDB(B1, 1, 1); PG8_STAGE(PG8_SB(1, 0), b3, voffB);
            PG8_BAR; PG8_WAIT_L(0); PG8_MMA(0, 1, At, B1); PG8_BAR;
            PG8_LDA(At, 1, 1); PG8_STAGE(PG8_SA(1, 0), a3, voffA);
            PG8_BAR; PG8_WAIT_L(0); PG8_MMA(1, 0, At, B0); PG8_BAR; PG8_SCHED;
            PG8_STAGE(PG8_SB(1, 1), b3 + hstep, voffB);
            PG8_WAIT_V(6); PG8_BAR; PG8_MMA(1, 1, At, B1); PG8_BAR;
            }
        }
        if constexpr (ALIGN_EPI) { if (wr == 0) PG8_BAR; }
        if constexpr (!Epi::AFTER_DRAIN) { E(acc, cur, wr, wc, fr, fq); S.done(cur); }
        if (!has_next) break;
#pragma unroll
        for (int a = 0; a < 2; ++a)
#pragma unroll
            for (int b = 0; b < 2; ++b)
#pragma unroll
                for (int m = 0; m < 4; ++m)
#pragma unroll
                    for (int n = 0; n < 2; ++n) acc[a][b][m][n] = (f32x4){0.f, 0.f, 0.f, 0.f};
        cur = nxt; cA = nA; cB = nB; ++ui;
        if constexpr (ALIGN_EPI) { if (wr == 1) PG8_BAR; }
    }
    PG8_WAIT_V(0);
    if constexpr (!ALIGN_EPI) { if (wr == 0) PG8_BAR; }
    PG8_BAR;
    if constexpr (Epi::AFTER_DRAIN) { E.fused(acc, cur, wr, wc, fr, fq, lds, wid, lane); S.done(cur); }
#undef PG8_SA
#undef PG8_SB
#undef PG8_STAGE
#undef PG8_LDA
#undef PG8_LDB
#undef PG8_MMA
#undef PG8_WAIT_V
#undef PG8_WAIT_L
#undef PG8_BAR
#undef PG8_SCHED
}
}

#define GAS __attribute__((address_space(1)))
#define LAS __attribute__((address_space(3)))
typedef unsigned short bf16;
typedef unsigned v4u __attribute__((ext_vector_type(4)));
typedef float f32x4 __attribute__((ext_vector_type(4)));
typedef short bf16x8 __attribute__((ext_vector_type(8)));
typedef GAS unsigned gu32;
typedef GAS unsigned long long gu64;
#define RLX_AGENT __ATOMIC_RELAXED, __HIP_MEMORY_SCOPE_AGENT
#define LDS_WAIT() asm volatile("s_waitcnt lgkmcnt(0)" ::: "memory")
#define VM_WAIT() asm volatile("s_waitcnt vmcnt(0)" ::: "memory")
__device__ __forceinline__ unsigned long long rt() { return __builtin_amdgcn_s_memrealtime(); }
__device__ __forceinline__ unsigned f2bf(float f) { unsigned u = __builtin_bit_cast(unsigned, f); return (u + 0x7fffu + ((u >> 16) & 1u)) >> 16; }
__device__ __forceinline__ unsigned pk2(float lo, float hi) { return f2bf(lo) | (f2bf(hi) << 16); }

#define XB_TMO      128
#define XB_XCNT(j)  (256  + 64 * (j))
#define XB_XSUB(j)  (1280 + 64 * (j))
#define XB_XGEN(j)  (2304 + 64 * (j))
#define XB_TOP      3328
#define XB_TOPGEN   3392
#define XCD_BAR_WORDS 3456
#define XB_SPIN_CAP (1u << 18)

__device__ __forceinline__ unsigned xb_ld(unsigned* p)              { return __hip_atomic_load(p, __ATOMIC_RELAXED, __HIP_MEMORY_SCOPE_AGENT); }
__device__ __forceinline__ unsigned xb_add(unsigned* p, unsigned v) { return __hip_atomic_fetch_add(p, v, __ATOMIC_RELAXED, __HIP_MEMORY_SCOPE_AGENT); }
__device__ __forceinline__ unsigned xb_xcc_id() { return (unsigned)__builtin_amdgcn_s_getreg((3 << 11) | 20) & 0xFu; }
#define XB_SPIN(cond, bar) do { unsigned _sp = 0; while (cond) { __builtin_amdgcn_s_sleep(1); \
    if ((++_sp & 255u) == 0u) { if (xb_ld(&(bar)[XB_TMO])) break; if (_sp > XB_SPIN_CAP) { atomicAdd(&(bar)[XB_TMO], 1u); break; } } } } while (0)

struct XcdBarrier {
    unsigned* bar; unsigned x;
    volatile LAS unsigned* st;
};

__device__ __forceinline__ XcdBarrier xcd_barrier_post(unsigned* bar, volatile LAS unsigned* st) {
    XcdBarrier b; b.bar = bar; b.x = xb_xcc_id(); b.st = st;
    if (threadIdx.x == 0) (void)xb_add(&bar[XB_XCNT(b.x)], 1u);
    return b;
}
__device__ __forceinline__ void xcd_barrier_complete(unsigned* bar, unsigned x, unsigned& nloc, unsigned& nx) {
    const unsigned G = gridDim.x * gridDim.y * gridDim.z;
    unsigned sum, cnt, mine, sp = 0u;
    for (;;) {
        sum = 0u; cnt = 0u; mine = 0u;
#pragma unroll
        for (unsigned j = 0; j < 16; ++j) { const unsigned c = xb_ld(&bar[XB_XCNT(j)]); sum += c; cnt += (c > 0u) ? 1u : 0u; mine = (j == x) ? c : mine; }
        if (sum == G) break;
        __builtin_amdgcn_s_sleep(1);
        if ((++sp & 255u) == 0u) { if (xb_ld(&bar[XB_TMO])) break; if (sp > XB_SPIN_CAP) { atomicAdd(&bar[XB_TMO], 1u); break; } }
    }
    nloc = mine > 0u ? mine : 1u; nx = cnt > 0u ? cnt : 1u;
}

__device__ __forceinline__ void xcd_barrier(const XcdBarrier& b) {
    asm volatile("s_waitcnt vmcnt(0)" ::: "memory");
    __syncthreads();
    if (threadIdx.x == 0) {
        unsigned* bar = b.bar;
        __builtin_amdgcn_s_waitcnt(0);
        unsigned nloc = b.st[0], nx = b.st[1];
        if (nloc == 0u) { xcd_barrier_complete(bar, b.x, nloc, nx); b.st[0] = nloc; b.st[1] = nx; }
        const unsigned old = xb_add(&bar[XB_XSUB(b.x)], 1u);
        const unsigned gen = old / nloc;
        if (old + 1u == (gen + 1u) * nloc) {
            __builtin_amdgcn_fence(__ATOMIC_RELEASE, "agent");
            asm volatile("s_waitcnt vmcnt(0)" ::: "memory");
            const unsigned og = xb_add(&bar[XB_TOP], 1u);
            const unsigned tg = og / nx;
            if (og + 1u == (tg + 1u) * nx) xb_add(&bar[XB_TOPGEN], 1u);
            else XB_SPIN(xb_ld(&bar[XB_TOPGEN]) == tg, bar);
            __builtin_amdgcn_fence(__ATOMIC_ACQUIRE, "agent");
            xb_add(&bar[XB_XGEN(b.x)], 1u);
            asm volatile("s_waitcnt vmcnt(0)" ::: "memory");
        } else {
            XB_SPIN(xb_ld(&bar[XB_XGEN(b.x)]) == gen, bar);
            __builtin_amdgcn_fence(__ATOMIC_ACQUIRE, "agent");
            asm volatile("s_waitcnt vmcnt(0)" ::: "memory");
        }
    }
    __syncthreads();
}

typedef short s16x4 __attribute__((ext_vector_type(4)));
typedef float f32x16 __attribute__((ext_vector_type(16)));
typedef unsigned u32x2v __attribute__((ext_vector_type(2)));
__device__ __forceinline__ unsigned cvtpk(float lo, float hi) { typedef float f2_t __attribute__((ext_vector_type(2))); typedef __bf16 b2_t __attribute__((ext_vector_type(2)));
    const f2_t v = {lo, hi}; const b2_t b = __builtin_convertvector(v, b2_t); return __builtin_bit_cast(unsigned, b); }
__device__ __forceinline__ float bf2f(unsigned short v) { return __uint_as_float((unsigned)v << 16); }
__device__ __forceinline__ float bflo(unsigned w) { return __uint_as_float(w << 16); }
__device__ __forceinline__ float bfhi(unsigned w) { return __uint_as_float(w & 0xffff0000u); }
__device__ __forceinline__ float wave_sum(float v) {
#pragma unroll
    for (int o = 1; o < 64; o <<= 1) v += __shfl_xor(v, o);
    return v;
}
__device__ __forceinline__ float sum16(float v) {
#pragma unroll
    for (int o = 1; o < 16; o <<= 1) v += __shfl_xor(v, o);
    return v;
}
__device__ __forceinline__ float sum32(float v) {
#pragma unroll
    for (int o = 1; o < 32; o <<= 1) v += __shfl_xor(v, o);
    return v;
}

struct Args { const float* in[10]; float* out; unsigned char* ws; int ph_lo, ph_hi, li, pad; };
struct Frame {
    LAS unsigned char* lds; volatile LAS unsigned* MISC; gu32* ctl; int tid, lane, wave, G, bid;
    const Args* A;
    float* out; unsigned char* ws;
};

__device__ __forceinline__ int fresh_tid() { int t = threadIdx.x; asm volatile("; LAUNDER" : "+v"(t)); return t; }
__device__ __forceinline__ int dst_col(int c) {
    const int g = c >> 10, j = c & 1023;
    if (g < 4) { const int th = j >> 6, cc = j & 63, wc = cc >> 4, fq = (cc >> 2) & 3, e = cc & 3, bj = g >> 1, n = g & 1; return 256 * th + 128 * bj + 32 * wc + 8 * fq + 4 * n + e; }
    if (g == 5 || g == 6) { const int d = j & 63, i = d & 31, hf = d >> 5; return g * 1024 + (j & ~63) + 2 * i + hf; }
    return c;
}
template <bool PERMUTE>
__device__ __forceinline__ void p0_transpose_item(const float* W, int K, int N, bf16* WT, LAS float* scr, int item, int lane) {
    const int nblk = N / 32, kb = item / nblk, nb = item % nblk, k0 = 64 * kb, n0 = 32 * nb;
#pragma unroll 8
    for (int i = 0; i < 32; ++i) { const int kk = 2 * i + (lane >> 5); scr[kk * 33 + (lane & 31)] = W[(size_t)(k0 + kk) * N + n0 + (lane & 31)]; }
    LDS_WAIT(); asm volatile("" ::: "memory");
    const int c = lane & 7;
#pragma unroll
    for (int j = 0; j < 4; ++j) { const int n = (lane >> 3) + 8 * j; const LAS float* s = scr + (8 * c) * 33 + n;
        v4u o; o.x = pk2(s[0 * 33], s[1 * 33]); o.y = pk2(s[2 * 33], s[3 * 33]); o.z = pk2(s[4 * 33], s[5 * 33]); o.w = pk2(s[6 * 33], s[7 * 33]);
        const int drow = PERMUTE ? dst_col(n0 + n) : (n0 + n);
        *(GAS v4u*)(WT + (size_t)drow * K + k0 + 8 * c) = o; }
    LDS_WAIT(); asm volatile("" ::: "memory");
}
__device__ __forceinline__ void norm_row_to_bf16(int lane, const float* xrow, const float* g, bf16* orow, int ncopy, size_t cstride) {
    const GAS f32x4* xr = (const GAS f32x4*)xrow + lane; const GAS f32x4* gr = (const GAS f32x4*)g + lane;
    f32x4 v[4]; float s = 0.f;
#pragma unroll
    for (int j = 0; j < 4; ++j) { v[j] = xr[64 * j]; s += (v[j].x * v[j].x + v[j].y * v[j].y) + (v[j].z * v[j].z + v[j].w * v[j].w); }
    const float rs = 1.0f / sqrtf(wave_sum(s) * (1.0f / DM) + NEPS);
    unsigned long long w[4];
#pragma unroll
    for (int j = 0; j < 4; ++j) { const f32x4 gg = gr[64 * j]; w[j] = (unsigned long long)pk2(v[j].x * rs * gg.x, v[j].y * rs * gg.y) | ((unsigned long long)pk2(v[j].z * rs * gg.z, v[j].w * rs * gg.w) << 32); }
    for (int c = 0; c < ncopy; ++c) { GAS unsigned long long* o8 = (GAS unsigned long long*)(orow + (size_t)c * cstride) + lane;
#pragma unroll
        for (int j = 0; j < 4; ++j) o8[64 * j] = w[j]; }
}
__device__ __forceinline__ void p0_prologue(Frame& F) {
    const int tid = fresh_tid(), lane = tid & 63, wave = __builtin_amdgcn_readfirstlane(tid >> 6);
    LAS float* scr = (LAS float*)(F.lds + wave * 16384);
    const int gw = F.bid * NWAVES + wave, NGW = F.G * NWAVES;
    constexpr int I_IN = (DM / 64) * (INW / 32), I_OUT = (2048 / 64) * (DM / 32);
    constexpr int NITEMS = 2 * (I_IN + I_OUT);
    bf16* win = (bf16*)(F.ws + WS_WIN); bf16* wout = (bf16*)(F.ws + WS_WOUT);
    for (int it = gw; it < NITEMS; it += NGW) {
        int r = it; const int l = r / (I_IN + I_OUT); r -= l * (I_IN + I_OUT);
        if (r < I_IN) p0_transpose_item<true>(F.A->in[3] + (size_t)l * DM * INW, DM, INW, win + (size_t)l * INW * DM, scr, r, lane);
        else p0_transpose_item<false>(F.A->in[8] + (size_t)l * 2048 * DM, 2048, DM, wout + (size_t)l * DM * 2048, scr, r - I_IN, lane);
    }
    { float* rope = (float*)(F.ws + WS_ROPE);
      for (int idx = F.bid * NTHREADS + tid; idx < LTOK * 32; idx += F.G * NTHREADS) { const int t = idx >> 5, i = idx & 31;
          const float inv = powf(10000.0f, -(float)(2 * i) / 64.0f), ang = (float)t * inv; rope[2 * idx] = cosf(ang); rope[2 * idx + 1] = sinf(ang); } }
    bf16* U = (bf16*)(F.ws + WS_U);
    for (int m = gw; m < NBATCH * SEQ + NMETA; m += NGW) {
        if (m < NBATCH * SEQ) { const int half = m >> 13; norm_row_to_bf16(lane, F.A->in[0] + (size_t)m * DM, F.A->in[2], U + ((size_t)m + half * 256) * DM, 1, 0); }
        else { const int j = m - NBATCH * SEQ;
            norm_row_to_bf16(lane, F.A->in[1] + (size_t)j * DM, F.A->in[2], U + ((size_t)8192 + j) * DM, 4, (size_t)16 * DM);
            norm_row_to_bf16(lane, F.A->in[1] + (size_t)j * DM, F.A->in[2], U + ((size_t)HROWS + 8192 + j) * DM, 4, (size_t)16 * DM); }
    }
}

constexpr int SC_PITCH = 272;
constexpr int SC_TILE = 16 * SC_PITCH;
constexpr int SC_DEC = 3 * SC_TILE;
constexpr int SC_BUF = SC_DEC + 512;
__device__ __forceinline__ s16x4 tr16(const LAS unsigned char* p) {
    typedef short v4i16_t __attribute__((ext_vector_type(4)));
    return __builtin_bit_cast(s16x4, __builtin_amdgcn_ds_read_tr16_b64_v4i16((LAS v4i16_t*)p));
}
__device__ __forceinline__ int scan_rowbase(int bl, int c) { return c == 0 ? 8192 + bl * 16 : bl * 2048 + 16 * (c - 1); }
struct ScanSet { bf16x8 a, b; f32x4 d; };

__device__ __forceinline__ void hgrn_scan_item(Frame& F, int bl, int hd, int dir, int layer, bool dry = false) {
    int tid_l = F.tid; asm volatile("; LAUNDER" : "+v"(tid_l));
    const int tid = tid_l, lane = tid & 63, vs = __builtin_amdgcn_readfirstlane(tid >> 6), g = lane >> 4, i16 = lane & 15;
    LAS unsigned char* lds = F.lds;
    unsigned char* const ws = F.ws;
    bf16* QD = (bf16*)(ws + (dir == 0 ? WS_QDF : WS_QDB));
    const int hcol = hd * 128;
    const int sh = tid >> 8, s_row = (tid & 255) >> 4, s_c16 = tid & 15;
    const bf16* srcA = (const bf16*)(ws + (sh == 0 ? (dir == 0 ? WS_QDF : WS_QDB) : (dir == 0 ? WS_KTF : WS_KTB))) + hcol + s_c16 * 8;
    const bf16* srcV = (const bf16*)(ws + WS_VH) + hcol + s_c16 * 8;
    const bool s_dec = sh == 1 && (tid & 255) < 32;
    const float* srcD = (const float*)(ws + (dir == 0 ? WS_DECF : WS_DECB)) + hcol + (tid & 31) * 4;
    const int s_off = s_row * SC_PITCH + s_c16 * 16;
    const int s_doff = SC_DEC + (tid & 31) * 16;
#define SC_LOAD(SET, step) do { const int c_ = dir == 0 ? (step) : 128 - (step); const int rb_ = scan_rowbase(bl, c_); const size_t ro_ = (size_t)(rb_ + s_row) * 1024; \
        SET.a = *(const GAS bf16x8*)(srcA + ro_); if (sh == 0) SET.b = *(const GAS bf16x8*)(srcV + ro_); \
        if (s_dec) SET.d = *(const GAS f32x4*)(srcD + (size_t)(rb_ >> 4) * 1024); } while (0)
#define SC_WRITE(SET, buf) do { LAS unsigned char* b_ = lds + (buf) * SC_BUF; *(LAS bf16x8*)(b_ + sh * SC_TILE + s_off) = SET.a; \
        if (sh == 0) *(LAS bf16x8*)(b_ + 2 * SC_TILE + s_off) = SET.b; if (s_dec) *(LAS f32x4*)(b_ + s_doff) = SET.d; } while (0)
    f32x4 S[8];
#pragma unroll
    for (int kb = 0; kb < 8; ++kb) S[kb] = (f32x4){0.f, 0.f, 0.f, 0.f};
    const int o_frag = i16 * SC_PITCH + 8 * g;
    const int o_tr = (4 * g + (i16 >> 2)) * SC_PITCH + (i16 & 3) * 8;
#define SC_STEP(step, LOADSET, NEXT) do { \
        const int buf = (step) & 1; const int c = dir == 0 ? (step) : 128 - (step); const int rowb = scan_rowbase(bl, c); \
        if ((step) + 3 < 129) SC_LOAD(LOADSET, (step) + 3); \
        const LAS unsigned char* B = lds + buf * SC_BUF; \
        bf16x8 cqd[4], ckt[4]; \
        _Pragma("unroll") for (int kk = 0; kk < 4; ++kk) { \
            const u32x2v a0 = *(const LAS u32x2v*)(B + o_frag + 64 * kk), a1 = *(const LAS u32x2v*)(B + o_frag + 64 * kk + 32); \
            const u32x2v b0 = *(const LAS u32x2v*)(B + SC_TILE + o_frag + 64 * kk), b1 = *(const LAS u32x2v*)(B + SC_TILE + o_frag + 64 * kk + 32); \
            cqd[kk] = __builtin_bit_cast(bf16x8, (v4u){a0.x, a0.y, a1.x, a1.y}); ckt[kk] = __builtin_bit_cast(bf16x8, (v4u){b0.x, b0.y, b1.x, b1.y}); } \
        s16x4 ktT[8]; \
        _Pragma("unroll") for (int kb = 0; kb < 8; ++kb) ktT[kb] = tr16(B + SC_TILE + o_tr + kb * 32); \
        const s16x4 vfr = tr16(B + 2 * SC_TILE + o_tr + vs * 32); \
          \
        f32x4 at = (f32x4){0.f, 0.f, 0.f, 0.f}; \
        _Pragma("unroll") for (int kk = 0; kk < 4; ++kk) at = __builtin_amdgcn_mfma_f32_16x16x32_bf16(ckt[kk], cqd[kk], at, 0, 0, 0); \
        _Pragma("unroll") for (int r = 0; r < 4; ++r) { const int s_ = 4 * g + r; const bool keep = dir == 0 ? (s_ <= i16) : (s_ >= i16); at[r] = keep ? at[r] : 0.f; } \
        const s16x4 pfr = __builtin_bit_cast(s16x4, (u32x2v){cvtpk(at[0], at[1]), cvtpk(at[2], at[3])}); \
          \
        const f32x4 oi = __builtin_amdgcn_mfma_f32_16x16x16bf16_1k(pfr, vfr, (f32x4){0.f, 0.f, 0.f, 0.f}, 0, 0, 0); \
        f32x4 oe = (f32x4){0.f, 0.f, 0.f, 0.f}; \
        _Pragma("unroll") for (int kk = 0; kk < 4; ++kk) { \
            const f32x4 s0 = S[2 * kk], s1 = S[2 * kk + 1]; \
            const bf16x8 sb = __builtin_bit_cast(bf16x8, (v4u){cvtpk(s0[0], s0[1]), cvtpk(s0[2], s0[3]), cvtpk(s1[0], s1[1]), cvtpk(s1[2], s1[3])}); \
            oe = __builtin_amdgcn_mfma_f32_16x16x32_bf16(cqd[kk], sb, oe, 0, 0, 0); } \
        const f32x4 o = oi + oe; \
          \
        _Pragma("unroll") for (int kb = 0; kb < 8; ++kb) { const f32x4 dec = *(const LAS f32x4*)(B + SC_DEC + (16 * kb + 4 * g) * 4); \
            S[kb] = __builtin_amdgcn_mfma_f32_16x16x16bf16_1k(ktT[kb], vfr, S[kb], 0, 0, 0); S[kb] = S[kb] * dec; } \
          \
        if (!(layer == 1 && c == 0) && !dry) { \
            _Pragma("unroll") for (int r = 0; r < 4; ++r) QD[(size_t)(rowb + 4 * g + r) * 1024 + hcol + 16 * vs + i16] = (bf16)(cvtpk(o[r], 0.f) & 0xffffu); } \
        if ((step) + 1 < 129) SC_WRITE(NEXT, buf ^ 1); \
        __syncthreads(); } while (0)
    ScanSet R0, R1, R2;
    SC_LOAD(R0, 0); SC_LOAD(R1, 1); SC_LOAD(R2, 2);
    SC_WRITE(R0, 0);
    __syncthreads();
#pragma unroll 1
    for (int st = 0; st < 129; st += 3) {
        SC_STEP(st, R0, R1);
        SC_STEP(st + 1, R1, R2);
        SC_STEP(st + 2, R2, R0);
    }
#undef SC_LOAD
#undef SC_WRITE
#undef SC_STEP
}
__device__ __forceinline__ void hgrn_finalize_item(Frame& F, size_t gq_half, int bl, int hd, int layer, bool dry = false) {
    int tid_l = F.tid; asm volatile("; LAUNDER" : "+v"(tid_l));
    const int tid = tid_l, lane = tid & 63, wave = __builtin_amdgcn_readfirstlane(tid >> 6), g = lane >> 4, i16 = lane & 15;
    unsigned char* const ws = F.ws; const int hcol = hd * 128;
    const float* gn = F.A->in[5] + layer * 128 + 8 * i16;
    const f32x4 g0 = *(const GAS f32x4*)gn, g1 = *(const GAS f32x4*)(gn + 4);
    const int ntok = layer == 1 ? SEQ : LTOK;
    for (int tk = wave * 4 + g; tk < ntok; tk += NWAVES * 4) {
        const int row = tk < SEQ ? bl * 2048 + tk : 8192 + bl * 16 + (tk - SEQ);
        const size_t ro = (size_t)row * 1024 + hcol + 8 * i16;
        const v4u a = *(const GAS v4u*)((const bf16*)(ws + WS_QDF) + ro), b = *(const GAS v4u*)((const bf16*)(ws + WS_QDB) + ro);
        float v[8];
        v[0] = bflo(a.x) + bflo(b.x); v[1] = bfhi(a.x) + bfhi(b.x); v[2] = bflo(a.y) + bflo(b.y); v[3] = bfhi(a.y) + bfhi(b.y);
        v[4] = bflo(a.z) + bflo(b.z); v[5] = bfhi(a.z) + bfhi(b.z); v[6] = bflo(a.w) + bflo(b.w); v[7] = bfhi(a.w) + bfhi(b.w);
        float ss = 0.f;
#pragma unroll
        for (int e = 0; e < 8; ++e) ss += v[e] * v[e];
        ss = sum16(ss);
        const float rs = 1.0f / sqrtf(ss * (1.0f / 128.0f) + NEPS);
        bf16* gp = (bf16*)(ws + WS_GQ + gq_half) + (size_t)row * 2048 + hcol + 8 * i16;
        const v4u gt = *(const GAS v4u*)gp;
        v4u w;
        w.x = cvtpk(v[0] * rs * g0[0] * bflo(gt.x), v[1] * rs * g0[1] * bfhi(gt.x)); w.y = cvtpk(v[2] * rs * g0[2] * bflo(gt.y), v[3] * rs * g0[3] * bfhi(gt.y));
        w.z = cvtpk(v[4] * rs * g1[0] * bflo(gt.z), v[5] * rs * g1[1] * bfhi(gt.z)); w.w = cvtpk(v[6] * rs * g1[2] * bflo(gt.w), v[7] * rs * g1[3] * bfhi(gt.w));
        if (!dry) *(GAS v4u*)gp = w;
    }
}

constexpr int AT_SHM_V = 64 * 128 * 2, AT_SHM_K = 64 * 128 * 2;
constexpr float AT_THR2 = 11.5f;
#define KSWZ(row, colB) ((row) * 256 + ((colB) ^ (((row) & 7) << 4)))
#define SBAR() __builtin_amdgcn_sched_barrier(0)
__device__ __forceinline__ int crow(int r, int hi) { return (r & 3) + 8 * (r >> 2) + 4 * hi; }
__device__ __forceinline__ int v_st(int k, int c) { const int kk = (k & ~0xC) | ((k & 4) << 1) | ((k & 8) >> 1); return ((kk >> 3) * 4 + (c >> 5)) * 512 + ((kk & 7) * 32 + (c & 31)) * 2; }
__device__ __forceinline__ int v_rd_base(int lane) { return ((lane & 3) << 3) | (((lane >> 2) & 3) << 6) | (((lane >> 4) & 1) << 5) | (((lane >> 5) & 1) << 8); }
constexpr int v_rd_off(int d0, int ks, int half) { return d0 * 512 + ks * 4096 + half * 2048; }
template <int OFF> __device__ __forceinline__ s16x4 tr_read(int vb) {
    s16x4 r; asm volatile("ds_read_b64_tr_b16 %0, %1 offset:%2" : "=&v"(r) : "v"(vb), "i"(OFF) : "memory"); return r;
}
template <int D0> __device__ __forceinline__ void pv_one(f32x16& od, int vb, bf16x8 pa0, bf16x8 pa1, bf16x8 pa2, bf16x8 pa3) {
    const s16x4 l0 = tr_read<v_rd_off(D0, 0, 0)>(vb), h0 = tr_read<v_rd_off(D0, 0, 1)>(vb), l1 = tr_read<v_rd_off(D0, 1, 0)>(vb), h1 = tr_read<v_rd_off(D0, 1, 1)>(vb);
    const s16x4 l2 = tr_read<v_rd_off(D0, 2, 0)>(vb), h2 = tr_read<v_rd_off(D0, 2, 1)>(vb), l3 = tr_read<v_rd_off(D0, 3, 0)>(vb), h3 = tr_read<v_rd_off(D0, 3, 1)>(vb);
    asm volatile("s_waitcnt lgkmcnt(0)" ::: "memory"); SBAR();
#define PK(L, H) (bf16x8){L[0], L[1], L[2], L[3], H[0], H[1], H[2], H[3]}
    od = __builtin_amdgcn_mfma_f32_32x32x16_bf16(pa0, PK(l0, h0), od, 0, 0, 0);
    od = __builtin_amdgcn_mfma_f32_32x32x16_bf16(pa1, PK(l1, h1), od, 0, 0, 0);
    od = __builtin_amdgcn_mfma_f32_32x32x16_bf16(pa2, PK(l2, h2), od, 0, 0, 0);
    od = __builtin_amdgcn_mfma_f32_32x32x16_bf16(pa3, PK(l3, h3), od, 0, 0, 0);
#undef PK
}
__device__ __forceinline__ void attn_tile(f32x16 (&o)[4], float& m_reg, float& l_reg, const LAS unsigned char* Ks  , int vb, const bf16x8 (&qr)[4], bool meta_tile,
                                          LAS float* al_l, int r32, int hi) {
    f32x16 p0 = {}, p1 = {};
#pragma unroll
    for (int d0 = 0; d0 < 4; ++d0) { const int cb = (d0 * 16 + hi * 8) * 2;
        const bf16x8 b0 = *(const LAS bf16x8*)(Ks + KSWZ(r32, cb));
        const bf16x8 b1 = *(const LAS bf16x8*)(Ks + KSWZ(32 + r32, cb));
        p0 = __builtin_amdgcn_mfma_f32_32x32x16_bf16(b0, qr[d0], p0, 0, 0, 0);
        p1 = __builtin_amdgcn_mfma_f32_32x32x16_bf16(b1, qr[d0], p1, 0, 0, 0); }
    if (meta_tile) {
#pragma unroll
        for (int r = 8; r < 16; ++r) p0[r] = -INFINITY;
#pragma unroll
        for (int r = 0; r < 16; ++r) p1[r] = -INFINITY;
    }
    float pmax = p0[0];
#pragma unroll
    for (int r = 1; r < 16; ++r) pmax = fmaxf(pmax, p0[r]);
#pragma unroll
    for (int r = 0; r < 16; ++r) pmax = fmaxf(pmax, p1[r]);
    { auto rr = __builtin_amdgcn_permlane32_swap(__float_as_uint(pmax), __float_as_uint(pmax), false, false);
      pmax = fmaxf(__uint_as_float(rr[0]), __uint_as_float(rr[1])); }
    float alpha = 1.f;
    if (!__all(pmax - m_reg <= AT_THR2)) { const float mn = fmaxf(m_reg, pmax); alpha = __builtin_amdgcn_exp2f(m_reg - mn); m_reg = mn; }
#pragma unroll
    for (int r = 0; r < 16; ++r) { p0[r] = __builtin_amdgcn_exp2f(p0[r] - m_reg); p1[r] = __builtin_amdgcn_exp2f(p1[r] - m_reg); }
    float ps = 0.f;
#pragma unroll
    for (int r = 0; r < 16; ++r) ps += p0[r];
#pragma unroll
    for (int r = 0; r < 16; ++r) ps += p1[r];
    { auto rr = __builtin_amdgcn_permlane32_swap(__float_as_uint(ps), __float_as_uint(ps), false, false);
      ps = __uint_as_float(rr[0]) + __uint_as_float(rr[1]); }
    l_reg = l_reg * alpha + ps;
    if (__any(alpha < 1.f)) {
        if (hi == 0) al_l[r32] = alpha;
        asm volatile("s_waitcnt lgkmcnt(0)" ::: "memory");
#pragma unroll
        for (int d = 0; d < 4; ++d)
#pragma unroll
            for (int r = 0; r < 16; ++r) o[d][r] *= al_l[crow(r, hi)];
    }
    bf16x8 pa0, pa1, pa2, pa3;
#define PK4(P, BASE, OUT) do { unsigned a0 = cvtpk(P[BASE + 0], P[BASE + 1]), a1 = cvtpk(P[BASE + 2], P[BASE + 3]);   \
    unsigned b0_ = cvtpk(P[BASE + 4], P[BASE + 5]), b1_ = cvtpk(P[BASE + 6], P[BASE + 7]);                              \
    auto r0 = __builtin_amdgcn_permlane32_swap(a0, b0_, false, false); auto r1 = __builtin_amdgcn_permlane32_swap(a1, b1_, false, false); \
    v4u w = {r0[0], r1[0], r0[1], r1[1]}; OUT = __builtin_bit_cast(bf16x8, w); } while (0)
    PK4(p0, 0, pa0); PK4(p0, 8, pa1); PK4(p1, 0, pa2); PK4(p1, 8, pa3);
#undef PK4
    pv_one<0>(o[0], vb, pa0, pa1, pa2, pa3); pv_one<1>(o[1], vb, pa0, pa1, pa2, pa3); pv_one<2>(o[2], vb, pa0, pa1, pa2, pa3); pv_one<3>(o[3], vb, pa0, pa1, pa2, pa3);
}
template <bool METAQ>
__device__ __forceinline__ void attn_item(Frame& F, size_t gq_half, int bl, int hd, int qt, int layer, bool dry = false, bool dummy_out = false, int half_for_dummy = 0) {
    int tid_l = F.tid; asm volatile("; LAUNDER" : "+v"(tid_l));
    const int tid = tid_l, wid = __builtin_amdgcn_readfirstlane(tid >> 6), lane = tid & 63, r32 = lane & 31, hi = lane >> 5, rg = wid & 3, cc = wid >> 2;
    LAS unsigned char* lds = F.lds; unsigned char* const ws = F.ws; bf16* const GQ = (bf16*)(ws + WS_GQ + gq_half);
    LAS unsigned char* V_lds = lds; LAS unsigned char* K_lds = lds + 2 * AT_SHM_V;
    LAS float* wsf = (LAS float*)(lds + 2 * AT_SHM_V + 2 * AT_SHM_K) + wid * 64; LAS float* li_l = wsf; LAS float* al_l = wsf + 32;
    const int qrow0 = METAQ ? (8192 + bl * 16) : (bl * 2048 + qt * 128 + rg * 32);
    const int qrow = METAQ ? (qrow0 + (r32 & 15)) : (qrow0 + r32);
    bf16x8 qr[4];
    { const bf16* Qw = GQ + (size_t)qrow * 2048 + 1024 + hd * 128 + cc * 64 + hi * 8;
#pragma unroll
      for (int d0 = 0; d0 < 4; ++d0) qr[d0] = *(const GAS bf16x8*)(Qw + d0 * 16); }
    const bf16* Kh = (const bf16*)(ws + WS_KA) + hd * 128; const bf16* Vh = (const bf16*)(ws + WS_VA) + hd * 128;
    const int sr = tid >> 4, sc = (tid & 15) * 8, vst0 = v_st(sr, sc), vst1 = v_st(32 + sr, sc);
    const int vb0 = (int)(uintptr_t)V_lds + v_rd_base(lane);
    constexpr int NT = 33;
    bf16x8 vs0, vs1, ks0, ks1;
#define AROW(kt, k) ((kt) < 32 ? (bl * 2048 + (kt) * 64 + (k)) : (8192 + bl * 16 + ((k) & 15)))
#define SLOAD(kt) do { const size_t ra_ = (size_t)AROW(kt, sr) * 1024 + sc, rb_ = (size_t)AROW(kt, 32 + sr) * 1024 + sc; \
        vs0 = *(const GAS bf16x8*)(Vh + ra_); vs1 = *(const GAS bf16x8*)(Vh + rb_); ks0 = *(const GAS bf16x8*)(Kh + ra_); ks1 = *(const GAS bf16x8*)(Kh + rb_); } while (0)
#define SWRITE(b) do { *(LAS bf16x8*)(V_lds + (b) * AT_SHM_V + vst0) = vs0; *(LAS bf16x8*)(V_lds + (b) * AT_SHM_V + vst1) = vs1; const int kc_ = sc * 2; \
        *(LAS bf16x8*)(K_lds + (b) * AT_SHM_K + KSWZ(sr, kc_)) = ks0; *(LAS bf16x8*)(K_lds + (b) * AT_SHM_K + KSWZ(32 + sr, kc_)) = ks1; } while (0)
    float m_reg = -1e30f, l_reg = 0.f;
    f32x16 o[4] = {};
    SLOAD(0); SWRITE(0); SLOAD(1);
    __syncthreads();
    for (int kt = 0; kt < NT; ++kt) {
        const int b = kt & 1;
        if (kt + 1 < NT) { SWRITE(b ^ 1); if (kt + 2 < NT) SLOAD(kt + 2); }
        attn_tile(o, m_reg, l_reg, K_lds + b * AT_SHM_K + cc * 128, vb0 + b * AT_SHM_V, qr, kt == 32, al_l, r32, hi);
        __syncthreads();
    }
#undef SLOAD
#undef SWRITE
#undef AROW
    const float lam_init = 0.8f - 0.6f * expf(-0.3f * (float)layer);
    float lam;
    { const float* lv = F.A->in[6] + layer * 256; const float d1 = wave_sum(lv[lane] * lv[64 + lane]), d2 = wave_sum(lv[128 + lane] * lv[192 + lane]); lam = expf(d1) - expf(d2) + lam_init; }
    if (hi == 0) li_l[r32] = l_reg;
    asm volatile("s_waitcnt lgkmcnt(0)" ::: "memory");
    float ra[16];
#pragma unroll
    for (int r = 0; r < 16; ++r) ra[r] = __builtin_amdgcn_rcpf(li_l[crow(r, hi)]) * (cc == 1 ? lam : 1.0f);
    LAS float* X = (LAS float*)lds + rg * 4096;
    if (cc == 1) {
#pragma unroll
        for (int d = 0; d < 4; ++d)
#pragma unroll
            for (int r = 0; r < 16; ++r) X[(d * 16 + r) * 64 + lane] = o[d][r] * ra[r];
    }
    __syncthreads();
    if (cc == 0) {
#pragma unroll
        for (int r = 0; r < 16; ++r) {
            float ss = 0.f;
#pragma unroll
            for (int d = 0; d < 4; ++d) { const float v = o[d][r] * ra[r] - X[(d * 16 + r) * 64 + lane]; o[d][r] = v; ss += v * v; }
            ss = sum32(ss);
            ra[r] = (1.0f / sqrtf(ss * (1.0f / 128.0f) + NEPS)) * (1.0f - lam_init);
        }
        const float* sg = F.A->in[7] + layer * 128;
        float sgv[4];
#pragma unroll
        for (int d = 0; d < 4; ++d) sgv[d] = sg[32 * d + r32];
#pragma unroll
        for (int d = 0; d < 4; ++d)
#pragma unroll
            for (int r = 0; r < 16; ++r) X[crow(r, hi) * 128 + 32 * d + r32] = o[d][r] * ra[r] * sgv[d];
        asm volatile("s_waitcnt lgkmcnt(0)" ::: "memory");
        if ((!METAQ || rg == 0) && !dry) {
            const bf16* GAp = (const bf16*)(ws + WS_GA);
#pragma unroll
            for (int it = 0; it < 8; ++it) { const int p = it * 64 + lane, row = p >> 4, c16 = p & 15;
                if (METAQ && row >= 16) continue;
                const size_t grow = (size_t)(qrow0 + row); const int col = hd * 128 + 8 * c16;
                const v4u gt = *(const GAS v4u*)(GAp + grow * 1024 + col);
                const f32x4 x0 = *(const LAS f32x4*)(X + row * 128 + 8 * c16), x1 = *(const LAS f32x4*)(X + row * 128 + 8 * c16 + 4);
                v4u w; w.x = cvtpk(x0[0] * bflo(gt.x), x0[1] * bfhi(gt.x)); w.y = cvtpk(x0[2] * bflo(gt.y), x0[3] * bfhi(gt.y));
                w.z = cvtpk(x1[0] * bflo(gt.z), x1[1] * bfhi(gt.z)); w.w = cvtpk(x1[2] * bflo(gt.w), x1[3] * bfhi(gt.w));
                bf16* dst = dummy_out ? ((bf16*)(ws + WS_U) + (size_t)half_for_dummy * HROWS * 1024 + grow * 1024 + col) : (GQ + grow * 2048 + 1024 + col);
                *(GAS v4u*)dst = w; }
        }
    }
    __syncthreads();
}
#undef SBAR


#ifdef DBG
namespace nv {
constexpr int D = 1024, BATCH = 8, SEQ = 2048, NMETA = 16, L = SEQ + NMETA, T = BATCH * L;
constexpr int INW = 9216, MIXW = 2048, NH = 8;
constexpr float EPS = 1e-6f, F_FLOOR = 1e-30f;

__device__ __forceinline__ float wave_sum(float v) {
#pragma unroll
    for (int o = 1; o < 64; o <<= 1) v += __shfl_xor(v, o);
    return v;
}
__device__ __forceinline__ float wave_max(float v) {
#pragma unroll
    for (int o = 1; o < 64; o <<= 1) v = fmaxf(v, __shfl_xor(v, o));
    return v;
}
__device__ __forceinline__ float sigmoidf_(float z) { return 1.0f / (1.0f + expf(-z)); }
__device__ __forceinline__ float siluf_(float z) { return z / (1.0f + expf(-z)); }

__global__ void k_build_h(const float* __restrict__ x, const float* __restrict__ meta, float* __restrict__ h) {
    const size_t n4 = (size_t)T * D / 4;
    for (size_t i = blockIdx.x * (size_t)blockDim.x + threadIdx.x; i < n4; i += (size_t)gridDim.x * blockDim.x) {
        const size_t e = i * 4; const int d = (int)(e % D); const size_t row = e / D; const int b = (int)(row / L), t = (int)(row % L);
        const float4 v = t < NMETA ? *(const float4*)(meta + (size_t)t * D + d) : *(const float4*)(x + ((size_t)b * SEQ + (t - NMETA)) * D + d);
        *(float4*)(h + e) = v;
    }
}
__global__ void k_rmsnorm(const float* __restrict__ in, const float* __restrict__ g, float* __restrict__ out, int rows, int drop_meta) {
    const int wave = (blockIdx.x * blockDim.x + threadIdx.x) >> 6, lane = threadIdx.x & 63;
    if (wave >= rows) return;
    int orow = wave;
    if (drop_meta) { const int b = wave / L, t = wave % L; if (t < NMETA) return; orow = b * SEQ + (t - NMETA); }
    const float* r = in + (size_t)wave * D; float v[16]; float s = 0.f;
#pragma unroll
    for (int j = 0; j < 16; ++j) { v[j] = r[lane + 64 * j]; s += v[j] * v[j]; }
    s = wave_sum(s); const float rs = rsqrtf(s * (1.0f / D) + EPS);
#pragma unroll
    for (int j = 0; j < 16; ++j) out[(size_t)orow * D + lane + 64 * j] = v[j] * rs * g[lane + 64 * j];
}
__global__ void __launch_bounds__(256) k_gemm(const float* __restrict__ A, int lda, const float* __restrict__ B, int ldb, float* __restrict__ C, int ldc,
                                              int M, int N, int K, int accumulate) {
    __shared__ float As[16][68], Bs[16][68];
    const int tid = threadIdx.x, tx = tid & 15, ty = tid >> 4, m0 = blockIdx.y * 64, n0 = blockIdx.x * 64;
    float acc[4][4];
#pragma unroll
    for (int i = 0; i < 4; ++i)
#pragma unroll
        for (int j = 0; j < 4; ++j) acc[i][j] = 0.f;
    for (int k0 = 0; k0 < K; k0 += 16) {
        { const int r = tid >> 2, c = (tid & 3) * 4; const int gr = m0 + r; float4 a = make_float4(0.f, 0.f, 0.f, 0.f);
          if (gr < M) a = *(const float4*)(A + (size_t)gr * lda + k0 + c);
          As[c + 0][r] = a.x; As[c + 1][r] = a.y; As[c + 2][r] = a.z; As[c + 3][r] = a.w; }
        { const int r = tid >> 4, c = (tid & 15) * 4; const float4 b = *(const float4*)(B + (size_t)(k0 + r) * ldb + n0 + c);
          Bs[r][c + 0] = b.x; Bs[r][c + 1] = b.y; Bs[r][c + 2] = b.z; Bs[r][c + 3] = b.w; }
        __syncthreads();
#pragma unroll
        for (int kk = 0; kk < 16; ++kk) {
            float a[4], b[4];
#pragma unroll
            for (int i = 0; i < 4; ++i) a[i] = As[kk][ty * 4 + i];
#pragma unroll
            for (int j = 0; j < 4; ++j) b[j] = Bs[kk][tx * 4 + j];
#pragma unroll
            for (int i = 0; i < 4; ++i)
#pragma unroll
                for (int j = 0; j < 4; ++j) acc[i][j] = fmaf(a[i], b[j], acc[i][j]);
        }
        __syncthreads();
    }
#pragma unroll
    for (int i = 0; i < 4; ++i) { const int gr = m0 + ty * 4 + i; if (gr >= M) continue;
        float* cp = C + (size_t)gr * ldc + n0 + tx * 4;
        float4 o = make_float4(acc[i][0], acc[i][1], acc[i][2], acc[i][3]);
        if (accumulate) { const float4 c = *(const float4*)cp; o.x += c.x; o.y += c.y; o.z += c.z; o.w += c.w; }
        *(float4*)cp = o; }
}
__global__ void k_rope(float* __restrict__ p) {
    const int idx = blockIdx.x * blockDim.x + threadIdx.x;
    if (idx >= L * 2 * NH * 2 * 32) return;
    const int i = idx & 31, c = (idx >> 5) & 1, hd = (idx >> 6) & 7, which = (idx >> 9) & 1, t = idx >> 10;
    const float inv = powf(10000.0f, -(float)(2 * i) / 64.0f); const float ang = (float)t * inv;
    const float cs = cosf(ang), sn = sinf(ang);
    float* base = p + (size_t)t * INW + 5120 + which * 1024 + hd * 128 + c * 64;
    const float t1 = base[i], t2 = base[32 + i];
    base[i] = t1 * cs - t2 * sn; base[32 + i] = t2 * cs + t1 * sn;
}
__global__ void __launch_bounds__(256) k_hgrn(const float* __restrict__ p, int ldp, const float* __restrict__ lb_logits  , int layer,
                                              float* __restrict__ o_f, float* __restrict__ o_b) {
    __shared__ float sq[128], sf[128], sk[128], sacc[256];
    const int hd = blockIdx.x, dir = blockIdx.y, tid = threadIdx.x, v = tid & 127, kh = tid >> 7;
    float lb = 0.f;
    if (tid < 128) { if (layer == 1) { const float l0 = lb_logits[(0 * 2 + dir) * 1024 + hd * 128 + tid], l1 = lb_logits[(1 * 2 + dir) * 1024 + hd * 128 + tid];
            const float m = fmaxf(l0, l1); const float e0 = expf(l0 - m), e1 = expf(l1 - m); lb = e1 / (e0 + e1); } }
    float S[64];
#pragma unroll
    for (int k = 0; k < 64; ++k) S[k] = 0.f;
    float* out = dir == 0 ? o_f : o_b;
    for (int step = 0; step < L; ++step) {
        const int t = dir == 0 ? step : L - 1 - step;
        const float* row = p + (size_t)t * ldp;
        if (tid < 128) {
            const float z = row[(dir == 0 ? 1024 : 2048) + hd * 128 + tid];
            const float s = sigmoidf_(z), sn = sigmoidf_(-z);
            sq[tid] = row[hd * 128 + tid]; sf[tid] = lb + (1.0f - lb) * s; sk[tid] = (1.0f - lb) * sn;
        }
        const float vv = row[3072 + hd * 128 + v];
        __syncthreads();
        float acc = 0.f;
#pragma unroll
        for (int k = 0; k < 64; ++k) { const int kk = kh * 64 + k; S[k] = fmaf(sf[kk], S[k], sk[kk] * vv); acc = fmaf(S[k], sq[kk], acc); }
        sacc[tid] = acc;
        __syncthreads();
        if (tid < 128) out[(size_t)t * 1024 + hd * 128 + tid] = sacc[tid] + sacc[tid + 128];
    }
}
__global__ void k_hgrn_final(const float* __restrict__ o_f, const float* __restrict__ o_b, const float* __restrict__ p, const float* __restrict__ g, float* __restrict__ mixed) {
    const int wave = (blockIdx.x * blockDim.x + threadIdx.x) >> 6, lane = threadIdx.x & 63;
    if (wave >= L * NH) return;
    const int t = wave >> 3, hd = wave & 7;
    const size_t off = (size_t)t * 1024 + hd * 128;
    const float a0 = o_f[off + lane] + o_b[off + lane], a1 = o_f[off + 64 + lane] + o_b[off + 64 + lane];
    const float ss = wave_sum(a0 * a0 + a1 * a1); const float rs = rsqrtf(ss * (1.0f / 128.0f) + EPS);
    const float g0 = p[(size_t)t * INW + 4096 + hd * 128 + lane], g1 = p[(size_t)t * INW + 4096 + hd * 128 + 64 + lane];
    mixed[(size_t)t * MIXW + hd * 128 + lane] = a0 * rs * g[lane] * siluf_(g0);
    mixed[(size_t)t * MIXW + hd * 128 + 64 + lane] = a1 * rs * g[64 + lane] * siluf_(g1);
}
constexpr int NKP = ((L + 63) / 64) * 64;
__global__ void __launch_bounds__(128) k_attn(const float* __restrict__ p, const float* __restrict__ lamv  , const float* __restrict__ subg, int layer, float* __restrict__ mixed) {
    __shared__ float sq[2][128]; __shared__ float sp[2][NKP]; __shared__ float st[2][NKP];
    const int wid = threadIdx.x >> 6, lane = threadIdx.x & 63; const int gw = blockIdx.x * 2 + wid;
    const int t = gw >> 3, hd = gw & 7;
    const float lam_init = 0.8f - 0.6f * expf(-0.3f * (float)layer);
    float d1 = lamv[lane] * lamv[64 + lane], d2 = lamv[128 + lane] * lamv[192 + lane];
    d1 = wave_sum(d1); d2 = wave_sum(d2);
    const float lam = expf(d1) - expf(d2) + lam_init;
    const float* qrow = p + (size_t)t * INW + 5120 + hd * 128;
    sq[wid][lane] = qrow[lane]; sq[wid][64 + lane] = qrow[64 + lane];
    __syncthreads();
#pragma unroll 1
    for (int c = 0; c < 2; ++c) {
        float m = -INFINITY;
#pragma unroll 1
        for (int key = lane; key < L; key += 64) {
            const float* kr = p + (size_t)key * INW + 6144 + hd * 128 + c * 64; float a = 0.f;
#pragma unroll 4
            for (int d = 0; d < 64; d += 4) { const float4 k0 = *(const float4*)(kr + d);
                a += sq[wid][c * 64 + d] * k0.x + sq[wid][c * 64 + d + 1] * k0.y + sq[wid][c * 64 + d + 2] * k0.z + sq[wid][c * 64 + d + 3] * k0.w; }
            a *= 0.125f; st[wid][key] = a; m = fmaxf(m, a);
        }
        m = wave_max(m);
        float l = 0.f;
#pragma unroll 1
        for (int key = lane; key < L; key += 64) { const float e = expf(st[wid][key] - m); st[wid][key] = e; l += e; }
        l = wave_sum(l);
        const float sc = c == 0 ? 1.0f / l : -lam / l;
#pragma unroll 1
        for (int key = lane; key < L; key += 64) { const float v = st[wid][key] * sc; sp[wid][key] = c == 0 ? v : sp[wid][key] + v; }
    }
    __syncthreads();
    float o0 = 0.f, o1 = 0.f;
#pragma unroll 4
    for (int key = 0; key < L; ++key) { const float pd = sp[wid][key]; const float* vr = p + (size_t)key * INW + 7168 + hd * 128;
        o0 = fmaf(pd, vr[lane], o0); o1 = fmaf(pd, vr[64 + lane], o1); }
    const float ss = wave_sum(o0 * o0 + o1 * o1); const float rs = rsqrtf(ss * (1.0f / 128.0f) + EPS) * (1.0f - lam_init);
    const float g0 = p[(size_t)t * INW + 8192 + hd * 128 + lane], g1 = p[(size_t)t * INW + 8192 + hd * 128 + 64 + lane];
    mixed[(size_t)t * MIXW + 1024 + hd * 128 + lane] = o0 * rs * subg[lane] * siluf_(g0);
    mixed[(size_t)t * MIXW + 1024 + hd * 128 + 64 + lane] = o1 * rs * subg[64 + lane] * siluf_(g1);
}
}
__device__ __forceinline__ float dbg_bf(const unsigned short* a, size_t i) { return __uint_as_float((unsigned)a[i] << 16); }
__device__ __forceinline__ void dbg_acc(float& d, float& r, float v, float ref) { const float e = fabsf(v - ref); if (!(e == e)) d = 1e30f; d = fmaxf(d, e); r = fmaxf(r, fabsf(ref)); }
__global__ void dbg_check_epi(const float* __restrict__ pb5  , const unsigned char* __restrict__ ws, unsigned* __restrict__ res) {
    const int idx = blockIdx.x * blockDim.x + threadIdx.x; if (idx >= 129 * 1024) return;
    const int c = idx >> 10, ch = idx & 1023;
    const unsigned short *QDF = (const unsigned short*)(ws + WS_QDF), *KTF = (const unsigned short*)(ws + WS_KTF), *QDB = (const unsigned short*)(ws + WS_QDB), *KTB = (const unsigned short*)(ws + WS_KTB);
    const float *DECF = (const float*)(ws + WS_DECF), *DECB = (const float*)(ws + WS_DECB);
    float dq = 0.f, rq = 0.f, dk = 0.f, rk = 0.f, dd = 0.f, rd = 0.f;
    float b = 0.f;
    for (int i = 0; i < 16; ++i) { const float* pr = pb5 + (size_t)(16 * c + i) * 5120; const float q = pr[ch], z = pr[1024 + ch];
        const float f = 1.0f / (1.0f + expf(-z)), kin = 1.0f / (1.0f + expf(z)); b += logf(fmaxf(f, 1e-30f));
        const size_t row = c == 0 ? 8192 + i : 16 * (c - 1) + i;
        dbg_acc(dq, rq, dbg_bf(QDF, row * 1024 + ch), q * expf(b)); dbg_acc(dk, rk, dbg_bf(KTF, row * 1024 + ch) * expf(b), kin); }
    dbg_acc(dd, rd, DECF[(size_t)(c == 0 ? 512 : c - 1) * 1024 + ch], expf(b));
    b = 0.f;
    for (int i = 15; i >= 0; --i) { const float* pr = pb5 + (size_t)(16 * c + i) * 5120; const float q = pr[ch], z = pr[2048 + ch];
        const float f = 1.0f / (1.0f + expf(-z)), kin = 1.0f / (1.0f + expf(z)); b += logf(fmaxf(f, 1e-30f));
        const size_t row = c == 0 ? 8192 + i : 16 * (c - 1) + i;
        dbg_acc(dq, rq, dbg_bf(QDB, row * 1024 + ch), q * expf(b)); dbg_acc(dk, rk, dbg_bf(KTB, row * 1024 + ch) * expf(b), kin); }
    dbg_acc(dd, rd, DECB[(size_t)(c == 0 ? 512 : c - 1) * 1024 + ch], expf(b));
    atomicMax(res + 0, __float_as_uint(dq)); atomicMax(res + 1, __float_as_uint(rq)); atomicMax(res + 2, __float_as_uint(dk)); atomicMax(res + 3, __float_as_uint(rk));
    atomicMax(res + 4, __float_as_uint(dd)); atomicMax(res + 5, __float_as_uint(rd));
}
__global__ void dbg_check_o(const float* __restrict__ of, const float* __restrict__ ob, const unsigned char* __restrict__ ws, unsigned* __restrict__ res) {
    const unsigned short *QDF = (const unsigned short*)(ws + WS_QDF), *QDB = (const unsigned short*)(ws + WS_QDB);
    float df = 0.f, rf = 0.f, db = 0.f, rb = 0.f;
    for (int i = blockIdx.x * blockDim.x + threadIdx.x; i < 2064 * 1024; i += gridDim.x * blockDim.x) { const int t = i >> 10, c = i & 1023; const size_t row = t < 16 ? 8192 + t : t - 16;
        dbg_acc(df, rf, dbg_bf(QDF, row * 1024 + c), of[i]); dbg_acc(db, rb, dbg_bf(QDB, row * 1024 + c), ob[i]); }
    atomicMax(res + 8, __float_as_uint(df)); atomicMax(res + 9, __float_as_uint(rf)); atomicMax(res + 10, __float_as_uint(db)); atomicMax(res + 11, __float_as_uint(rb));
}

__global__ void __launch_bounds__(256) dbg_chunk_oracle(const unsigned char* __restrict__ ws, float* __restrict__ o2f, float* __restrict__ o2b) {
    __shared__ float sQ[16][128], sK[16][128], sV[16][128], sA[16][16], sO[2][16][128], sD[128];
    const int hd = blockIdx.x, dir = blockIdx.y, tid = threadIdx.x, v = tid & 127, kh = tid >> 7;
    const unsigned short* QD = (const unsigned short*)(ws + (dir == 0 ? WS_QDF : WS_QDB)); const unsigned short* KT = (const unsigned short*)(ws + (dir == 0 ? WS_KTF : WS_KTB));
    const unsigned short* VH = (const unsigned short*)(ws + WS_VH); const float* DEC = (const float*)(ws + (dir == 0 ? WS_DECF : WS_DECB));
    float* out = dir == 0 ? o2f : o2b;
    float S[64];
#pragma unroll
    for (int k = 0; k < 64; ++k) S[k] = 0.f;
    for (int step = 0; step < 129; ++step) {
        const int c = dir == 0 ? step : 128 - step; const size_t rowb = c == 0 ? 8192 : 16 * (c - 1);
        for (int i = tid; i < 16 * 128; i += 256) { const int t = i >> 7, k = i & 127; const size_t o = (rowb + t) * 1024 + hd * 128 + k;
            sQ[t][k] = dbg_bf(QD, o); sK[t][k] = dbg_bf(KT, o); sV[t][k] = dbg_bf(VH, o); }
        if (tid < 128) sD[tid] = DEC[(size_t)(c == 0 ? 512 : c - 1) * 1024 + hd * 128 + tid];
#ifdef DBG_DEC1
        if (tid < 128) sD[tid] = 0.5f;
#endif
#ifdef DBG_SFIX
#pragma unroll
        for (int k = 0; k < 64; ++k) S[k] = DBG_SFN(kh * 64 + k, v);
#endif
        __syncthreads();
        { const int t = tid >> 4, s = tid & 15; float a = 0.f; for (int k = 0; k < 128; ++k) a += sQ[t][k] * sK[s][k];
          const bool keep = dir == 0 ? (s <= t) : (s >= t); sA[t][s] = keep ? a : 0.f; }
        __syncthreads();
#pragma unroll 1
        for (int t = 0; t < 16; ++t) { float acc = 0.f;
#ifndef DBG_NOINTRA
            if (kh == 0) {
#pragma unroll 1
                for (int s = 0; s < 16; ++s) acc += sA[t][s] * sV[s][v]; }
#endif
#ifndef DBG_INTRA_ONLY
#pragma unroll
            for (int k = 0; k < 64; ++k) acc += sQ[t][kh * 64 + k] * S[k];
#endif
            sO[kh][t][v] = acc; }
        { float U[64];
#pragma unroll
          for (int k = 0; k < 64; ++k) U[k] = 0.f;
#pragma unroll 1
          for (int s = 0; s < 16; ++s) { const float vs = sV[s][v];
#pragma unroll
              for (int k = 0; k < 64; ++k) U[k] += sK[s][kh * 64 + k] * vs; }
#pragma unroll
          for (int k = 0; k < 64; ++k) S[k] = sD[kh * 64 + k] * (S[k] + U[k]); }
        __syncthreads();
        for (int i = tid; i < 16 * 128; i += 256) { const int t = i >> 7, vv = i & 127; const int tok = c * 16 + t; out[(size_t)tok * 1024 + hd * 128 + vv] = sO[0][t][vv] + sO[1][t][vv]; }
        __syncthreads();
    }
}
__global__ void dbg_check_o2(const float* __restrict__ of, const float* __restrict__ ob, const float* __restrict__ o2f, const float* __restrict__ o2b, unsigned* __restrict__ res) {
    float df = 0.f, rf = 0.f, db = 0.f, rb = 0.f;
    for (int i = blockIdx.x * blockDim.x + threadIdx.x; i < 2064 * 1024; i += gridDim.x * blockDim.x) { dbg_acc(df, rf, o2f[i], of[i]); dbg_acc(db, rb, o2b[i], ob[i]); }
    atomicMax(res + 12, __float_as_uint(df)); atomicMax(res + 13, __float_as_uint(rf)); atomicMax(res + 14, __float_as_uint(db)); atomicMax(res + 15, __float_as_uint(rb));
}
__device__ int dbg_digit(float d, float r) { const float rel = d / fmaxf(r, 1e-20f); if (!(rel == rel) || rel > 1e20f) return 9; int k = (int)floorf(-2.0f * log10f(fmaxf(rel, 1e-12f))); return k < 1 ? 1 : (k > 8 ? 8 : k); }
__global__ void dbg_report(float* __restrict__ out, int n, const unsigned* __restrict__ res, int ia, int ib) {
    for (int i = blockIdx.x * blockDim.x + threadIdx.x; i < n; i += gridDim.x * blockDim.x) out[i] = 0.f;
    if (blockIdx.x == 0 && threadIdx.x == 0) {
        const int d1 = dbg_digit(__uint_as_float(res[ia]), __uint_as_float(res[ia + 1])), d2 = dbg_digit(__uint_as_float(res[ib]), __uint_as_float(res[ib + 1]));
        out[0] = (float)(d1 * 10 + d2) * 1000.0f;
    }
}
#endif

#ifndef TYMASK
#define TYMASK 0xffu
#endif
#define TY(t) ((TYMASK >> (t)) & 1u)
#ifndef REPMASK
#define REPMASK 0u
#endif
#define NREP(t) (1 + (int)((REPMASK >> (t)) & 1u))
#ifndef PHMASK
#define PHMASK 0xffffffffu
#endif
__device__ __forceinline__ void meta_outproj(Frame& F, int task) {
    int tid_l = F.tid; asm volatile("; LAUNDER" : "+v"(tid_l));
    const int rg = task >> 4, cb = task & 15, half = rg >> 2, bl = rg & 3, lane = tid_l & 63, g = lane >> 4, i16 = lane & 15, wave = __builtin_amdgcn_readfirstlane(tid_l >> 6);
    const bf16* A = (const bf16*)(F.ws + WS_GQ) + ((size_t)half * HROWS + 8192 + bl * 16 + i16) * 2048;
    const bf16* B = (const bf16*)(F.ws + WS_WOUT) + (size_t)(cb * 64 + i16) * 2048;
    f32x4 acc[4];
#pragma unroll
    for (int nt = 0; nt < 4; ++nt) acc[nt] = (f32x4){0.f, 0.f, 0.f, 0.f};
#pragma unroll 2
    for (int kk = 0; kk < 8; ++kk) { const int k0 = wave * 256 + kk * 32 + 8 * g;
        const bf16x8 a = *(const GAS bf16x8*)(A + k0);
#pragma unroll
        for (int nt = 0; nt < 4; ++nt) { const bf16x8 b = *(const GAS bf16x8*)(B + (size_t)nt * 16 * 2048 + k0); acc[nt] = __builtin_amdgcn_mfma_f32_16x16x32_bf16(a, b, acc[nt], 0, 0, 0); } }
    LAS f32x4* red = (LAS f32x4*)F.lds;
#pragma unroll
    for (int nt = 0; nt < 4; ++nt) red[(wave * 4 + nt) * 64 + lane] = acc[nt];
    __syncthreads();
    if (wave < 4) { const int nt = wave; f32x4 s = red[nt * 64 + lane];
#pragma unroll
        for (int w = 1; w < 8; ++w) s = s + red[(w * 4 + nt) * 64 + lane];
        float* hm = (float*)(F.ws + WS_HMETA);
#pragma unroll
        for (int r = 0; r < 4; ++r) { const int j = 4 * g + r, col = cb * 64 + 16 * nt + i16; hm[(size_t)(rg * 16 + j) * 1024 + col] = F.A->in[1][(size_t)j * 1024 + col] + s[r]; } }
    __syncthreads();
}
__device__ __forceinline__ void phase_norm_mid(Frame& F) {
    const int tid = fresh_tid(), lane = tid & 63, wave = __builtin_amdgcn_readfirstlane(tid >> 6);
    const int gw = F.bid * NWAVES + wave, NGW = F.G * NWAVES; bf16* U = (bf16*)(F.ws + WS_U);
    const float* g1 = F.A->in[2] + DM; const float* hm = (const float*)(F.ws + WS_HMETA);
    for (int m = gw; m < NBATCH * SEQ + NBATCH * NMETA; m += NGW) {
        if (m < NBATCH * SEQ) { const int half = m >> 13; norm_row_to_bf16(lane, F.out + (size_t)m * DM, g1, U + ((size_t)m + half * 256) * DM, 1, 0); }
        else { const int mm = m - NBATCH * SEQ, b = mm >> 4, j = mm & 15; norm_row_to_bf16(lane, hm + (size_t)mm * DM, g1, U + ((size_t)(b >> 2) * HROWS + 8192 + (b & 3) * 16 + j) * DM, 1, 0); }
    }
}
__device__ __forceinline__ void phase_norm_final(Frame& F) {
    const int tid = fresh_tid(), lane = tid & 63, wave = __builtin_amdgcn_readfirstlane(tid >> 6);
    const int gw = F.bid * NWAVES + wave, NGW = F.G * NWAVES;
    for (int m = gw; m < NBATCH * SEQ; m += NGW) {
        GAS f32x4* xr = (GAS f32x4*)(F.out + (size_t)m * DM) + lane; const GAS f32x4* gr = (const GAS f32x4*)F.A->in[9] + lane;
        f32x4 v[4]; float s = 0.f;
#pragma unroll
        for (int j = 0; j < 4; ++j) { v[j] = xr[64 * j]; s += (v[j].x * v[j].x + v[j].y * v[j].y) + (v[j].z * v[j].z + v[j].w * v[j].w); }
        const float rs = 1.0f / sqrtf(wave_sum(s) * (1.0f / DM) + NEPS);
#pragma unroll
        for (int j = 0; j < 4; ++j) { const f32x4 gg = gr[64 * j]; xr[64 * j] = v[j] * rs * gg; }
    }
}
__device__ __forceinline__ void phase_mix(Frame& F, int layer, int half) {
    const size_t gq_half = (size_t)half * HROWS * 2048 * 2;
    #ifndef NO_SCAN
    if (F.bid < 64) {
        const int bl = F.bid >> 4, hd = (F.bid >> 1) & 7, dir = F.bid & 1;
        if (NREP(5) > 1) { const bool odry = __hip_atomic_load(F.ctl + 8, RLX_AGENT) == 0u;   hgrn_scan_item(F, bl, hd, dir, layer, odry); __syncthreads(); }
        hgrn_scan_item(F, bl, hd, dir, layer);
        asm volatile("s_waitcnt vmcnt(0)" ::: "memory");
        __syncthreads();
        if (F.tid == 0) { __builtin_amdgcn_fence(__ATOMIC_RELEASE, "agent"); asm volatile("s_waitcnt vmcnt(0)" ::: "memory");
            F.MISC[17] = __hip_atomic_fetch_add(F.ctl + CW_QUEUE + 64 * (8 + 2 * layer + half) + (bl * 8 + hd), 1u, RLX_AGENT); }
        __syncthreads();
        const bool last = F.MISC[17] == 1u;
        __syncthreads();
        if (last) {
            if (F.tid == 0) { __builtin_amdgcn_fence(__ATOMIC_ACQUIRE, "agent"); asm volatile("s_waitcnt vmcnt(0)" ::: "memory"); }
            __syncthreads();
            hgrn_finalize_item(F, gq_half, bl, hd, layer);
        }
        __syncthreads();
    }
#endif
#ifndef NO_ATTN
    const int per_pair = layer == 0 ? 17 : 16, nitems = 32 * per_pair;
    for (int rep = NREP(6) - 1; rep >= 0; --rep) {
    const bool dry = rep > 0 && __hip_atomic_load(F.ctl + 8, RLX_AGENT) == 0u;
    gu32* head = F.ctl + CW_QUEUE + 64 * (2 * layer + half) + (dry ? 4096 : 0);
    for (;;) {
        if (F.tid == 0) F.MISC[16] = __hip_atomic_fetch_add(head, 1u, RLX_AGENT);
        __syncthreads();
        const int item = (int)F.MISC[16];
        __syncthreads();
        if (item >= nitems) break;
        const int pair = item / per_pair, sub = item - pair * per_pair;
        const bool dummy = dry && NREP(7) > 1;
        if (sub == 16) attn_item<true>(F, gq_half, pair >> 3, pair & 7, 0, layer, dry && !dummy, dummy, half);
        else attn_item<false>(F, gq_half, pair >> 3, pair & 7, sub, layer, dry && !dummy, dummy, half);
    }
    }
#endif
}

constexpr int N_PHASES = 13;
#ifndef MK_N_LAUNCHES
#define MK_N_LAUNCHES 1
#endif
__global__ void __launch_bounds__(NTHREADS, 2) hymba_fwd(Args args) {
    extern __shared__ __attribute__((aligned(16))) unsigned char lds[];
    Frame F;
    F.lds = (LAS unsigned char*)lds; F.MISC = (volatile LAS unsigned*)(F.lds + MISC_OFF);
    F.tid = threadIdx.x; F.lane = F.tid & 63; F.wave = __builtin_amdgcn_readfirstlane(F.tid >> 6); F.G = gridDim.x; F.bid = blockIdx.x;
    F.ws = args.ws; F.ctl = (gu32*)(args.ws + WS_CTL); F.out = args.out;
    F.A = &args;
    for (int u = F.tid; u < (LDS_BYTES - LDSCTL_OFF) / 4; u += NTHREADS) ((LAS unsigned*)(F.lds + LDSCTL_OFF))[u] = 0u;
    __syncthreads();
    XcdBarrier bar; bar.bar = (unsigned*)(F.ctl + CW_BAR) + args.li * XCD_BAR_WORDS; bar.x = 0; bar.st = nullptr;
    const int lo = args.ph_lo, hi = args.ph_hi;
    if (hi - lo > 1) bar = xcd_barrier_post((unsigned*)(F.ctl + CW_BAR) + args.li * XCD_BAR_WORDS, F.MISC + 8);
#define IN(k) (((PHMASK >> (k)) & 1u) && lo <= (k) && (k) < hi)
#define SEAM(k) do { if (IN(k) && IN((k) + 1)) xcd_barrier(bar); } while (0)
    unsigned char* ws = args.ws;
    if (TY(0) && IN(0)) { for (int rep = 0; rep < NREP(0); ++rep) { p0_prologue(F); if (rep + 1 < NREP(0)) xcd_barrier(bar); } SEAM(0); }
#pragma unroll 1
    for (int l = 0; l < 2; ++l) {
        const int pb = 1 + 6 * l;
#pragma unroll 1
        for (int half = 0; half < 2; ++half) {
            if (TY(1) && IN(pb + 2 * half)) {
                pg8::Gemm g{(const pg8::bf16_t*)(ws + WS_U) + (size_t)half * HROWS * DM, (const pg8::bf16_t*)(ws + WS_WIN) + (size_t)l * INW * DM, HROWS, INW, DM};
                pg8::OrderIn S; S.init(HROWS, INW, F.G, F.bid);
                pg8::EpiIn E{ws, (size_t)half * HROWS * 2048 * 2, F.A->in[4], l};
                for (int rep = 0; rep < NREP(1); ++rep) { pg8::gemm_phase<pg8::EpiIn, pg8::OrderIn, true, true>(F.lds, g, S, E); if (rep + 1 < NREP(1)) xcd_barrier(bar); }
                SEAM(pb + 2 * half);
            }
            if (TY(2) && IN(pb + 2 * half + 1)) { phase_mix(F, l, half); SEAM(pb + 2 * half + 1); }
        }
        if (TY(3) && IN(pb + 4)) {
            pg8::Gemm g{(const pg8::bf16_t*)(ws + WS_GQ), (const pg8::bf16_t*)(ws + WS_WOUT) + (size_t)l * DM * 2048, NBATCH * SEQ, DM, 2048};
            pg8::OrderOut S; S.init(NBATCH * SEQ, DM, F.G, F.bid);
            pg8::EpiOut E{l == 0 ? F.A->in[0] : (const float*)F.out, F.out};
            for (int rep = 0; rep < (l == 0 ? NREP(3) : 1); ++rep) { pg8::gemm_phase<pg8::EpiOut, pg8::OrderOut, false, true>(F.lds, g, S, E);
            if (l == 0) { for (int t = F.bid; t < 128; t += F.G) meta_outproj(F, t); } if (rep + 1 < (l == 0 ? NREP(3) : 1)) xcd_barrier(bar); }
            SEAM(pb + 4);
        }
        if (TY(4) && IN(pb + 5)) { if (l == 0) { for (int rep = 0; rep < NREP(4); ++rep) { phase_norm_mid(F); if (rep + 1 < NREP(4)) xcd_barrier(bar); } SEAM(pb + 5); } else phase_norm_final(F); }
    }
#undef IN
#undef SEAM
}

extern "C" void kernel_launch(void* const* d_in, const int* in_sizes, int n_in, void* d_out, int out_size, void* d_ws, size_t ws_size, hipStream_t stream) {
    static int grid = 0;
    if (grid == 0) {
        if (n_in != 10 || in_sizes[0] != NBATCH * SEQ * DM || out_size != NBATCH * SEQ * DM || ws_size < WS_END) {
            fprintf(stderr, "kernel_launch: shape/workspace mismatch: n_in %d in0 %d out %d ws %zu (need %zu)\n", n_in, n_in > 0 ? in_sizes[0] : -1, out_size, ws_size, (size_t)WS_END); grid = -1; return; }
        int dev = 0, cus = 0;
        if (hipGetDevice(&dev) != hipSuccess || hipDeviceGetAttribute(&cus, hipDeviceAttributeMultiprocessorCount, dev) != hipSuccess) { grid = -1; return; }
        if (hipFuncSetAttribute((const void*)hymba_fwd, hipFuncAttributeMaxDynamicSharedMemorySize, LDS_BYTES) != hipSuccess) { fprintf(stderr, "kernel_launch: hipFuncSetAttribute failed\n"); grid = -1; return; }
        int per_cu = 0;
        if (hipOccupancyMaxActiveBlocksPerMultiprocessor(&per_cu, (const void*)hymba_fwd, NTHREADS, LDS_BYTES) != hipSuccess || per_cu < 1)
            fprintf(stderr, "kernel_launch: note: occupancy query reports %d workgroups per CU\n", per_cu);
        (void)hipGetLastError();
        grid = cus;
    }
    if (grid < 0) return;
#ifdef DBG
    float* dbg_pb5 = (float*)d_out; float* dbg_of = (float*)((char*)d_ws + WS_GQ + 2 * SZ_HALF); float* dbg_ob = dbg_of + (size_t)2064 * 1024;
    {   using nv::L; using nv::D; using nv::NH;
        float* hb = (float*)((char*)d_ws + WS_U + SZ_HALF); float* ub = hb + (size_t)L * D;
        const float* x = (const float*)d_in[0]; const float* meta = (const float*)d_in[1];
        (void)hipMemcpyAsync(hb, meta, (size_t)16 * D * 4, hipMemcpyDeviceToDevice, stream); (void)hipMemcpyAsync(hb + 16 * D, x, (size_t)nv::SEQ * D * 4, hipMemcpyDeviceToDevice, stream);
        nv::k_rmsnorm<<<(L + 3) / 4, 256, 0, stream>>>(hb, (const float*)d_in[2], ub, L, 0);
        nv::k_gemm<<<dim3(5120 / 64, (L + 63) / 64), 256, 0, stream>>>(ub, D, (const float*)d_in[3], nv::INW, dbg_pb5, 5120, L, 5120, D, 0);
        nv::k_hgrn<<<dim3(NH, 2), 256, 0, stream>>>(dbg_pb5, 5120, (const float*)d_in[4], 0, dbg_of, dbg_ob);
    }
#endif
    if (hipMemsetAsync((char*)d_ws + WS_CTL, 0, CTL_ZERO_BYTES, stream) != hipSuccess) { fprintf(stderr, "kernel_launch: memset failed\n"); return; }
    Args a{};
    for (int i = 0; i < 10; ++i) a.in[i] = (const float*)d_in[i];
    a.out = (float*)d_out; a.ws = (unsigned char*)d_ws;
    constexpr int NL = MK_N_LAUNCHES;
#ifdef DBG
    const int nl_run = 3;
#else
    const int nl_run = NL;
#endif
    for (int li = 0; li < nl_run; ++li) {
        a.ph_lo = NL == 1 ? 0 : li; a.ph_hi = NL == 1 ? N_PHASES : li + 1; a.li = NL == 1 ? 0 : 0;
        hipLaunchKernelGGL(hymba_fwd, dim3(grid), dim3(NTHREADS), LDS_BYTES, stream, a);
        const hipError_t le = hipPeekAtLastError();
        if (le != hipSuccess) { fprintf(stderr, "kernel_launch: launch %d failed: %s\n", li, hipGetErrorName(le)); break; }
#ifdef DBG
        if (li == 1) { dbg_check_epi<<<(129 * 1024 + 255) / 256, 256, 0, stream>>>(dbg_pb5, (const unsigned char*)d_ws, (unsigned*)d_ws + 64);
            float* o2f = (float*)((char*)d_ws + WS_U + SZ_HALF); float* o2b = o2f + (size_t)2064 * 1024;
            dbg_chunk_oracle<<<dim3(8, 2), 256, 0, stream>>>((const unsigned char*)d_ws, o2f, o2b);
            dbg_check_o2<<<1024, 256, 0, stream>>>(dbg_of, dbg_ob, o2f, o2b, (unsigned*)d_ws + 64); }
#endif
    }
#ifdef DBG
#ifdef DBG_VS_O2
    { float* o2f = (float*)((char*)d_ws + WS_U + SZ_HALF); float* o2b = o2f + (size_t)2064 * 1024; dbg_check_o<<<1024, 256, 0, stream>>>(o2f, o2b, (const unsigned char*)d_ws, (unsigned*)d_ws + 64); }
#else
    dbg_check_o<<<1024, 256, 0, stream>>>(dbg_of, dbg_ob, (const unsigned char*)d_ws, (unsigned*)d_ws + 64);
#endif
    dbg_report<<<1024, 256, 0, stream>>>((float*)d_out, out_size, (const unsigned*)d_ws + 64, DBG_IA, DBG_IB);
#endif
}
```

```cpp
#include <hip/hip_runtime.h>
#include <hip/hip_bf16.h>
#include <cstdio>
#include <cstdint>
#include <cmath>
namespace pg8 {
#define PG8_LAS __attribute__((address_space(3)))
typedef unsigned short bf16_t;
typedef short bf16x8 __attribute__((ext_vector_type(8)));
typedef float f32x4 __attribute__((ext_vector_type(4)));
typedef unsigned u32x4 __attribute__((ext_vector_type(4)));
constexpr int BM = 256, BK = 64, HALF = 128, HTB = HALF * BK * 2  , STAGE_BYTES = 8 * HTB, NXCD = 8, WGM = 8;

__host__ __device__ __forceinline__ int lds_byte(int r, int c) { const int st = (r >> 4) * 2 + (c >> 5), rr = r & 15, cc = c & 31, ob = rr * 64 + cc * 2; return st * 1024 + (ob ^ (((ob >> 9) & 1) << 5)); }
__host__ __device__ __forceinline__ void stage_rc(int b, int& R, int& C) { const int st = b / 1024, sb = b % 1024, swz = sb ^ (((sb >> 9) & 1) << 5); R = (st >> 1) * 16 + swz / 64; C = (st & 1) * 32 + (swz % 64) / 2; }
__host__ __device__ __forceinline__ int perm32(int rho) { const int n = rho >> 4, i = rho & 15; return 8 * (i >> 2) + 4 * n + (i & 3); }

struct Unit { int pm, pn; };
struct Gemm { const bf16_t* A; const bf16_t* Bt; int M, N, K; };

struct StaticOrder {
    int nM, nN, nwg, G, c;
    __host__ __device__ void init(int M, int N, int G_, int c_) { nM = M / BM; nN = N / BM; nwg = nM * nN; G = G_; c = c_; }
    __host__ __device__ bool next(int i, Unit& u) const {
        const long L = (long)i * G + c; if (L >= nwg) return false;
        int wgid = (int)L; { const int q = nwg / NXCD, r = nwg % NXCD, xcd = wgid % NXCD, off = wgid / NXCD; wgid = (xcd < r ? xcd * (q + 1) : r * (q + 1) + (xcd - r) * q) + off; }
        const int nig = WGM * nN, gid = wgid / nig, fm = gid * WGM, gsz = (nM - fm) < WGM ? (nM - fm) : WGM;
        u.pm = fm + ((wgid % nig) % gsz); u.pn = (wgid % nig) / gsz; return true;
    }
    __device__ __forceinline__ void a_ready(const Unit&) const {}
    __device__ __forceinline__ void done(const Unit&) const {}
};

__device__ __forceinline__ unsigned cvt_pk_bf16(float lo, float hi) { unsigned r; asm volatile("v_cvt_pk_bf16_f32 %0, %1, %2" : "=v"(r) : "v"(lo), "v"(hi)); return r; }
}
constexpr int DM = 1024, NBATCH = 8, SEQ = 2048, NMETA = 16, LTOK = SEQ + NMETA, NHEAD = 8, INW = 9216;
constexpr int HROWS = 8448;
constexpr int NWAVES = 8, NTHREADS = 512;
constexpr float NEPS = 1e-6f;
constexpr size_t MiB = 1u << 20;
constexpr size_t WS_CTL = 0, CTL_ZERO_BYTES = 1 * MiB;
constexpr size_t WS_ROPE = 1 * MiB;
constexpr size_t WS_HMETA = 2 * MiB;
constexpr size_t WS_WIN = 3 * MiB;
constexpr size_t WS_WOUT = WS_WIN + 36 * MiB;
constexpr size_t WS_U = WS_WOUT + 8 * MiB;
constexpr size_t SZ_HALF = (size_t)HROWS * 1024 * 2;
constexpr size_t WS_GQ = WS_U + 2 * SZ_HALF;
constexpr size_t WS_QDF = WS_GQ + 4 * SZ_HALF, WS_KTF = WS_QDF + SZ_HALF, WS_QDB = WS_KTF + SZ_HALF, WS_KTB = WS_QDB + SZ_HALF, WS_VH = WS_KTB + SZ_HALF;
constexpr size_t WS_KA = WS_VH + SZ_HALF, WS_VA = WS_KA + SZ_HALF, WS_GA = WS_VA + SZ_HALF;
constexpr size_t SZ_DEC = (size_t)(HROWS / 16) * 1024 * 4;
constexpr size_t WS_DECF = WS_GA + SZ_HALF, WS_DECB = WS_DECF + SZ_DEC, WS_END = WS_DECB + SZ_DEC;
static_assert(WS_END <= 288 * MiB, "workspace map must fit 4 x largest tensor");
constexpr int CW_BAR = 4096;
constexpr int CW_QUEUE = 16384;
constexpr int RING_BYTES = 135168, LDSCTL_OFF = RING_BYTES, MISC_OFF = LDSCTL_OFF + 320, LDS_BYTES = 151552;


namespace pg8 {
typedef unsigned u32x2 __attribute__((ext_vector_type(2)));
__device__ __forceinline__ float fexp(float x) { return __builtin_amdgcn_exp2f(x * 1.4426950408889634f); }
__device__ __forceinline__ float flog(float x) { return __builtin_amdgcn_logf(x) * 0.6931471805599453f; }
__device__ __forceinline__ float frcp(float x) { return __builtin_amdgcn_rcpf(x); }
__device__ __forceinline__ float fsilu(float z) { const float zc = fminf(fmaxf(z, -80.f), 80.f); return z * frcp(1.0f + fexp(-zc)); }
__device__ __forceinline__ float scan16(float x) {
    x += __builtin_bit_cast(float, __builtin_amdgcn_update_dpp(0, __builtin_bit_cast(int, x), 0x111, 0xf, 0xf, true));
    x += __builtin_bit_cast(float, __builtin_amdgcn_update_dpp(0, __builtin_bit_cast(int, x), 0x112, 0xf, 0xf, true));
    x += __builtin_bit_cast(float, __builtin_amdgcn_update_dpp(0, __builtin_bit_cast(int, x), 0x114, 0xf, 0xf, true));
    x += __builtin_bit_cast(float, __builtin_amdgcn_update_dpp(0, __builtin_bit_cast(int, x), 0x118, 0xf, 0xf, true));
    return x;
}
constexpr float QSCALE = 0.125f * 1.4426950408889634f;

struct EpiIn {
    static constexpr bool PERM = true, AFTER_DRAIN = false;
    unsigned char* ws;
    size_t gq_half;
    const float* lbl;
    int layer;
    __device__ __forceinline__ void operator()(const f32x4 (&acc)[2][2][4][2], const Unit& u, int wr, int wc, int fr, int fq) const {
        const int rowb = u.pm * BM + wr * 64 + fr;
        if (u.pn < 16) {
            const int ch0 = u.pn * 64 + wc * 16 + fq * 4;
            float lbf[4], lbb[4];
#pragma unroll
            for (int e = 0; e < 4; ++e) { lbf[e] = 0.f; lbb[e] = 0.f; }
            if (layer == 1) {
#pragma unroll
                for (int e = 0; e < 4; ++e) {
                    lbf[e] = frcp(1.0f + fexp(lbl[0 * 1024 + ch0 + e] - lbl[2048 + 0 * 1024 + ch0 + e]));
                    lbb[e] = frcp(1.0f + fexp(lbl[1 * 1024 + ch0 + e] - lbl[2048 + 1 * 1024 + ch0 + e]));
                }
            }
#pragma unroll
            for (int ai = 0; ai < 2; ++ai)
#pragma unroll
                for (int m = 0; m < 4; ++m) {
                    const int row = rowb + ai * HALF + m * 16; const int chunk = row >> 4;
                    const f32x4 q = acc[ai][0][m][0], zf = acc[ai][0][m][1], zb = acc[ai][1][m][0], vi = acc[ai][1][m][1];
                    float qdf[4], ktf[4], qdb[4], ktb[4], dcf[4], dcb[4];
#pragma unroll
                    for (int e = 0; e < 4; ++e) {
                        {   const float z = fminf(fmaxf(zf[e], -80.f), 80.f);
                            const float t = fexp(-z), s = frcp(1.0f + t);
                            const float f = lbf[e] + (1.0f - lbf[e]) * s, kin = (1.0f - lbf[e]) * t * s;
                            const float a = flog(fmaxf(f, 1e-30f));
                            const float b = scan16(a);
                            const float E = fexp(b);
                            qdf[e] = q[e] * E; ktf[e] = kin * fexp(fminf(-b, 80.f)); dcf[e] = E; }
                        {   const float z = fminf(fmaxf(zb[e], -80.f), 80.f);
                            const float t = fexp(-z), s = frcp(1.0f + t);
                            const float f = lbb[e] + (1.0f - lbb[e]) * s, kin = (1.0f - lbb[e]) * t * s;
                            const float a = flog(fmaxf(f, 1e-30f));
                            const float b = scan16(a);
                            const float tot = __shfl(b, 15, 16);
                            const float bb = tot - b + a;
                            const float E = fexp(bb);
                            qdb[e] = q[e] * E; ktb[e] = kin * fexp(fminf(-bb, 80.f)); dcb[e] = E; }
                    }
                    unsigned char* o = ws + ((size_t)row * 1024 + ch0) * 2;
                    *(u32x2*)(o + WS_QDF) = (u32x2){cvt_pk_bf16(qdf[0], qdf[1]), cvt_pk_bf16(qdf[2], qdf[3])};
                    *(u32x2*)(o + WS_KTF) = (u32x2){cvt_pk_bf16(ktf[0], ktf[1]), cvt_pk_bf16(ktf[2], ktf[3])};
                    *(u32x2*)(o + WS_QDB) = (u32x2){cvt_pk_bf16(qdb[0], qdb[1]), cvt_pk_bf16(qdb[2], qdb[3])};
                    *(u32x2*)(o + WS_KTB) = (u32x2){cvt_pk_bf16(ktb[0], ktb[1]), cvt_pk_bf16(ktb[2], ktb[3])};
                    *(u32x2*)(o + WS_VH)  = (u32x2){cvt_pk_bf16(vi[0], vi[1]), cvt_pk_bf16(vi[2], vi[3])};
                    if (fr == 15 || fr == 0) { const bool fw = fr == 15;
                        *(f32x4*)(ws + (fw ? WS_DECF : WS_DECB) + ((size_t)chunk * 1024 + ch0) * 4) = fw ? (f32x4){dcf[0], dcf[1], dcf[2], dcf[3]} : (f32x4){dcb[0], dcb[1], dcb[2], dcb[3]}; }
                    asm volatile("" ::: "memory");
                }
        } else if (u.pn >= 20 && u.pn < 28) {
            const bool isq = u.pn < 24;
            const int colt = (u.pn - (isq ? 20 : 24)) * BM + wc * 32 + 8 * fq;
            const float sc = isq ? QSCALE : 1.0f;
            unsigned char* base = ws + (isq ? (WS_GQ + gq_half + 2048) : WS_KA); const int ld = isq ? 2048 : 1024;
#pragma unroll
            for (int ai = 0; ai < 2; ++ai)
#pragma unroll
                for (int m = 0; m < 4; ++m) {
                    const int row = rowb + ai * HALF + m * 16;
                    const int tpos = row < 8192 ? 16 + (row & 2047) : ((row - 8192) & 15);
                    const float* rp = (const float*)(ws + WS_ROPE) + (size_t)tpos * 64;
#pragma unroll
                    for (int bj = 0; bj < 2; ++bj) {
                        const int col = colt + bj * HALF;
                        const int i0 = (col & 63) >> 1;
                        const f32x4 cs0 = *(const f32x4*)(rp + 2 * i0), cs1 = *(const f32x4*)(rp + 2 * i0 + 4);
                        const f32x4 a = acc[ai][bj][m][0], b = acc[ai][bj][m][1];
                        const float o0 = a[0] * cs0[0] - a[1] * cs0[1], o1 = a[1] * cs0[0] + a[0] * cs0[1];
                        const float o2 = a[2] * cs0[2] - a[3] * cs0[3], o3 = a[3] * cs0[2] + a[2] * cs0[3];
                        const float o4 = b[0] * cs1[0] - b[1] * cs1[1], o5 = b[1] * cs1[0] + b[0] * cs1[1];
                        const float o6 = b[2] * cs1[2] - b[3] * cs1[3], o7 = b[3] * cs1[2] + b[2] * cs1[3];
                        u32x4 w; w.x = cvt_pk_bf16(o0 * sc, o1 * sc); w.y = cvt_pk_bf16(o2 * sc, o3 * sc); w.z = cvt_pk_bf16(o4 * sc, o5 * sc); w.w = cvt_pk_bf16(o6 * sc, o7 * sc);
                        *(u32x4*)(base + ((size_t)row * ld + col) * 2) = w;
                    }
                    asm volatile("" ::: "memory");
                }
        } else {
            const bool isg = u.pn < 20, isv = (u.pn >= 28 && u.pn < 32);
            const int colt = (u.pn - (isg ? 16 : (isv ? 28 : 32))) * BM + wc * 32 + 8 * fq;
            unsigned char* base = ws + (isg ? (WS_GQ + gq_half) : (isv ? WS_VA : WS_GA)); const int ld = isg ? 2048 : 1024;
#pragma unroll
            for (int ai = 0; ai < 2; ++ai)
#pragma unroll
                for (int m = 0; m < 4; ++m) {
                    const int row = rowb + ai * HALF + m * 16;
#pragma unroll
                    for (int bj = 0; bj < 2; ++bj) {
                        f32x4 a = acc[ai][bj][m][0], b = acc[ai][bj][m][1];
                        if (!isv) {
#pragma unroll
                            for (int e = 0; e < 4; ++e) { a[e] = fsilu(a[e]); b[e] = fsilu(b[e]); }
                        }
                        u32x4 w; w.x = cvt_pk_bf16(a[0], a[1]); w.y = cvt_pk_bf16(a[2], a[3]); w.z = cvt_pk_bf16(b[0], b[1]); w.w = cvt_pk_bf16(b[2], b[3]);
                        *(u32x4*)(base + ((size_t)row * ld + colt + bj * HALF) * 2) = w;
                    }
                    asm volatile("" ::: "memory");
                }
        }
    }
};
struct EpiOut {
    static constexpr bool PERM = false, AFTER_DRAIN = false;
    const float* hin; float* hout;
    __device__ __forceinline__ void operator()(const f32x4 (&acc)[2][2][4][2], const Unit& u, int wr, int wc, int fr, int fq) const {
        const int rowb = u.pm * BM + wr * 64 + fr, colb = u.pn * BM + wc * 32 + 4 * fq;
#pragma unroll
        for (int ai = 0; ai < 2; ++ai)
#pragma unroll
            for (int m = 0; m < 4; ++m) {
                const size_t ro = (size_t)(rowb + ai * HALF + m * 16) * 1024;
#pragma unroll
                for (int bj = 0; bj < 2; ++bj)
#pragma unroll
                    for (int n = 0; n < 2; ++n) {
                        const size_t o = ro + colb + bj * HALF + n * 16;
                        const f32x4 hv = *(const f32x4*)(hin + o);
                        *(f32x4*)(hout + o) = hv + acc[ai][bj][m][n];
                    }
            }
    }
};
struct OrderIn : StaticOrder { __device__ __forceinline__ size_t arow(int pm) const { return (size_t)pm * BM; } };
struct OrderOut : StaticOrder { __device__ __forceinline__ size_t arow(int pm) const { return (size_t)(pm >> 5) * 8448 + (size_t)(pm & 31) * BM; } };

template <class Epi, class Sched, bool ALIGN_EPI = false, bool SP2 = false>
__device__ __forceinline__ void gemm_phase(PG8_LAS unsigned char* lds, const Gemm g, const Sched& S, const Epi& E) {
    int tid_l = threadIdx.x; asm volatile("; LAUNDER" : "+v"(tid_l));
    const int tid = tid_l, wid = __builtin_amdgcn_readfirstlane(tid >> 6), lane = tid & 63, wr = wid >> 2, wc = wid & 3, fr = lane & 15, fq = lane >> 4;
    const int K = g.K, nt = K / BK;
    unsigned voffA[2], voffB[2];
#pragma unroll
    for (int i = 0; i < 2; ++i) { int R, C; stage_rc(tid * 16 + i * 8192, R, C); const int Rb = Epi::PERM ? ((R & ~31) + perm32(R & 31)) : R;
        voffA[i] = (unsigned)(R * K + C) * 2u; voffB[i] = (unsigned)(Rb * K + C) * 2u; }
    const size_t kstep = (size_t)(BK * 2);
    const size_t hstep = (size_t)HALF * K * 2;
    const size_t tstep = 2 * hstep;
    const unsigned ldsw = (unsigned)wid * 1024u;
    const int aoff = lds_byte(wr * 64 + fr, fq * 8), boff = lds_byte(wc * 32 + fr, fq * 8);
#define PG8_SA(b, h) (((b) * 2 + (h)) * HTB)
#define PG8_SB(b, h) ((4 + (b) * 2 + (h)) * HTB)
#define PG8_STAGE(bufoff, gbase, voff) do { _Pragma("unroll") for (int _i = 0; _i < 2; ++_i) \
        __builtin_amdgcn_global_load_lds((const unsigned*)((const char*)(gbase) + (voff)[_i]), (PG8_LAS unsigned*)(lds + (bufoff) + ldsw + _i * 8192), 16, 0, 0); } while (0)
#define PG8_LDA(dst, b, h) do { _Pragma("unroll") for (int m = 0; m < 4; ++m) _Pragma("unroll") for (int k = 0; k < 2; ++k) dst[m][k] = *(const PG8_LAS bf16x8*)(lds + PG8_SA(b, h) + aoff + m * 2048 + k * 1024); } while (0)
#define PG8_LDB(dst, b, h) do { _Pragma("unroll") for (int n = 0; n < 2; ++n) _Pragma("unroll") for (int k = 0; k < 2; ++k) dst[n][k] = *(const PG8_LAS bf16x8*)(lds + PG8_SB(b, h) + boff + n * 2048 + k * 1024); } while (0)
#define PG8_MMA(ai, bj, At, Bt) do { __builtin_amdgcn_s_setprio(1); _Pragma("unroll") for (int m = 0; m < 4; ++m) _Pragma("unroll") for (int n = 0; n < 2; ++n) _Pragma("unroll") for (int k = 0; k < 2; ++k) \
        acc[ai][bj][m][n] = __builtin_amdgcn_mfma_f32_16x16x32_bf16(Bt[n][k], At[m][k], acc[ai][bj][m][n], 0, 0, 0); __builtin_amdgcn_s_setprio(0); } while (0)
#define PG8_WAIT_V(n) asm volatile("s_waitcnt vmcnt(" #n ")" ::: "memory")
#define PG8_WAIT_L(n) asm volatile("s_waitcnt lgkmcnt(" #n ")" ::: "memory")
#define PG8_BAR __builtin_amdgcn_s_barrier()
#define PG8_SCHED __builtin_amdgcn_sched_barrier(0)
    Unit cur, nxt; int ui = 0;
    if (!S.next(0, cur)) return;
    f32x4 acc[2][2][4][2];
#pragma unroll
    for (int a = 0; a < 2; ++a)
#pragma unroll
        for (int b = 0; b < 2; ++b)
#pragma unroll
            for (int m = 0; m < 4; ++m)
#pragma unroll
                for (int n = 0; n < 2; ++n) acc[a][b][m][n] = (f32x4){0.f, 0.f, 0.f, 0.f};
    bf16x8 At[4][2], B0[2][2], B1[2][2];
    const char* cA = (const char*)g.A + S.arow(cur.pm) * (size_t)(K * 2); const char* cB = (const char*)g.Bt + (size_t)cur.pn * tstep;
    S.a_ready(cur);
    if constexpr (SP2) {
        PG8_STAGE(PG8_SB(0, 0), cB, voffB); PG8_STAGE(PG8_SB(0, 1), cB + hstep, voffB); PG8_STAGE(PG8_SA(0, 0), cA, voffA); PG8_STAGE(PG8_SA(0, 1), cA + hstep, voffA);
        if (wr == 1) PG8_BAR;
        PG8_WAIT_V(2); PG8_BAR;
        PG8_STAGE(PG8_SB(1, 0), cB + kstep, voffB); PG8_STAGE(PG8_SA(1, 0), cA + kstep, voffA); PG8_STAGE(PG8_SB(1, 1), cB + hstep + kstep, voffB);
        PG8_WAIT_V(6); PG8_BAR;
    } else {
        PG8_STAGE(PG8_SB(0, 0), cB, voffB); PG8_STAGE(PG8_SA(0, 0), cA, voffA); PG8_STAGE(PG8_SB(0, 1), cB + hstep, voffB); PG8_STAGE(PG8_SA(0, 1), cA + hstep, voffA);
        if (wr == 1) PG8_BAR;
        PG8_WAIT_V(4); PG8_BAR;
        PG8_STAGE(PG8_SB(1, 0), cB + kstep, voffB); PG8_STAGE(PG8_SA(1, 0), cA + kstep, voffA); PG8_STAGE(PG8_SB(1, 1), cB + hstep + kstep, voffB);
        PG8_WAIT_V(6); PG8_BAR;
    }
    for (;;) {
        const bool has_next = S.next(ui + 1, nxt);
        const char* nA = has_next ? (const char*)g.A + S.arow(nxt.pm) * (size_t)(K * 2) : cA; const char* nB = has_next ? (const char*)g.Bt + (size_t)nxt.pn * tstep : cB;
        for (int t = 0; t < nt; t += 2) {
            const bool last = (t == nt - 2);
            const char* a1 = cA + (size_t)(t + 1) * kstep;
            const char* a2 = last ? nA : cA + (size_t)(t + 2) * kstep; const char* b2 = last ? nB : cB + (size_t)(t + 2) * kstep;
            const char* a3 = a2 + kstep; const char* b3 = b2 + kstep;
            if (last && has_next) S.a_ready(nxt);
            if constexpr (SP2) {
            PG8_LDB(B0, 0, 0); PG8_LDB(B1, 0, 1); PG8_SCHED; PG8_LDA(At, 0, 0); PG8_STAGE(PG8_SA(1, 1), a1 + hstep, voffA);
            PG8_WAIT_V(8); PG8_WAIT_L(0); PG8_BAR; PG8_MMA(0, 0, At, B0); PG8_MMA(0, 1, At, B1); PG8_BAR; PG8_SCHED;
            PG8_LDA(At, 0, 1); PG8_STAGE(PG8_SB(0, 0), b2, voffB); PG8_STAGE(PG8_SB(0, 1), b2 + hstep, voffB); PG8_STAGE(PG8_SA(0, 0), a2, voffA);
            PG8_WAIT_V(8); PG8_WAIT_L(0); PG8_BAR; PG8_MMA(1, 0, At, B0); PG8_MMA(1, 1, At, B1); PG8_BAR; PG8_SCHED;
            PG8_LDB(B0, 1, 0); PG8_LDB(B1, 1, 1); PG8_SCHED; PG8_LDA(At, 1, 0); PG8_STAGE(PG8_SA(0, 1), a2 + hstep, voffA);
            PG8_WAIT_V(8); PG8_WAIT_L(0); PG8_BAR; PG8_MMA(0, 0, At, B0); PG8_MMA(0, 1, At, B1); PG8_BAR; PG8_SCHED;
            PG8_LDA(At, 1, 1); PG8_STAGE(PG8_SB(1, 0), b3, voffB); PG8_STAGE(PG8_SB(1, 1), b3 + hstep, voffB); PG8_STAGE(PG8_SA(1, 0), a3, voffA);
            PG8_WAIT_V(8); PG8_WAIT_L(0); PG8_BAR; PG8_MMA(1, 0, At, B0); PG8_MMA(1, 1, At, B1); PG8_BAR; PG8_SCHED;
            } else {
            PG8_LDB(B0, 0, 0); PG8_SCHED; PG8_LDA(At, 0, 0); PG8_STAGE(PG8_SA(1, 1), a1 + hstep, voffA);
            PG8_WAIT_L(8); PG8_BAR; PG8_WAIT_L(0); PG8_MMA(0, 0, At, B0); PG8_BAR; PG8_SCHED;
            PG8_LDB(B1, 0, 1); PG8_STAGE(PG8_SB(0, 0), b2, voffB);
            PG8_BAR; PG8_WAIT_L(0); PG8_MMA(0, 1, At, B1); PG8_BAR;
            PG8_LDA(At, 0, 1); PG8_STAGE(PG8_SA(0, 0), a2, voffA);
            PG8_BAR; PG8_WAIT_L(0); PG8_MMA(1, 0, At, B0); PG8_BAR; PG8_SCHED;
            PG8_STAGE(PG8_SB(0, 1), b2 + hstep, voffB);
            PG8_WAIT_V(6); PG8_BAR; PG8_MMA(1, 1, At, B1); PG8_BAR;
            PG8_LDB(B0, 1, 0); PG8_SCHED; PG8_LDA(At, 1, 0); PG8_STAGE(PG8_SA(0, 1), a2 + hstep, voffA);
            PG8_WAIT_L(8); PG8_BAR; PG8_WAIT_L(0); PG8_MMA(0, 0, At, B0); PG8_BAR; PG8_SCHED;
            PG8_LDB(B1, 1, 1); PG8_STAGE(PG8_SB(1, 0), b3, voffB);
            PG8_BAR; PG8_WAIT_L(0); PG8_MMA(0, 1, At, B1); PG8_BAR;
            PG8_LDA(At, 1, 1); PG8_STAGE(PG8_SA(1, 0), a3, voffA);
            PG8_BAR; PG8_WAIT_L(0); PG8_MMA(1, 0, At, B0); PG8_BAR; PG8_SCHED;
            PG8_STAGE(PG8_SB(1, 1), b3 + hstep, voffB);
            PG8_WAIT_V(6); PG8_BAR; PG8_MMA(1, 1, At, B1); PG8_BAR;
            }
        }
        if constexpr (ALIGN_EPI) { if (wr == 0) PG8_BAR; }
        if constexpr (!Epi::AFTER_DRAIN) { E(acc, cur, wr, wc, fr, fq); S.done(cur); }
        if (!has_next) break;
#pragma unroll
        for (int a = 0; a < 2; ++a)
#pragma unroll
            for (int b = 0; b < 2; ++b)
#pragma unroll
                for (int m = 0; m < 4; ++m)
#pragma unroll
                    for (int n = 0; n < 2; ++n) acc[a][b][m][n] = (f32x4){0.f, 0.f, 0.f, 0.f};
        cur = nxt; cA = nA; cB = nB; ++ui;
        if constexpr (ALIGN_EPI) { if (wr == 1) PG8_BAR; }
    }
    PG8_WAIT_V(0);
    if constexpr (!ALIGN_EPI) { if (wr == 0) PG8_BAR; }
    PG8_BAR;
    if constexpr (Epi::AFTER_DRAIN) { E.fused(acc, cur, wr, wc, fr, fq, lds, wid, lane); S.done(cur); }
#undef PG8_SA
#undef PG8_SB
#undef PG8_STAGE
#undef PG8_LDA
#undef PG8_LDB
#undef PG8_MMA
#undef PG8_WAIT_V
#undef PG8_WAIT_L
#undef PG8_BAR
#undef PG8_SCHED
}
}

#define GAS __attribute__((address_space(1)))
#define LAS __attribute__((address_space(3)))
typedef unsigned short bf16;
typedef unsigned v4u __attribute__((ext_vector_type(4)));
typedef float f32x4 __attribute__((ext_vector_type(4)));
typedef short bf16x8 __attribute__((ext_vector_type(8)));
typedef GAS unsigned gu32;
typedef GAS unsigned long long gu64;
#define RLX_AGENT __ATOMIC_RELAXED, __HIP_MEMORY_SCOPE_AGENT
#define LDS_WAIT() asm volatile("s_waitcnt lgkmcnt(0)" ::: "memory")
#define VM_WAIT() asm volatile("s_waitcnt vmcnt(0)" ::: "memory")
__device__ __forceinline__ unsigned long long rt() { return __builtin_amdgcn_s_memrealtime(); }
__device__ __forceinline__ unsigned f2bf(float f) { unsigned u = __builtin_bit_cast(unsigned, f); return (u + 0x7fffu + ((u >> 16) & 1u)) >> 16; }
__device__ __forceinline__ unsigned pk2(float lo, float hi) { return f2bf(lo) | (f2bf(hi) << 16); }

#define XB_TMO      128
#define XB_XCNT(j)  (256  + 64 * (j))
#define XB_XSUB(j)  (1280 + 64 * (j))
#define XB_XGEN(j)  (2304 + 64 * (j))
#define XB_TOP      3328
#define XB_TOPGEN   3392
#define XCD_BAR_WORDS 3456
#define XB_SPIN_CAP (1u << 18)

__device__ __forceinline__ unsigned xb_ld(unsigned* p)              { return __hip_atomic_load(p, __ATOMIC_RELAXED, __HIP_MEMORY_SCOPE_AGENT); }
__device__ __forceinline__ unsigned xb_add(unsigned* p, unsigned v) { return __hip_atomic_fetch_add(p, v, __ATOMIC_RELAXED, __HIP_MEMORY_SCOPE_AGENT); }
__device__ __forceinline__ unsigned xb_xcc_id() { return (unsigned)__builtin_amdgcn_s_getreg((3 << 11) | 20) & 0xFu; }
#define XB_SPIN(cond, bar) do { unsigned _sp = 0; while (cond) { __builtin_amdgcn_s_sleep(1); \
    if ((++_sp & 255u) == 0u) { if (xb_ld(&(bar)[XB_TMO])) break; if (_sp > XB_SPIN_CAP) { atomicAdd(&(bar)[XB_TMO], 1u); break; } } } } while (0)

struct XcdBarrier {
    unsigned* bar; unsigned x;
    volatile LAS unsigned* st;
};

__device__ __forceinline__ XcdBarrier xcd_barrier_post(unsigned* bar, volatile LAS unsigned* st) {
    XcdBarrier b; b.bar = bar; b.x = xb_xcc_id(); b.st = st;
    if (threadIdx.x == 0) (void)xb_add(&bar[XB_XCNT(b.x)], 1u);
    return b;
}
__device__ __forceinline__ void xcd_barrier_complete(unsigned* bar, unsigned x, unsigned& nloc, unsigned& nx) {
    const unsigned G = gridDim.x * gridDim.y * gridDim.z;
    unsigned sum, cnt, mine, sp = 0u;
    for (;;) {
        sum = 0u; cnt = 0u; mine = 0u;
#pragma unroll
        for (unsigned j = 0; j < 16; ++j) { const unsigned c = xb_ld(&bar[XB_XCNT(j)]); sum += c; cnt += (c > 0u) ? 1u : 0u; mine = (j == x) ? c : mine; }
        if (sum == G) break;
        __builtin_amdgcn_s_sleep(1);
        if ((++sp & 255u) == 0u) { if (xb_ld(&bar[XB_TMO])) break; if (sp > XB_SPIN_CAP) { atomicAdd(&bar[XB_TMO], 1u); break; } }
    }
    nloc = mine > 0u ? mine : 1u; nx = cnt > 0u ? cnt : 1u;
}

__device__ __forceinline__ void xcd_barrier(const XcdBarrier& b) {
    asm volatile("s_waitcnt vmcnt(0)" ::: "memory");
    __syncthreads();
    if (threadIdx.x == 0) {
        unsigned* bar = b.bar;
        __builtin_amdgcn_s_waitcnt(0);
        unsigned nloc = b.st[0], nx = b.st[1];
        if (nloc == 0u) { xcd_barrier_complete(bar, b.x, nloc, nx); b.st[0] = nloc; b.st[1] = nx; }
        const unsigned old = xb_add(&bar[XB_XSUB(b.x)], 1u);
        const unsigned gen = old / nloc;
        if (old + 1u == (gen + 1u) * nloc) {
            __builtin_amdgcn_fence(__ATOMIC_RELEASE, "agent");
            asm volatile("s_waitcnt vmcnt(0)" ::: "memory");
            const unsigned og = xb_add(&bar[XB_TOP], 1u);
            const unsigned tg = og / nx;
            if (og + 1u == (tg + 1u) * nx) xb_add(&bar[XB_TOPGEN], 1u);
            else XB_SPIN(xb_ld(&bar[XB_TOPGEN]) == tg, bar);
            __builtin_amdgcn_fence(__ATOMIC_ACQUIRE, "agent");
            xb_add(&bar[XB_XGEN(b.x)], 1u);
            asm volatile("s_waitcnt vmcnt(0)" ::: "memory");
        } else {
            XB_SPIN(xb_ld(&bar[XB_XGEN(b.x)]) == gen, bar);
            __builtin_amdgcn_fence(__ATOMIC_ACQUIRE, "agent");
            asm volatile("s_waitcnt vmcnt(0)" ::: "memory");
        }
    }
    __syncthreads();
}

typedef short s16x4 __attribute__((ext_vector_type(4)));
typedef float f32x16 __attribute__((ext_vector_type(16)));
typedef unsigned u32x2v __attribute__((ext_vector_type(2)));
__device__ __forceinline__ unsigned cvtpk(float lo, float hi) { typedef float f2_t __attribute__((ext_vector_type(2))); typedef __bf16 b2_t __attribute__((ext_vector_type(2)));
    const f2_t v = {lo, hi}; const b2_t b = __builtin_convertvector(v, b2_t); return __builtin_bit_cast(unsigned, b); }
__device__ __forceinline__ float bf2f(unsigned short v) { return __uint_as_float((unsigned)v << 16); }
__device__ __forceinline__ float bflo(unsigned w) { return __uint_as_float(w << 16); }
__device__ __forceinline__ float bfhi(unsigned w) { return __uint_as_float(w & 0xffff0000u); }
__device__ __forceinline__ float wave_sum(float v) {
#pragma unroll
    for (int o = 1; o < 64; o <<= 1) v += __shfl_xor(v, o);
    return v;
}
__device__ __forceinline__ float sum16(float v) {
#pragma unroll
    for (int o = 1; o < 16; o <<= 1) v += __shfl_xor(v, o);
    return v;
}
__device__ __forceinline__ float sum32(float v) {
#pragma unroll
    for (int o = 1; o < 32; o <<= 1) v += __shfl_xor(v, o);
    return v;
}

struct Args { const float* in[10]; float* out; unsigned char* ws; int ph_lo, ph_hi, li, pad; };
struct Frame {
    LAS unsigned char* lds; volatile LAS unsigned* MISC; gu32* ctl; int tid, lane, wave, G, bid;
    const Args* A;
    float* out; unsigned char* ws;
};

__device__ __forceinline__ int fresh_tid() { int t = threadIdx.x; asm volatile("; LAUNDER" : "+v"(t)); return t; }
__device__ __forceinline__ int dst_col(int c) {
    const int g = c >> 10, j = c & 1023;
    if (g < 4) { const int th = j >> 6, cc = j & 63, wc = cc >> 4, fq = (cc >> 2) & 3, e = cc & 3, bj = g >> 1, n = g & 1; return 256 * th + 128 * bj + 32 * wc + 8 * fq + 4 * n + e; }
    if (g == 5 || g == 6) { const int d = j & 63, i = d & 31, hf = d >> 5; return g * 1024 + (j & ~63) + 2 * i + hf; }
    return c;
}
template <bool PERMUTE>
__device__ __forceinline__ void p0_transpose_item(const float* W, int K, int N, bf16* WT, LAS float* scr, int item, int lane) {
    const int nblk = N / 32, kb = item / nblk, nb = item % nblk, k0 = 64 * kb, n0 = 32 * nb;
#pragma unroll 8
    for (int i = 0; i < 32; ++i) { const int kk = 2 * i + (lane >> 5); scr[kk * 33 + (lane & 31)] = W[(size_t)(k0 + kk) * N + n0 + (lane & 31)]; }
    LDS_WAIT(); asm volatile("" ::: "memory");
    const int c = lane & 7;
#pragma unroll
    for (int j = 0; j < 4; ++j) { const int n = (lane >> 3) + 8 * j; const LAS float* s = scr + (8 * c) * 33 + n;
        v4u o; o.x = pk2(s[0 * 33], s[1 * 33]); o.y = pk2(s[2 * 33], s[3 * 33]); o.z = pk2(s[4 * 33], s[5 * 33]); o.w = pk2(s[6 * 33], s[7 * 33]);
        const int drow = PERMUTE ? dst_col(n0 + n) : (n0 + n);
        *(GAS v4u*)(WT + (size_t)drow * K + k0 + 8 * c) = o; }
    LDS_WAIT(); asm volatile("" ::: "memory");
}
__device__ __forceinline__ void norm_row_to_bf16(int lane, const float* xrow, const float* g, bf16* orow, int ncopy, size_t cstride) {
    const GAS f32x4* xr = (const GAS f32x4*)xrow + lane; const GAS f32x4* gr = (const GAS f32x4*)g + lane;
    f32x4 v[4]; float s = 0.f;
#pragma unroll
    for (int j = 0; j < 4; ++j) { v[j] = xr[64 * j]; s += (v[j].x * v[j].x + v[j].y * v[j].y) + (v[j].z * v[j].z + v[j].w * v[j].w); }
    const float rs = 1.0f / sqrtf(wave_sum(s) * (1.0f / DM) + NEPS);
    unsigned long long w[4];
#pragma unroll
    for (int j = 0; j < 4; ++j) { const f32x4 gg = gr[64 * j]; w[j] = (unsigned long long)pk2(v[j].x * rs * gg.x, v[j].y * rs * gg.y) | ((unsigned long long)pk2(v[j].z * rs * gg.z, v[j].w * rs * gg.w) << 32); }
    for (int c = 0; c < ncopy; ++c) { GAS unsigned long long* o8 = (GAS unsigned long long*)(orow + (size_t)c * cstride) + lane;
#pragma unroll
        for (int j = 0; j < 4; ++j) o8[64 * j] = w[j]; }
}
__device__ __forceinline__ void p0_prologue(Frame& F) {
    const int tid = fresh_tid(), lane = tid & 63, wave = __builtin_amdgcn_readfirstlane(tid >> 6);
    LAS float* scr = (LAS float*)(F.lds + wave * 16384);
    const int gw = F.bid * NWAVES + wave, NGW = F.G * NWAVES;
    constexpr int I_IN = (DM / 64) * (INW / 32), I_OUT = (2048 / 64) * (DM / 32);
    constexpr int NITEMS = 2 * (I_IN + I_OUT);
    bf16* win = (bf16*)(F.ws + WS_WIN); bf16* wout = (bf16*)(F.ws + WS_WOUT);
    for (int it = gw; it < NITEMS; it += NGW) {
        int r = it; const int l = r / (I_IN + I_OUT); r -= l * (I_IN + I_OUT);
        if (r < I_IN) p0_transpose_item<true>(F.A->in[3] + (size_t)l * DM * INW, DM, INW, win + (size_t)l * INW * DM, scr, r, lane);
        else p0_transpose_item<false>(F.A->in[8] + (size_t)l * 2048 * DM, 2048, DM, wout + (size_t)l * DM * 2048, scr, r - I_IN, lane);
    }
    { float* rope = (float*)(F.ws + WS_ROPE);
      for (int idx = F.bid * NTHREADS + tid; idx < LTOK * 32; idx += F.G * NTHREADS) { const int t = idx >> 5, i = idx & 31;
          const float inv = powf(10000.0f, -(float)(2 * i) / 64.0f), ang = (float)t * inv; rope[2 * idx] = cosf(ang); rope[2 * idx + 1] = sinf(ang); } }
    bf16* U = (bf16*)(F.ws + WS_U);
    for (int m = gw; m < NBATCH * SEQ + NMETA; m += NGW) {
        if (m < NBATCH * SEQ) { const int half = m >> 13; norm_row_to_bf16(lane, F.A->in[0] + (size_t)m * DM, F.A->in[2], U + ((size_t)m + half * 256) * DM, 1, 0); }
        else { const int j = m - NBATCH * SEQ;
            norm_row_to_bf16(lane, F.A->in[1] + (size_t)j * DM, F.A->in[2], U + ((size_t)8192 + j) * DM, 4, (size_t)16 * DM);
            norm_row_to_bf16(lane, F.A->in[1] + (size_t)j * DM, F.A->in[2], U + ((size_t)HROWS + 8192 + j) * DM, 4, (size_t)16 * DM); }
    }
}

constexpr int SC_PITCH = 272;
constexpr int SC_TILE = 16 * SC_PITCH;
constexpr int SC_DEC = 3 * SC_TILE;
constexpr int SC_CH = SC_DEC + 512;
constexpr int SC_BUF = 2 * SC_CH;
constexpr int SC_NPOS = 129, SC_NMAC = 65;
__device__ __forceinline__ s16x4 tr16(const LAS unsigned char* p) {
    typedef short v4i16_t __attribute__((ext_vector_type(4)));
    return __builtin_bit_cast(s16x4, __builtin_amdgcn_ds_read_tr16_b64_v4i16((LAS v4i16_t*)p));
}
__device__ __forceinline__ int scan_rowbase(int bl, int c) { return c == 0 ? 8192 + bl * 16 : bl * 2048 + 16 * (c - 1); }
struct ScanSet { bf16x8 a0, b0, a1, b1; f32x4 d0, d1; };

__device__ __forceinline__ void hgrn_scan_item(Frame& F, int bl, int hd, int dir, int layer, bool dry = false) {
    int tid_l = F.tid; asm volatile("; LAUNDER" : "+v"(tid_l));
    const int tid = tid_l, lane = tid & 63, vs = __builtin_amdgcn_readfirstlane(tid >> 6), g = lane >> 4, i16 = lane & 15;
    LAS unsigned char* lds = F.lds;
    unsigned char* const ws = F.ws;
    bf16* QD = (bf16*)(ws + (dir == 0 ? WS_QDF : WS_QDB));
    const int hcol = hd * 128;
    const int sh = tid >> 8, s_row = (tid & 255) >> 4, s_c16 = tid & 15;
    const bf16* srcA = (const bf16*)(ws + (sh == 0 ? (dir == 0 ? WS_QDF : WS_QDB) : (dir == 0 ? WS_KTF : WS_KTB))) + hcol + s_c16 * 8;
    const bf16* srcV = (const bf16*)(ws + WS_VH) + hcol + s_c16 * 8;
    const bool s_dec = sh == 1 && (tid & 255) < 32;
    const float* srcD = (const float*)(ws + (dir == 0 ? WS_DECF : WS_DECB)) + hcol + (tid & 31) * 4;
    const int s_off = s_row * SC_PITCH + s_c16 * 16;
    const int s_doff = SC_DEC + (tid & 31) * 16;
#define SC_LOAD1(A, Bv, Dv, pos) do { const int c_ = dir == 0 ? (pos) : 128 - (pos); const int rb_ = scan_rowbase(bl, c_); const size_t ro_ = (size_t)(rb_ + s_row) * 1024; \
        A = *(const GAS bf16x8*)(srcA + ro_); if (sh == 0) Bv = *(const GAS bf16x8*)(srcV + ro_); \
        if (s_dec) Dv = *(const GAS f32x4*)(srcD + (size_t)(rb_ >> 4) * 1024); } while (0)
#define SC_LOAD(SET, mac) do { SC_LOAD1(SET.a0, SET.b0, SET.d0, 2 * (mac)); if (2 * (mac) + 1 < SC_NPOS) SC_LOAD1(SET.a1, SET.b1, SET.d1, 2 * (mac) + 1); } while (0)
#define SC_WRITE1(A, Bv, Dv, base) do { LAS unsigned char* b_ = (base); *(LAS bf16x8*)(b_ + sh * SC_TILE + s_off) = A; \
        if (sh == 0) *(LAS bf16x8*)(b_ + 2 * SC_TILE + s_off) = Bv; if (s_dec) *(LAS f32x4*)(b_ + s_doff) = Dv; } while (0)
#define SC_WRITE(SET, buf, mac) do { SC_WRITE1(SET.a0, SET.b0, SET.d0, lds + (buf) * SC_BUF); if (2 * (mac) + 1 < SC_NPOS) SC_WRITE1(SET.a1, SET.b1, SET.d1, lds + (buf) * SC_BUF + SC_CH); } while (0)
    f32x4 S[8];
#pragma unroll
    for (int kb = 0; kb < 8; ++kb) S[kb] = (f32x4){0.f, 0.f, 0.f, 0.f};
    const int o_frag = i16 * SC_PITCH + 8 * g;
    const int o_tr = (4 * g + (i16 >> 2)) * SC_PITCH + (i16 & 3) * 8;
#define SC_CHUNK(Bp, pos) do { \
        const LAS unsigned char* B = (Bp); const int c = dir == 0 ? (pos) : 128 - (pos); const int rowb = scan_rowbase(bl, c); \
        bf16x8 cqd[4], ckt[4]; \
        _Pragma("unroll") for (int kk = 0; kk < 4; ++kk) { \
            const u32x2v a0 = *(const LAS u32x2v*)(B + o_frag + 64 * kk), a1 = *(const LAS u32x2v*)(B + o_frag + 64 * kk + 32); \
            const u32x2v b0 = *(const LAS u32x2v*)(B + SC_TILE + o_frag + 64 * kk), b1 = *(const LAS u32x2v*)(B + SC_TILE + o_frag + 64 * kk + 32); \
            cqd[kk] = __builtin_bit_cast(bf16x8, (v4u){a0.x, a0.y, a1.x, a1.y}); ckt[kk] = __builtin_bit_cast(bf16x8, (v4u){b0.x, b0.y, b1.x, b1.y}); } \
        s16x4 ktT[8]; \
        _Pragma("unroll") for (int kb = 0; kb < 8; ++kb) ktT[kb] = tr16(B + SC_TILE + o_tr + kb * 32); \
        const s16x4 vfr = tr16(B + 2 * SC_TILE + o_tr + vs * 32); \
          \
        f32x4 at = (f32x4){0.f, 0.f, 0.f, 0.f}; \
        _Pragma("unroll") for (int kk = 0; kk < 4; ++kk) at = __builtin_amdgcn_mfma_f32_16x16x32_bf16(ckt[kk], cqd[kk], at, 0, 0, 0); \
        _Pragma("unroll") for (int r = 0; r < 4; ++r) { const int s_ = 4 * g + r; const bool keep = dir == 0 ? (s_ <= i16) : (s_ >= i16); at[r] = keep ? at[r] : 0.f; } \
        const s16x4 pfr = __builtin_bit_cast(s16x4, (u32x2v){cvtpk(at[0], at[1]), cvtpk(at[2], at[3])}); \
          \
        const f32x4 oi = __builtin_amdgcn_mfma_f32_16x16x16bf16_1k(pfr, vfr, (f32x4){0.f, 0.f, 0.f, 0.f}, 0, 0, 0); \
        f32x4 oe = (f32x4){0.f, 0.f, 0.f, 0.f}; \
        _Pragma("unroll") for (int kk = 0; kk < 4; ++kk) { \
            const f32x4 s0 = S[2 * kk], s1 = S[2 * kk + 1]; \
            const bf16x8 sb = __builtin_bit_cast(bf16x8, (v4u){cvtpk(s0[0], s0[1]), cvtpk(s0[2], s0[3]), cvtpk(s1[0], s1[1]), cvtpk(s1[2], s1[3])}); \
            oe = __builtin_amdgcn_mfma_f32_16x16x32_bf16(cqd[kk], sb, oe, 0, 0, 0); } \
        const f32x4 o = oi + oe; \
          \
        _Pragma("unroll") for (int kb = 0; kb < 8; ++kb) { const f32x4 dec = *(const LAS f32x4*)(B + SC_DEC + (16 * kb + 4 * g) * 4); \
            S[kb] = __builtin_amdgcn_mfma_f32_16x16x16bf16_1k(ktT[kb], vfr, S[kb], 0, 0, 0); S[kb] = S[kb] * dec; } \
          \
        if (!(layer == 1 && c == 0) && !dry) { \
            _Pragma("unroll") for (int r = 0; r < 4; ++r) QD[(size_t)(rowb + 4 * g + r) * 1024 + hcol + 16 * vs + i16] = (bf16)(cvtpk(o[r], 0.f) & 0xffffu); } } while (0)
#define SC_STEP(mac, LOADSET, NEXT) do { \
        const int buf = (mac) & 1; \
        if ((mac) + 2 < SC_NMAC) SC_LOAD(LOADSET, (mac) + 2); \
        SC_CHUNK(lds + buf * SC_BUF, 2 * (mac)); \
        if (2 * (mac) + 1 < SC_NPOS) SC_CHUNK(lds + buf * SC_BUF + SC_CH, 2 * (mac) + 1); \
        if ((mac) + 1 < SC_NMAC) SC_WRITE(NEXT, buf ^ 1, (mac) + 1); \
        __syncthreads(); } while (0)
    ScanSet R0, R1;
    SC_LOAD(R0, 0); SC_LOAD(R1, 1);
    SC_WRITE(R0, 0, 0);
    __syncthreads();
#pragma unroll 1
    for (int mc = 0; mc < SC_NMAC - 1; mc += 2) {
        SC_STEP(mc, R0, R1);
        SC_STEP(mc + 1, R1, R0);
    }
    SC_STEP(SC_NMAC - 1, R0, R1);
#undef SC_LOAD1
#undef SC_LOAD
#undef SC_WRITE1
#undef SC_WRITE
#undef SC_CHUNK
#undef SC_STEP
}
__device__ __forceinline__ void hgrn_finalize_item(Frame& F, size_t gq_half, int bl, int hd, int layer, bool dry = false) {
    int tid_l = F.tid; asm volatile("; LAUNDER" : "+v"(tid_l));
    const int tid = tid_l, lane = tid & 63, wave = __builtin_amdgcn_readfirstlane(tid >> 6), g = lane >> 4, i16 = lane & 15;
    unsigned char* const ws = F.ws; const int hcol = hd * 128;
    const float* gn = F.A->in[5] + layer * 128 + 8 * i16;
    const f32x4 g0 = *(const GAS f32x4*)gn, g1 = *(const GAS f32x4*)(gn + 4);
    const int ntok = layer == 1 ? SEQ : LTOK;
    for (int tk = wave * 4 + g; tk < ntok; tk += NWAVES * 4) {
        const int row = tk < SEQ ? bl * 2048 + tk : 8192 + bl * 16 + (tk - SEQ);
        const size_t ro = (size_t)row * 1024 + hcol + 8 * i16;
        const v4u a = *(const GAS v4u*)((const bf16*)(ws + WS_QDF) + ro), b = *(const GAS v4u*)((const bf16*)(ws + WS_QDB) + ro);
        float v[8];
        v[0] = bflo(a.x) + bflo(b.x); v[1] = bfhi(a.x) + bfhi(b.x); v[2] = bflo(a.y) + bflo(b.y); v[3] = bfhi(a.y) + bfhi(b.y);
        v[4] = bflo(a.z) + bflo(b.z); v[5] = bfhi(a.z) + bfhi(b.z); v[6] = bflo(a.w) + bflo(b.w); v[7] = bfhi(a.w) + bfhi(b.w);
        float ss = 0.f;
#pragma unroll
        for (int e = 0; e < 8; ++e) ss += v[e] * v[e];
        ss = sum16(ss);
        const float rs = 1.0f / sqrtf(ss * (1.0f / 128.0f) + NEPS);
        bf16* gp = (bf16*)(ws + WS_GQ + gq_half) + (size_t)row * 2048 + hcol + 8 * i16;
        const v4u gt = *(const GAS v4u*)gp;
        v4u w;
        w.x = cvtpk(v[0] * rs * g0[0] * bflo(gt.x), v[1] * rs * g0[1] * bfhi(gt.x)); w.y = cvtpk(v[2] * rs * g0[2] * bflo(gt.y), v[3] * rs * g0[3] * bfhi(gt.y));
        w.z = cvtpk(v[4] * rs * g1[0] * bflo(gt.z), v[5] * rs * g1[1] * bfhi(gt.z)); w.w = cvtpk(v[6] * rs * g1[2] * bflo(gt.w), v[7] * rs * g1[3] * bfhi(gt.w));
        if (!dry) *(GAS v4u*)gp = w;
    }
}

constexpr int AT_SHM_V = 64 * 128 * 2, AT_SHM_K = 64 * 128 * 2;
constexpr int AT_X_OFF = 2 * AT_SHM_V + 2 * AT_SHM_K, AT_WS_OFF = AT_X_OFF + 65536;
constexpr float AT_THR2 = 11.5f;
#define KSWZ(row, colB) ((row) * 256 + ((colB) ^ (((row) & 7) << 4)))
#define SBAR() __builtin_amdgcn_sched_barrier(0)
__device__ __forceinline__ int crow(int r, int hi) { return (r & 3) + 8 * (r >> 2) + 4 * hi; }
__device__ __forceinline__ int v_st(int k, int c) { const int kk = (k & ~0xC) | ((k & 4) << 1) | ((k & 8) >> 1); return ((kk >> 3) * 4 + (c >> 5)) * 512 + ((kk & 7) * 32 + (c & 31)) * 2; }
__device__ __forceinline__ int v_rd_base(int lane) { return ((lane & 3) << 3) | (((lane >> 2) & 3) << 6) | (((lane >> 4) & 1) << 5) | (((lane >> 5) & 1) << 8); }
constexpr int v_rd_off(int d0, int ks, int half) { return d0 * 512 + ks * 4096 + half * 2048; }
template <int OFF> __device__ __forceinline__ s16x4 tr_read(int vb) {
    s16x4 r; asm volatile("ds_read_b64_tr_b16 %0, %1 offset:%2" : "=&v"(r) : "v"(vb), "i"(OFF) : "memory"); return r;
}
template <int D0> __device__ __forceinline__ void pv_one(f32x16& od, int vb, bf16x8 pa0, bf16x8 pa1, bf16x8 pa2, bf16x8 pa3) {
    const s16x4 l0 = tr_read<v_rd_off(D0, 0, 0)>(vb), h0 = tr_read<v_rd_off(D0, 0, 1)>(vb), l1 = tr_read<v_rd_off(D0, 1, 0)>(vb), h1 = tr_read<v_rd_off(D0, 1, 1)>(vb);
    const s16x4 l2 = tr_read<v_rd_off(D0, 2, 0)>(vb), h2 = tr_read<v_rd_off(D0, 2, 1)>(vb), l3 = tr_read<v_rd_off(D0, 3, 0)>(vb), h3 = tr_read<v_rd_off(D0, 3, 1)>(vb);
    asm volatile("s_waitcnt lgkmcnt(0)" ::: "memory"); SBAR();
#define PK(L, H) (bf16x8){L[0], L[1], L[2], L[3], H[0], H[1], H[2], H[3]}
    od = __builtin_amdgcn_mfma_f32_32x32x16_bf16(pa0, PK(l0, h0), od, 0, 0, 0);
    od = __builtin_amdgcn_mfma_f32_32x32x16_bf16(pa1, PK(l1, h1), od, 0, 0, 0);
    od = __builtin_amdgcn_mfma_f32_32x32x16_bf16(pa2, PK(l2, h2), od, 0, 0, 0);
    od = __builtin_amdgcn_mfma_f32_32x32x16_bf16(pa3, PK(l3, h3), od, 0, 0, 0);
#undef PK
}
__device__ __forceinline__ void attn_tile(f32x16 (&o)[4], float& m_reg, float& l_reg, const LAS unsigned char* Ks  , int vb, const bf16x8 (&qr)[4], bool meta_tile, bool first,
                                          LAS float* al_l, int r32, int hi) {
    f32x16 p0, p1;
    { f32x16 negm;
#pragma unroll
      for (int r = 0; r < 16; ++r) negm[r] = -m_reg;
#pragma unroll
      for (int d0 = 0; d0 < 4; ++d0) { const int cb = (d0 * 16 + hi * 8) * 2;
        const bf16x8 b0 = *(const LAS bf16x8*)(Ks + KSWZ(r32, cb));
        const bf16x8 b1 = *(const LAS bf16x8*)(Ks + KSWZ(32 + r32, cb));
        p0 = __builtin_amdgcn_mfma_f32_32x32x16_bf16(b0, qr[d0], d0 == 0 ? negm : p0, 0, 0, 0);
        p1 = __builtin_amdgcn_mfma_f32_32x32x16_bf16(b1, qr[d0], d0 == 0 ? negm : p1, 0, 0, 0); } }
    if (meta_tile) {
#pragma unroll
        for (int r = 8; r < 16; ++r) p0[r] = -INFINITY;
#pragma unroll
        for (int r = 0; r < 16; ++r) p1[r] = -INFINITY;
    }
    float pa_ = fmaxf(fmaxf(p0[0], p0[1]), p1[0]), pb_ = fmaxf(fmaxf(p0[2], p0[3]), p1[1]);
    pa_ = fmaxf(fmaxf(pa_, p1[2]), p1[3]);
#pragma unroll
    for (int r = 4; r < 16; r += 4) { pa_ = fmaxf(fmaxf(pa_, p0[r]), p0[r + 1]); pb_ = fmaxf(fmaxf(pb_, p0[r + 2]), p0[r + 3]); pa_ = fmaxf(fmaxf(pa_, p1[r]), p1[r + 1]); pb_ = fmaxf(fmaxf(pb_, p1[r + 2]), p1[r + 3]); }
    float pmax = fmaxf(pa_, pb_);
    { auto rr = __builtin_amdgcn_permlane32_swap(__float_as_uint(pmax), __float_as_uint(pmax), false, false);
      pmax = fmaxf(__uint_as_float(rr[0]), __uint_as_float(rr[1])); }
    if (first || __any(pmax > AT_THR2)) {
        const float dl = first ? pmax : fmaxf(pmax, 0.f); const float alpha = __builtin_amdgcn_exp2f(-dl);
        m_reg += dl; l_reg *= alpha;
#pragma unroll
        for (int r = 0; r < 16; ++r) { p0[r] -= dl; p1[r] -= dl; }
        if (hi == 0) al_l[r32] = alpha;
        asm volatile("s_waitcnt lgkmcnt(0)" ::: "memory");
#pragma unroll
        for (int d = 0; d < 4; ++d)
#pragma unroll
            for (int r = 0; r < 16; ++r) o[d][r] *= al_l[crow(r, hi)];
    }
#pragma unroll
    for (int r = 0; r < 16; ++r) { p0[r] = __builtin_amdgcn_exp2f(p0[r]); p1[r] = __builtin_amdgcn_exp2f(p1[r]); }
    float ps = 0.f, ps2 = 0.f;
#pragma unroll
    for (int r = 0; r < 16; ++r) { ps += p0[r]; ps2 += p1[r]; }
    ps += ps2;
    { auto rr = __builtin_amdgcn_permlane32_swap(__float_as_uint(ps), __float_as_uint(ps), false, false);
      ps = __uint_as_float(rr[0]) + __uint_as_float(rr[1]); }
    l_reg += ps;
    bf16x8 pa0, pa1, pa2, pa3;
#define PK4(P, BASE, OUT) do { unsigned a0 = cvtpk(P[BASE + 0], P[BASE + 1]), a1 = cvtpk(P[BASE + 2], P[BASE + 3]);   \
    unsigned b0_ = cvtpk(P[BASE + 4], P[BASE + 5]), b1_ = cvtpk(P[BASE + 6], P[BASE + 7]);                              \
    auto r0 = __builtin_amdgcn_permlane32_swap(a0, b0_, false, false); auto r1 = __builtin_amdgcn_permlane32_swap(a1, b1_, false, false); \
    v4u w = {r0[0], r1[0], r0[1], r1[1]}; OUT = __builtin_bit_cast(bf16x8, w); } while (0)
    PK4(p0, 0, pa0); PK4(p0, 8, pa1); PK4(p1, 0, pa2); PK4(p1, 8, pa3);
#undef PK4
    pv_one<0>(o[0], vb, pa0, pa1, pa2, pa3); pv_one<1>(o[1], vb, pa0, pa1, pa2, pa3); pv_one<2>(o[2], vb, pa0, pa1, pa2, pa3); pv_one<3>(o[3], vb, pa0, pa1, pa2, pa3);
}
__device__ __forceinline__ void attn_phase(Frame& F, size_t gq_half, int layer, gu32* head) {
    int tid_l = F.tid; asm volatile("; LAUNDER" : "+v"(tid_l));
    const int tid = tid_l, wid = __builtin_amdgcn_readfirstlane(tid >> 6), lane = tid & 63, r32 = lane & 31, hi = lane >> 5, rg = wid & 3, cc = wid >> 2;
    LAS unsigned char* lds = F.lds; unsigned char* const ws = F.ws; bf16* const GQ = (bf16*)(ws + WS_GQ + gq_half);
    LAS unsigned char* V_lds = lds; LAS unsigned char* K_lds = lds + 2 * AT_SHM_V;
    LAS float* wsf = (LAS float*)(lds + AT_WS_OFF) + wid * 64; LAS float* li_l = wsf; LAS float* al_l = wsf + 32;
    LAS float* X = (LAS float*)(lds + AT_X_OFF) + rg * 4096;
    const bf16* KA = (const bf16*)(ws + WS_KA); const bf16* VA = (const bf16*)(ws + WS_VA);
    const int sr = tid >> 4, sc = (tid & 15) * 8, vst0 = v_st(sr, sc), vst1 = v_st(32 + sr, sc);
    const int vb0 = (int)(uintptr_t)V_lds + v_rd_base(lane);
    constexpr int NT = 33;
    const int per_pair = layer == 0 ? 17 : 16, nitems = 32 * per_pair;
    const float lam_init = 0.8f - 0.6f * expf(-0.3f * (float)layer);
    float lam;
    { const float* lv = F.A->in[6] + layer * 256; const float d1 = wave_sum(lv[lane] * lv[64 + lane]), d2 = wave_sum(lv[128 + lane] * lv[192 + lane]); lam = expf(d1) - expf(d2) + lam_init; }
    bf16x8 vs0, vs1, ks0, ks1;
#define AROW(bl_, kt, k) ((kt) < 32 ? ((bl_) * 2048 + (kt) * 64 + (k)) : (8192 + (bl_) * 16 + ((k) & 15)))
#define SLOAD(bl_, hd_, kt) do { const size_t ra_ = (size_t)AROW(bl_, kt, sr) * 1024 + (hd_) * 128 + sc, rb_ = (size_t)AROW(bl_, kt, 32 + sr) * 1024 + (hd_) * 128 + sc; \
        vs0 = *(const GAS bf16x8*)(VA + ra_); vs1 = *(const GAS bf16x8*)(VA + rb_); ks0 = *(const GAS bf16x8*)(KA + ra_); ks1 = *(const GAS bf16x8*)(KA + rb_); } while (0)
#define SWRITE(b) do { *(LAS bf16x8*)(V_lds + (b) * AT_SHM_V + vst0) = vs0; *(LAS bf16x8*)(V_lds + (b) * AT_SHM_V + vst1) = vs1; const int kc_ = sc * 2; \
        *(LAS bf16x8*)(K_lds + (b) * AT_SHM_K + KSWZ(sr, kc_)) = ks0; *(LAS bf16x8*)(K_lds + (b) * AT_SHM_K + KSWZ(32 + sr, kc_)) = ks1; } while (0)
#define QROW0(meta_, bl_, qt_) ((meta_) ? (8192 + (bl_) * 16) : ((bl_) * 2048 + (qt_) * 128 + rg * 32))
#define QLOAD(dst, meta_, bl_, hd_, qt_) do { const int q0_ = QROW0(meta_, bl_, qt_); const int qr_ = (meta_) ? (q0_ + (r32 & 15)) : (q0_ + r32); \
        const bf16* Qw_ = GQ + (size_t)qr_ * 2048 + 1024 + (hd_) * 128 + cc * 64 + hi * 8; \
        _Pragma("unroll") for (int d0 = 0; d0 < 4; ++d0) dst[d0] = *(const GAS bf16x8*)(Qw_ + d0 * 16); } while (0)
    if (tid == 0) F.MISC[16] = __hip_atomic_fetch_add(head, 1u, RLX_AGENT);
    __syncthreads();
    int cur = (int)F.MISC[16];
    __syncthreads();
    if (cur >= nitems) return;
    int pair = cur / per_pair, sub = cur - pair * per_pair; int bl = pair >> 3, hd = pair & 7, qt = sub; bool meta = sub == 16;
    bf16x8 qr[4], qn[4];
    QLOAD(qr, meta, bl, hd, qt);
    SLOAD(bl, hd, 0); SWRITE(0); SLOAD(bl, hd, 1);
    __syncthreads();
    int par = 0;
    for (;;) {
        unsigned nxt_reg = 0u;
        if (tid == 0) nxt_reg = __hip_atomic_fetch_add(head, 1u, RLX_AGENT);
        bool nvalid = false; int nbl = 0, nhd = 0, nqt = 0; bool nmeta = false;
        float m_reg = 0.f, l_reg = 0.f;
        f32x16 o[4] = {};
        for (int kt = 0; kt < NT; ++kt) {
            if (kt == 4 && tid == 0) F.MISC[16] = nxt_reg;
            if (kt == 5) { const int nx = (int)F.MISC[16]; nvalid = nx < nitems; const int np = nx / per_pair, ns = nx - np * per_pair; nbl = np >> 3; nhd = np & 7; nqt = ns; nmeta = ns == 16; }
            if (kt + 1 < NT || nvalid) SWRITE(par ^ 1);
            if (kt + 2 < NT) SLOAD(bl, hd, kt + 2); else if (nvalid) SLOAD(nbl, nhd, kt + 2 - NT);
            if (kt == NT - 1 && nvalid) QLOAD(qn, nmeta, nbl, nhd, nqt);
            attn_tile(o, m_reg, l_reg, K_lds + par * AT_SHM_K + cc * 128, vb0 + par * AT_SHM_V, qr, kt == 32, kt == 0, al_l, r32, hi);
            __syncthreads();
            par ^= 1;
        }
        if (hi == 0) li_l[r32] = l_reg;
        asm volatile("s_waitcnt lgkmcnt(0)" ::: "memory");
        float ra[16];
#pragma unroll
        for (int r = 0; r < 16; ++r) ra[r] = __builtin_amdgcn_rcpf(li_l[crow(r, hi)]) * (cc == 1 ? lam : 1.0f);
        if (cc == 1) {
#pragma unroll
            for (int d = 0; d < 4; ++d)
#pragma unroll
                for (int r = 0; r < 16; ++r) X[(d * 16 + r) * 64 + lane] = o[d][r] * ra[r];
        }
        __syncthreads();
        if (cc == 0) {
#pragma unroll
            for (int d = 0; d < 4; ++d)
#pragma unroll
                for (int r = 0; r < 16; ++r) o[d][r] = o[d][r] * ra[r] - X[(d * 16 + r) * 64 + lane];
            asm volatile("s_waitcnt lgkmcnt(0)" ::: "memory");
#pragma unroll
            for (int d = 0; d < 4; ++d)
#pragma unroll
                for (int r = 0; r < 16; ++r) X[crow(r, hi) * 128 + 32 * d + r32] = o[d][r];
            asm volatile("s_waitcnt lgkmcnt(0)" ::: "memory");
            if (!meta || rg == 0) {
                const bf16* GAp = (const bf16*)(ws + WS_GA); const float* sg = F.A->in[7] + layer * 128; const int qrow0 = QROW0(meta, bl, qt);
                const int c16 = lane & 15;
                const f32x4 sg0 = *(const GAS f32x4*)(sg + 8 * c16), sg1 = *(const GAS f32x4*)(sg + 8 * c16 + 4);
#pragma unroll
                for (int it = 0; it < 8; ++it) { const int row = it * 4 + (lane >> 4);
                    const f32x4 x0 = *(const LAS f32x4*)(X + row * 128 + 8 * c16), x1 = *(const LAS f32x4*)(X + row * 128 + 8 * c16 + 4);
                    float ss = (x0[0] * x0[0] + x0[1] * x0[1]) + (x0[2] * x0[2] + x0[3] * x0[3]) + (x1[0] * x1[0] + x1[1] * x1[1]) + (x1[2] * x1[2] + x1[3] * x1[3]);
                    ss = sum16(ss);
                    const float rs = (1.0f / sqrtf(ss * (1.0f / 128.0f) + NEPS)) * (1.0f - lam_init);
                    if (meta && row >= 16) continue;
                    const size_t grow = (size_t)(qrow0 + row); const int col = hd * 128 + 8 * c16;
                    const v4u gt = *(const GAS v4u*)(GAp + grow * 1024 + col);
                    v4u w; w.x = cvtpk(x0[0] * rs * sg0[0] * bflo(gt.x), x0[1] * rs * sg0[1] * bfhi(gt.x)); w.y = cvtpk(x0[2] * rs * sg0[2] * bflo(gt.y), x0[3] * rs * sg0[3] * bfhi(gt.y));
                    w.z = cvtpk(x1[0] * rs * sg1[0] * bflo(gt.z), x1[1] * rs * sg1[1] * bfhi(gt.z)); w.w = cvtpk(x1[2] * rs * sg1[2] * bflo(gt.w), x1[3] * rs * sg1[3] * bfhi(gt.w));
                    *(GAS v4u*)(GQ + grow * 2048 + 1024 + col) = w; }
            }
        }
        if (!nvalid) break;
        bl = nbl; hd = nhd; qt = nqt; meta = nmeta;
#pragma unroll
        for (int d0 = 0; d0 < 4; ++d0) qr[d0] = qn[d0];
    }
    __syncthreads();
#undef AROW
#undef SLOAD
#undef SWRITE
#undef QROW0
#undef QLOAD
}
#undef SBAR


#ifdef DBG
namespace nv {
constexpr int D = 1024, BATCH = 8, SEQ = 2048, NMETA = 16, L = SEQ + NMETA, T = BATCH * L;
constexpr int INW = 9216, MIXW = 2048, NH = 8;
constexpr float EPS = 1e-6f, F_FLOOR = 1e-30f;

__device__ __forceinline__ float wave_sum(float v) {
#pragma unroll
    for (int o = 1; o < 64; o <<= 1) v += __shfl_xor(v, o);
    return v;
}
__device__ __forceinline__ float wave_max(float v) {
#pragma unroll
    for (int o = 1; o < 64; o <<= 1) v = fmaxf(v, __shfl_xor(v, o));
    return v;
}
__device__ __forceinline__ float sigmoidf_(float z) { return 1.0f / (1.0f + expf(-z)); }
__device__ __forceinline__ float siluf_(float z) { return z / (1.0f + expf(-z)); }

__global__ void k_build_h(const float* __restrict__ x, const float* __restrict__ meta, float* __restrict__ h) {
    const size_t n4 = (size_t)T * D / 4;
    for (size_t i = blockIdx.x * (size_t)blockDim.x + threadIdx.x; i < n4; i += (size_t)gridDim.x * blockDim.x) {
        const size_t e = i * 4; const int d = (int)(e % D); const size_t row = e / D; const int b = (int)(row / L), t = (int)(row % L);
        const float4 v = t < NMETA ? *(const float4*)(meta + (size_t)t * D + d) : *(const float4*)(x + ((size_t)b * SEQ + (t - NMETA)) * D + d);
        *(float4*)(h + e) = v;
    }
}
__global__ void k_rmsnorm(const float* __restrict__ in, const float* __restrict__ g, float* __restrict__ out, int rows, int drop_meta) {
    const int wave = (blockIdx.x * blockDim.x + threadIdx.x) >> 6, lane = threadIdx.x & 63;
    if (wave >= rows) return;
    int orow = wave;
    if (drop_meta) { const int b = wave / L, t = wave % L; if (t < NMETA) return; orow = b * SEQ + (t - NMETA); }
    const float* r = in + (size_t)wave * D; float v[16]; float s = 0.f;
#pragma unroll
    for (int j = 0; j < 16; ++j) { v[j] = r[lane + 64 * j]; s += v[j] * v[j]; }
    s = wave_sum(s); const float rs = rsqrtf(s * (1.0f / D) + EPS);
#pragma unroll
    for (int j = 0; j < 16; ++j) out[(size_t)orow * D + lane + 64 * j] = v[j] * rs * g[lane + 64 * j];
}
__global__ void __launch_bounds__(256) k_gemm(const float* __restrict__ A, int lda, const float* __restrict__ B, int ldb, float* __restrict__ C, int ldc,
                                              int M, int N, int K, int accumulate) {
    __shared__ float As[16][68], Bs[16][68];
    const int tid = threadIdx.x, tx = tid & 15, ty = tid >> 4, m0 = blockIdx.y * 64, n0 = blockIdx.x * 64;
    float acc[4][4];
#pragma unroll
    for (int i = 0; i < 4; ++i)
#pragma unroll
        for (int j = 0; j < 4; ++j) acc[i][j] = 0.f;
    for (int k0 = 0; k0 < K; k0 += 16) {
        { const int r = tid >> 2, c = (tid & 3) * 4; const int gr = m0 + r; float4 a = make_float4(0.f, 0.f, 0.f, 0.f);
          if (gr < M) a = *(const float4*)(A + (size_t)gr * lda + k0 + c);
          As[c + 0][r] = a.x; As[c + 1][r] = a.y; As[c + 2][r] = a.z; As[c + 3][r] = a.w; }
        { const int r = tid >> 4, c = (tid & 15) * 4; const float4 b = *(const float4*)(B + (size_t)(k0 + r) * ldb + n0 + c);
          Bs[r][c + 0] = b.x; Bs[r][c + 1] = b.y; Bs[r][c + 2] = b.z; Bs[r][c + 3] = b.w; }
        __syncthreads();
#pragma unroll
        for (int kk = 0; kk < 16; ++kk) {
            float a[4], b[4];
#pragma unroll
            for (int i = 0; i < 4; ++i) a[i] = As[kk][ty * 4 + i];
#pragma unroll
            for (int j = 0; j < 4; ++j) b[j] = Bs[kk][tx * 4 + j];
#pragma unroll
            for (int i = 0; i < 4; ++i)
#pragma unroll
                for (int j = 0; j < 4; ++j) acc[i][j] = fmaf(a[i], b[j], acc[i][j]);
        }
        __syncthreads();
    }
#pragma unroll
    for (int i = 0; i < 4; ++i) { const int gr = m0 + ty * 4 + i; if (gr >= M) continue;
        float* cp = C + (size_t)gr * ldc + n0 + tx * 4;
        float4 o = make_float4(acc[i][0], acc[i][1], acc[i][2], acc[i][3]);
        if (accumulate) { const float4 c = *(const float4*)cp; o.x += c.x; o.y += c.y; o.z += c.z; o.w += c.w; }
        *(float4*)cp = o; }
}
__global__ void k_rope(float* __restrict__ p) {
    const int idx = blockIdx.x * blockDim.x + threadIdx.x;
    if (idx >= L * 2 * NH * 2 * 32) return;
    const int i = idx & 31, c = (idx >> 5) & 1, hd = (idx >> 6) & 7, which = (idx >> 9) & 1, t = idx >> 10;
    const float inv = powf(10000.0f, -(float)(2 * i) / 64.0f); const float ang = (float)t * inv;
    const float cs = cosf(ang), sn = sinf(ang);
    float* base = p + (size_t)t * INW + 5120 + which * 1024 + hd * 128 + c * 64;
    const float t1 = base[i], t2 = base[32 + i];
    base[i] = t1 * cs - t2 * sn; base[32 + i] = t2 * cs + t1 * sn;
}
__global__ void __launch_bounds__(256) k_hgrn(const float* __restrict__ p, int ldp, const float* __restrict__ lb_logits  , int layer,
                                              float* __restrict__ o_f, float* __restrict__ o_b) {
    __shared__ float sq[128], sf[128], sk[128], sacc[256];
    const int hd = blockIdx.x, dir = blockIdx.y, tid = threadIdx.x, v = tid & 127, kh = tid >> 7;
    float lb = 0.f;
    if (tid < 128) { if (layer == 1) { const float l0 = lb_logits[(0 * 2 + dir) * 1024 + hd * 128 + tid], l1 = lb_logits[(1 * 2 + dir) * 1024 + hd * 128 + tid];
            const float m = fmaxf(l0, l1); const float e0 = expf(l0 - m), e1 = expf(l1 - m); lb = e1 / (e0 + e1); } }
    float S[64];
#pragma unroll
    for (int k = 0; k < 64; ++k) S[k] = 0.f;
    float* out = dir == 0 ? o_f : o_b;
    for (int step = 0; step < L; ++step) {
        const int t = dir == 0 ? step : L - 1 - step;
        const float* row = p + (size_t)t * ldp;
        if (tid < 128) {
            const float z = row[(dir == 0 ? 1024 : 2048) + hd * 128 + tid];
            const float s = sigmoidf_(z), sn = sigmoidf_(-z);
            sq[tid] = row[hd * 128 + tid]; sf[tid] = lb + (1.0f - lb) * s; sk[tid] = (1.0f - lb) * sn;
        }
        const float vv = row[3072 + hd * 128 + v];
        __syncthreads();
        float acc = 0.f;
#pragma unroll
        for (int k = 0; k < 64; ++k) { const int kk = kh * 64 + k; S[k] = fmaf(sf[kk], S[k], sk[kk] * vv); acc = fmaf(S[k], sq[kk], acc); }
        sacc[tid] = acc;
        __syncthreads();
        if (tid < 128) out[(size_t)t * 1024 + hd * 128 + tid] = sacc[tid] + sacc[tid + 128];
    }
}
__global__ void k_hgrn_final(const float* __restrict__ o_f, const float* __restrict__ o_b, const float* __restrict__ p, const float* __restrict__ g, float* __restrict__ mixed) {
    const int wave = (blockIdx.x * blockDim.x + threadIdx.x) >> 6, lane = threadIdx.x & 63;
    if (wave >= L * NH) return;
    const int t = wave >> 3, hd = wave & 7;
    const size_t off = (size_t)t * 1024 + hd * 128;
    const float a0 = o_f[off + lane] + o_b[off + lane], a1 = o_f[off + 64 + lane] + o_b[off + 64 + lane];
    const float ss = wave_sum(a0 * a0 + a1 * a1); const float rs = rsqrtf(ss * (1.0f / 128.0f) + EPS);
    const float g0 = p[(size_t)t * INW + 4096 + hd * 128 + lane], g1 = p[(size_t)t * INW + 4096 + hd * 128 + 64 + lane];
    mixed[(size_t)t * MIXW + hd * 128 + lane] = a0 * rs * g[lane] * siluf_(g0);
    mixed[(size_t)t * MIXW + hd * 128 + 64 + lane] = a1 * rs * g[64 + lane] * siluf_(g1);
}
constexpr int NKP = ((L + 63) / 64) * 64;
__global__ void __launch_bounds__(128) k_attn(const float* __restrict__ p, const float* __restrict__ lamv  , const float* __restrict__ subg, int layer, float* __restrict__ mixed) {
    __shared__ float sq[2][128]; __shared__ float sp[2][NKP]; __shared__ float st[2][NKP];
    const int wid = threadIdx.x >> 6, lane = threadIdx.x & 63; const int gw = blockIdx.x * 2 + wid;
    const int t = gw >> 3, hd = gw & 7;
    const float lam_init = 0.8f - 0.6f * expf(-0.3f * (float)layer);
    float d1 = lamv[lane] * lamv[64 + lane], d2 = lamv[128 + lane] * lamv[192 + lane];
    d1 = wave_sum(d1); d2 = wave_sum(d2);
    const float lam = expf(d1) - expf(d2) + lam_init;
    const float* qrow = p + (size_t)t * INW + 5120 + hd * 128;
    sq[wid][lane] = qrow[lane]; sq[wid][64 + lane] = qrow[64 + lane];
    __syncthreads();
#pragma unroll 1
    for (int c = 0; c < 2; ++c) {
        float m = -INFINITY;
#pragma unroll 1
        for (int key = lane; key < L; key += 64) {
            const float* kr = p + (size_t)key * INW + 6144 + hd * 128 + c * 64; float a = 0.f;
#pragma unroll 4
            for (int d = 0; d < 64; d += 4) { const float4 k0 = *(const float4*)(kr + d);
                a += sq[wid][c * 64 + d] * k0.x + sq[wid][c * 64 + d + 1] * k0.y + sq[wid][c * 64 + d + 2] * k0.z + sq[wid][c * 64 + d + 3] * k0.w; }
            a *= 0.125f; st[wid][key] = a; m = fmaxf(m, a);
        }
        m = wave_max(m);
        float l = 0.f;
#pragma unroll 1
        for (int key = lane; key < L; key += 64) { const float e = expf(st[wid][key] - m); st[wid][key] = e; l += e; }
        l = wave_sum(l);
        const float sc = c == 0 ? 1.0f / l : -lam / l;
#pragma unroll 1
        for (int key = lane; key < L; key += 64) { const float v = st[wid][key] * sc; sp[wid][key] = c == 0 ? v : sp[wid][key] + v; }
    }
    __syncthreads();
    float o0 = 0.f, o1 = 0.f;
#pragma unroll 4
    for (int key = 0; key < L; ++key) { const float pd = sp[wid][key]; const float* vr = p + (size_t)key * INW + 7168 + hd * 128;
        o0 = fmaf(pd, vr[lane], o0); o1 = fmaf(pd, vr[64 + lane], o1); }
    const float ss = wave_sum(o0 * o0 + o1 * o1); const float rs = rsqrtf(ss * (1.0f / 128.0f) + EPS) * (1.0f - lam_init);
    const float g0 = p[(size_t)t * INW + 8192 + hd * 128 + lane], g1 = p[(size_t)t * INW + 8192 + hd * 128 + 64 + lane];
    mixed[(size_t)t * MIXW + 1024 + hd * 128 + lane] = o0 * rs * subg[lane] * siluf_(g0);
    mixed[(size_t)t * MIXW + 1024 + hd * 128 + 64 + lane] = o1 * rs * subg[64 + lane] * siluf_(g1);
}
}
__device__ __forceinline__ float dbg_bf(const unsigned short* a, size_t i) { return __uint_as_float((unsigned)a[i] << 16); }
__device__ __forceinline__ void dbg_acc(float& d, float& r, float v, float ref) { const float e = fabsf(v - ref); if (!(e == e)) d = 1e30f; d = fmaxf(d, e); r = fmaxf(r, fabsf(ref)); }
__global__ void dbg_check_epi(const float* __restrict__ pb5  , const unsigned char* __restrict__ ws, unsigned* __restrict__ res) {
    const int idx = blockIdx.x * blockDim.x + threadIdx.x; if (idx >= 129 * 1024) return;
    const int c = idx >> 10, ch = idx & 1023;
    const unsigned short *QDF = (const unsigned short*)(ws + WS_QDF), *KTF = (const unsigned short*)(ws + WS_KTF), *QDB = (const unsigned short*)(ws + WS_QDB), *KTB = (const unsigned short*)(ws + WS_KTB);
    const float *DECF = (const float*)(ws + WS_DECF), *DECB = (const float*)(ws + WS_DECB);
    float dq = 0.f, rq = 0.f, dk = 0.f, rk = 0.f, dd = 0.f, rd = 0.f;
    float b = 0.f;
    for (int i = 0; i < 16; ++i) { const float* pr = pb5 + (size_t)(16 * c + i) * 5120; const float q = pr[ch], z = pr[1024 + ch];
        const float f = 1.0f / (1.0f + expf(-z)), kin = 1.0f / (1.0f + expf(z)); b += logf(fmaxf(f, 1e-30f));
        const size_t row = c == 0 ? 8192 + i : 16 * (c - 1) + i;
        dbg_acc(dq, rq, dbg_bf(QDF, row * 1024 + ch), q * expf(b)); dbg_acc(dk, rk, dbg_bf(KTF, row * 1024 + ch) * expf(b), kin); }
    dbg_acc(dd, rd, DECF[(size_t)(c == 0 ? 512 : c - 1) * 1024 + ch], expf(b));
    b = 0.f;
    for (int i = 15; i >= 0; --i) { const float* pr = pb5 + (size_t)(16 * c + i) * 5120; const float q = pr[ch], z = pr[2048 + ch];
        const float f = 1.0f / (1.0f + expf(-z)), kin = 1.0f / (1.0f + expf(z)); b += logf(fmaxf(f, 1e-30f));
        const size_t row = c == 0 ? 8192 + i : 16 * (c - 1) + i;
        dbg_acc(dq, rq, dbg_bf(QDB, row * 1024 + ch), q * expf(b)); dbg_acc(dk, rk, dbg_bf(KTB, row * 1024 + ch) * expf(b), kin); }
    dbg_acc(dd, rd, DECB[(size_t)(c == 0 ? 512 : c - 1) * 1024 + ch], expf(b));
    atomicMax(res + 0, __float_as_uint(dq)); atomicMax(res + 1, __float_as_uint(rq)); atomicMax(res + 2, __float_as_uint(dk)); atomicMax(res + 3, __float_as_uint(rk));
    atomicMax(res + 4, __float_as_uint(dd)); atomicMax(res + 5, __float_as_uint(rd));
}
__global__ void dbg_check_o(const float* __restrict__ of, const float* __restrict__ ob, const unsigned char* __restrict__ ws, unsigned* __restrict__ res) {
    const unsigned short *QDF = (const unsigned short*)(ws + WS_QDF), *QDB = (const unsigned short*)(ws + WS_QDB);
    float df = 0.f, rf = 0.f, db = 0.f, rb = 0.f;
    for (int i = blockIdx.x * blockDim.x + threadIdx.x; i < 2064 * 1024; i += gridDim.x * blockDim.x) { const int t = i >> 10, c = i & 1023; const size_t row = t < 16 ? 8192 + t : t - 16;
        dbg_acc(df, rf, dbg_bf(QDF, row * 1024 + c), of[i]); dbg_acc(db, rb, dbg_bf(QDB, row * 1024 + c), ob[i]); }
    atomicMax(res + 8, __float_as_uint(df)); atomicMax(res + 9, __float_as_uint(rf)); atomicMax(res + 10, __float_as_uint(db)); atomicMax(res + 11, __float_as_uint(rb));
}

__global__ void __launch_bounds__(256) dbg_chunk_oracle(const unsigned char* __restrict__ ws, float* __restrict__ o2f, float* __restrict__ o2b) {
    __shared__ float sQ[16][128], sK[16][128], sV[16][128], sA[16][16], sO[2][16][128], sD[128];
    const int hd = blockIdx.x, dir = blockIdx.y, tid = threadIdx.x, v = tid & 127, kh = tid >> 7;
    const unsigned short* QD = (const unsigned short*)(ws + (dir == 0 ? WS_QDF : WS_QDB)); const unsigned short* KT = (const unsigned short*)(ws + (dir == 0 ? WS_KTF : WS_KTB));
    const unsigned short* VH = (const unsigned short*)(ws + WS_VH); const float* DEC = (const float*)(ws + (dir == 0 ? WS_DECF : WS_DECB));
    float* out = dir == 0 ? o2f : o2b;
    float S[64];
#pragma unroll
    for (int k = 0; k < 64; ++k) S[k] = 0.f;
    for (int step = 0; step < 129; ++step) {
        const int c = dir == 0 ? step : 128 - step; const size_t rowb = c == 0 ? 8192 : 16 * (c - 1);
        for (int i = tid; i < 16 * 128; i += 256) { const int t = i >> 7, k = i & 127; const size_t o = (rowb + t) * 1024 + hd * 128 + k;
            sQ[t][k] = dbg_bf(QD, o); sK[t][k] = dbg_bf(KT, o); sV[t][k] = dbg_bf(VH, o); }
        if (tid < 128) sD[tid] = DEC[(size_t)(c == 0 ? 512 : c - 1) * 1024 + hd * 128 + tid];
#ifdef DBG_DEC1
        if (tid < 128) sD[tid] = 0.5f;
#endif
#ifdef DBG_SFIX
#pragma unroll
        for (int k = 0; k < 64; ++k) S[k] = DBG_SFN(kh * 64 + k, v);
#endif
        __syncthreads();
        { const int t = tid >> 4, s = tid & 15; float a = 0.f; for (int k = 0; k < 128; ++k) a += sQ[t][k] * sK[s][k];
          const bool keep = dir == 0 ? (s <= t) : (s >= t); sA[t][s] = keep ? a : 0.f; }
        __syncthreads();
#pragma unroll 1
        for (int t = 0; t < 16; ++t) { float acc = 0.f;
#ifndef DBG_NOINTRA
            if (kh == 0) {
#pragma unroll 1
                for (int s = 0; s < 16; ++s) acc += sA[t][s] * sV[s][v]; }
#endif
#ifndef DBG_INTRA_ONLY
#pragma unroll
            for (int k = 0; k < 64; ++k) acc += sQ[t][kh * 64 + k] * S[k];
#endif
            sO[kh][t][v] = acc; }
        { float U[64];
#pragma unroll
          for (int k = 0; k < 64; ++k) U[k] = 0.f;
#pragma unroll 1
          for (int s = 0; s < 16; ++s) { const float vs = sV[s][v];
#pragma unroll
              for (int k = 0; k < 64; ++k) U[k] += sK[s][kh * 64 + k] * vs; }
#pragma unroll
          for (int k = 0; k < 64; ++k) S[k] = sD[kh * 64 + k] * (S[k] + U[k]); }
        __syncthreads();
        for (int i = tid; i < 16 * 128; i += 256) { const int t = i >> 7, vv = i & 127; const int tok = c * 16 + t; out[(size_t)tok * 1024 + hd * 128 + vv] = sO[0][t][vv] + sO[1][t][vv]; }
        __syncthreads();
    }
}
__global__ void dbg_check_o2(const float* __restrict__ of, const float* __restrict__ ob, const float* __restrict__ o2f, const float* __restrict__ o2b, unsigned* __restrict__ res) {
    float df = 0.f, rf = 0.f, db = 0.f, rb = 0.f;
    for (int i = blockIdx.x * blockDim.x + threadIdx.x; i < 2064 * 1024; i += gridDim.x * blockDim.x) { dbg_acc(df, rf, o2f[i], of[i]); dbg_acc(db, rb, o2b[i], ob[i]); }
    atomicMax(res + 12, __float_as_uint(df)); atomicMax(res + 13, __float_as_uint(rf)); atomicMax(res + 14, __float_as_uint(db)); atomicMax(res + 15, __float_as_uint(rb));
}
__device__ int dbg_digit(float d, float r) { const float rel = d / fmaxf(r, 1e-20f); if (!(rel == rel) || rel > 1e20f) return 9; int k = (int)floorf(-2.0f * log10f(fmaxf(rel, 1e-12f))); return k < 1 ? 1 : (k > 8 ? 8 : k); }
__global__ void dbg_report(float* __restrict__ out, int n, const unsigned* __restrict__ res, int ia, int ib) {
    for (int i = blockIdx.x * blockDim.x + threadIdx.x; i < n; i += gridDim.x * blockDim.x) out[i] = 0.f;
    if (blockIdx.x == 0 && threadIdx.x == 0) {
        const int d1 = dbg_digit(__uint_as_float(res[ia]), __uint_as_float(res[ia + 1])), d2 = dbg_digit(__uint_as_float(res[ib]), __uint_as_float(res[ib + 1]));
        out[0] = (float)(d1 * 10 + d2) * 1000.0f;
    }
}
#endif

#ifdef TPROBE
#ifndef TPROBE_BLOCK
#define TPROBE_BLOCK 0
#endif
#ifndef TPROBE_MULT
#define TPROBE_MULT 2
#endif
#define TP_START(id) do { if ((id) == TPROBE && F.bid == TPROBE_BLOCK && F.tid == 0) { const unsigned long long t_ = __builtin_amdgcn_s_memrealtime(); F.MISC[24] = (unsigned)t_; F.MISC[25] = (unsigned)(t_ >> 32); } } while (0)
#define TP_STOP(id) do { if ((id) == TPROBE && F.bid == TPROBE_BLOCK && F.tid == 0) { const unsigned long long t_ = __builtin_amdgcn_s_memrealtime(), s_ = ((unsigned long long)F.MISC[25] << 32) | F.MISC[24]; \
        unsigned long long a_ = ((unsigned long long)F.MISC[27] << 32) | F.MISC[26]; a_ += t_ - s_; F.MISC[26] = (unsigned)a_; F.MISC[27] = (unsigned)(a_ >> 32); } } while (0)
#else
#define TP_START(id) do {} while (0)
#define TP_STOP(id) do {} while (0)
#endif
#ifndef ABL
#define ABL 0
#endif
#ifndef TYMASK
#define TYMASK 0xffu
#endif
#define TY(t) ((TYMASK >> (t)) & 1u)
#ifndef REPMASK
#define REPMASK 0u
#endif
#define NREP(t) (1 + (int)((REPMASK >> (t)) & 1u))
#ifndef PHMASK
#define PHMASK 0xffffffffu
#endif
__device__ __forceinline__ void meta_outproj(Frame& F, int task) {
    int tid_l = F.tid; asm volatile("; LAUNDER" : "+v"(tid_l));
    const int rg = task >> 4, cb = task & 15, half = rg >> 2, bl = rg & 3, lane = tid_l & 63, g = lane >> 4, i16 = lane & 15, wave = __builtin_amdgcn_readfirstlane(tid_l >> 6);
    const bf16* A = (const bf16*)(F.ws + WS_GQ) + ((size_t)half * HROWS + 8192 + bl * 16 + i16) * 2048;
    const bf16* B = (const bf16*)(F.ws + WS_WOUT) + (size_t)(cb * 64 + i16) * 2048;
    f32x4 acc[4];
#pragma unroll
    for (int nt = 0; nt < 4; ++nt) acc[nt] = (f32x4){0.f, 0.f, 0.f, 0.f};
#pragma unroll 2
    for (int kk = 0; kk < 8; ++kk) { const int k0 = wave * 256 + kk * 32 + 8 * g;
        const bf16x8 a = *(const GAS bf16x8*)(A + k0);
#pragma unroll
        for (int nt = 0; nt < 4; ++nt) { const bf16x8 b = *(const GAS bf16x8*)(B + (size_t)nt * 16 * 2048 + k0); acc[nt] = __builtin_amdgcn_mfma_f32_16x16x32_bf16(a, b, acc[nt], 0, 0, 0); } }
    LAS f32x4* red = (LAS f32x4*)F.lds;
#pragma unroll
    for (int nt = 0; nt < 4; ++nt) red[(wave * 4 + nt) * 64 + lane] = acc[nt];
    __syncthreads();
    if (wave < 4) { const int nt = wave; f32x4 s = red[nt * 64 + lane];
#pragma unroll
        for (int w = 1; w < 8; ++w) s = s + red[(w * 4 + nt) * 64 + lane];
        float* hm = (float*)(F.ws + WS_HMETA);
#pragma unroll
        for (int r = 0; r < 4; ++r) { const int j = 4 * g + r, col = cb * 64 + 16 * nt + i16; hm[(size_t)(rg * 16 + j) * 1024 + col] = F.A->in[1][(size_t)j * 1024 + col] + s[r]; } }
    __syncthreads();
}
__device__ __forceinline__ void phase_norm_mid(Frame& F) {
    const int tid = fresh_tid(), lane = tid & 63, wave = __builtin_amdgcn_readfirstlane(tid >> 6);
    const int gw = F.bid * NWAVES + wave, NGW = F.G * NWAVES; bf16* U = (bf16*)(F.ws + WS_U);
    const float* g1 = F.A->in[2] + DM; const float* hm = (const float*)(F.ws + WS_HMETA);
    for (int m = gw; m < NBATCH * SEQ + NBATCH * NMETA; m += NGW) {
        if (m < NBATCH * SEQ) { const int half = m >> 13; norm_row_to_bf16(lane, F.out + (size_t)m * DM, g1, U + ((size_t)m + half * 256) * DM, 1, 0); }
        else { const int mm = m - NBATCH * SEQ, b = mm >> 4, j = mm & 15; norm_row_to_bf16(lane, hm + (size_t)mm * DM, g1, U + ((size_t)(b >> 2) * HROWS + 8192 + (b & 3) * 16 + j) * DM, 1, 0); }
    }
}
__device__ __forceinline__ void phase_norm_final(Frame& F) {
    const int tid = fresh_tid(), lane = tid & 63, wave = __builtin_amdgcn_readfirstlane(tid >> 6);
    const int gw = F.bid * NWAVES + wave, NGW = F.G * NWAVES;
    for (int m = gw; m < NBATCH * SEQ; m += NGW) {
        GAS f32x4* xr = (GAS f32x4*)(F.out + (size_t)m * DM) + lane; const GAS f32x4* gr = (const GAS f32x4*)F.A->in[9] + lane;
        f32x4 v[4]; float s = 0.f;
#pragma unroll
        for (int j = 0; j < 4; ++j) { v[j] = xr[64 * j]; s += (v[j].x * v[j].x + v[j].y * v[j].y) + (v[j].z * v[j].z + v[j].w * v[j].w); }
        const float rs = 1.0f / sqrtf(wave_sum(s) * (1.0f / DM) + NEPS);
#pragma unroll
        for (int j = 0; j < 4; ++j) { const f32x4 gg = gr[64 * j]; xr[64 * j] = v[j] * rs * gg; }
    }
}
__device__ __forceinline__ void phase_mix(Frame& F, int layer, int half) {
    const size_t gq_half = (size_t)half * HROWS * 2048 * 2;
    #ifndef NO_SCAN
    if (F.bid < 64) {
        const int bl = F.bid >> 4, hd = (F.bid >> 1) & 7, dir = F.bid & 1;
        if (NREP(5) > 1) { const bool odry = __hip_atomic_load(F.ctl + 8, RLX_AGENT) == 0u;   hgrn_scan_item(F, bl, hd, dir, layer, odry); __syncthreads(); }
        TP_START(2); hgrn_scan_item(F, bl, hd, dir, layer); TP_STOP(2);
        asm volatile("s_waitcnt vmcnt(0)" ::: "memory");
        __syncthreads();
        if (F.tid == 0) { __builtin_amdgcn_fence(__ATOMIC_RELEASE, "agent"); asm volatile("s_waitcnt vmcnt(0)" ::: "memory");
            F.MISC[17] = __hip_atomic_fetch_add(F.ctl + CW_QUEUE + 64 * (8 + 2 * layer + half) + (bl * 8 + hd), 1u, RLX_AGENT); }
        __syncthreads();
        const bool last = F.MISC[17] == 1u;
        __syncthreads();
        if (last) {
            if (F.tid == 0) { __builtin_amdgcn_fence(__ATOMIC_ACQUIRE, "agent"); asm volatile("s_waitcnt vmcnt(0)" ::: "memory"); }
            __syncthreads();
            hgrn_finalize_item(F, gq_half, bl, hd, layer);
        }
        __syncthreads();
    }
#endif
#ifndef NO_ATTN
    TP_START(3); attn_phase(F, gq_half, layer, F.ctl + CW_QUEUE + 64 * (2 * layer + half)); TP_STOP(3);
#endif
}

constexpr int N_PHASES = 13;
#ifndef MK_N_LAUNCHES
#define MK_N_LAUNCHES 1
#endif
__global__ void __launch_bounds__(NTHREADS, 2) hymba_fwd(Args args) {
    extern __shared__ __attribute__((aligned(16))) unsigned char lds[];
    Frame F;
    F.lds = (LAS unsigned char*)lds; F.MISC = (volatile LAS unsigned*)(F.lds + MISC_OFF);
    F.tid = threadIdx.x; F.lane = F.tid & 63; F.wave = __builtin_amdgcn_readfirstlane(F.tid >> 6); F.G = gridDim.x; F.bid = blockIdx.x;
    F.ws = args.ws; F.ctl = (gu32*)(args.ws + WS_CTL); F.out = args.out;
    F.A = &args;
    for (int u = F.tid; u < (LDS_BYTES - LDSCTL_OFF) / 4; u += NTHREADS) ((LAS unsigned*)(F.lds + LDSCTL_OFF))[u] = 0u;
    __syncthreads();
    XcdBarrier bar; bar.bar = (unsigned*)(F.ctl + CW_BAR) + args.li * XCD_BAR_WORDS; bar.x = 0; bar.st = nullptr;
    const int lo = args.ph_lo, hi = args.ph_hi;
    if (hi - lo > 1) bar = xcd_barrier_post((unsigned*)(F.ctl + CW_BAR) + args.li * XCD_BAR_WORDS, F.MISC + 8);
#define IN(k) (((PHMASK >> (k)) & 1u) && lo <= (k) && (k) < hi)
#define SEAM(k) do { if (IN(k) && IN((k) + 1)) xcd_barrier(bar); } while (0)
    unsigned char* ws = args.ws;
    TP_START(10); if (TY(0) && IN(0)) { for (int rep = 0; rep < NREP(0); ++rep) { p0_prologue(F); if (rep + 1 < NREP(0)) xcd_barrier(bar); } SEAM(0); } TP_STOP(10);
#pragma unroll 1
    for (int l = 0; l < 2; ++l) {
        const int pb = 1 + 6 * l;
#pragma unroll 1
        for (int half = 0; half < 2; ++half) {
            if (TY(1) && IN(pb + 2 * half)) {
                TP_START(11); TP_START(21);
                pg8::Gemm g{(const pg8::bf16_t*)(ws + WS_U) + (size_t)half * HROWS * DM, (const pg8::bf16_t*)(ws + WS_WIN) + (size_t)l * INW * DM, HROWS, INW, DM};
                pg8::OrderIn S; S.init(HROWS, INW, F.G, F.bid);
                pg8::EpiIn E{ws, (size_t)half * HROWS * 2048 * 2, F.A->in[4], l};
                for (int rep = 0; rep < NREP(1); ++rep) { pg8::gemm_phase<pg8::EpiIn, pg8::OrderIn, true, true>(F.lds, g, S, E); if (rep + 1 < NREP(1)) xcd_barrier(bar); }
                TP_STOP(21); SEAM(pb + 2 * half); TP_STOP(11);
            }
            if (TY(2) && IN(pb + 2 * half + 1)) { TP_START(12); TP_START(22); phase_mix(F, l, half); TP_STOP(22); SEAM(pb + 2 * half + 1); TP_STOP(12); }
        }
        if (TY(3) && IN(pb + 4)) {
            TP_START(13); TP_START(23);
            pg8::Gemm g{(const pg8::bf16_t*)(ws + WS_GQ), (const pg8::bf16_t*)(ws + WS_WOUT) + (size_t)l * DM * 2048, NBATCH * SEQ, DM, 2048};
            pg8::OrderOut S; S.init(NBATCH * SEQ, DM, F.G, F.bid);
            pg8::EpiOut E{l == 0 ? F.A->in[0] : (const float*)F.out, F.out};
            for (int rep = 0; rep < (l == 0 ? NREP(3) : 1); ++rep) { pg8::gemm_phase<pg8::EpiOut, pg8::OrderOut, false, true>(F.lds, g, S, E);
            if (l == 0) { for (int t = F.bid; t < 128; t += F.G) meta_outproj(F, t); } if (rep + 1 < (l == 0 ? NREP(3) : 1)) xcd_barrier(bar); }
            TP_STOP(23); SEAM(pb + 4); TP_STOP(13);
        }
        if (TY(4) && IN(pb + 5)) { TP_START(14); if (l == 0) { for (int rep = 0; rep < NREP(4); ++rep) { phase_norm_mid(F); if (rep + 1 < NREP(4)) xcd_barrier(bar); } SEAM(pb + 5); } else phase_norm_final(F); TP_STOP(14); }
    }
#undef IN
#undef SEAM
#ifdef TPROBE
    if (F.bid == TPROBE_BLOCK && F.tid == 0) { const unsigned long long a_ = (((unsigned long long)F.MISC[27] << 32) | F.MISC[26]) * TPROBE_MULT, t0_ = __builtin_amdgcn_s_memrealtime();
        while (__builtin_amdgcn_s_memrealtime() - t0_ < a_) __builtin_amdgcn_s_sleep(8); }
#endif
}

extern "C" void kernel_launch(void* const* d_in, const int* in_sizes, int n_in, void* d_out, int out_size, void* d_ws, size_t ws_size, hipStream_t stream) {
    static int grid = 0;
    if (grid == 0) {
        if (n_in != 10 || in_sizes[0] != NBATCH * SEQ * DM || out_size != NBATCH * SEQ * DM || ws_size < WS_END) {
            fprintf(stderr, "kernel_launch: shape/workspace mismatch: n_in %d in0 %d out %d ws %zu (need %zu)\n", n_in, n_in > 0 ? in_sizes[0] : -1, out_size, ws_size, (size_t)WS_END); grid = -1; return; }
        int dev = 0, cus = 0;
        if (hipGetDevice(&dev) != hipSuccess || hipDeviceGetAttribute(&cus, hipDeviceAttributeMultiprocessorCount, dev) != hipSuccess) { grid = -1; return; }
        if (hipFuncSetAttribute((const void*)hymba_fwd, hipFuncAttributeMaxDynamicSharedMemorySize, LDS_BYTES) != hipSuccess) { fprintf(stderr, "kernel_launch: hipFuncSetAttribute failed\n"); grid = -1; return; }
        int per_cu = 0;
        if (hipOccupancyMaxActiveBlocksPerMultiprocessor(&per_cu, (const void*)hymba_fwd, NTHREADS, LDS_BYTES) != hipSuccess || per_cu < 1)
            fprintf(stderr, "kernel_launch: note: occupancy query reports %d workgroups per CU\n", per_cu);
        (void)hipGetLastError();
        grid = cus;
    }
    if (grid < 0) return;
#ifdef DBG
    float* dbg_pb5 = (float*)d_out; float* dbg_of = (float*)((char*)d_ws + WS_GQ + 2 * SZ_HALF); float* dbg_ob = dbg_of + (size_t)2064 * 1024;
    {   using nv::L; using nv::D; using nv::NH;
        float* hb = (float*)((char*)d_ws + WS_U + SZ_HALF); float* ub = hb + (size_t)L * D;
        const float* x = (const float*)d_in[0]; const float* meta = (const float*)d_in[1];
        (void)hipMemcpyAsync(hb, meta, (size_t)16 * D * 4, hipMemcpyDeviceToDevice, stream); (void)hipMemcpyAsync(hb + 16 * D, x, (size_t)nv::SEQ * D * 4, hipMemcpyDeviceToDevice, stream);
        nv::k_rmsnorm<<<(L + 3) / 4, 256, 0, stream>>>(hb, (const float*)d_in[2], ub, L, 0);
        nv::k_gemm<<<dim3(5120 / 64, (L + 63) / 64), 256, 0, stream>>>(ub, D, (const float*)d_in[3], nv::INW, dbg_pb5, 5120, L, 5120, D, 0);
        nv::k_hgrn<<<dim3(NH, 2), 256, 0, stream>>>(dbg_pb5, 5120, (const float*)d_in[4], 0, dbg_of, dbg_ob);
    }
#endif
    if (hipMemsetAsync((char*)d_ws + WS_CTL, 0, CTL_ZERO_BYTES, stream) != hipSuccess) { fprintf(stderr, "kernel_launch: memset failed\n"); return; }
    Args a{};
    for (int i = 0; i < 10; ++i) a.in[i] = (const float*)d_in[i];
    a.out = (float*)d_out; a.ws = (unsigned char*)d_ws;
    constexpr int NL = MK_N_LAUNCHES;
#ifdef DBG
    const int nl_run = 3;
#else
    const int nl_run = NL;
#endif
    for (int li = 0; li < nl_run; ++li) {
        a.ph_lo = NL == 1 ? 0 : li; a.ph_hi = NL == 1 ? N_PHASES : li + 1; a.li = NL == 1 ? 0 : 0;
        hipLaunchKernelGGL(hymba_fwd, dim3(grid), dim3(NTHREADS), LDS_BYTES, stream, a);
        const hipError_t le = hipPeekAtLastError();
        if (le != hipSuccess) { fprintf(stderr, "kernel_launch: launch %d failed: %s\n", li, hipGetErrorName(le)); break; }
#ifdef DBG
        if (li == 1) { dbg_check_epi<<<(129 * 1024 + 255) / 256, 256, 0, stream>>>(dbg_pb5, (const unsigned char*)d_ws, (unsigned*)d_ws + 64);
            float* o2f = (float*)((char*)d_ws + WS_U + SZ_HALF); float* o2b = o2f + (size_t)2064 * 1024;
            dbg_chunk_oracle<<<dim3(8, 2), 256, 0, stream>>>((const unsigned char*)d_ws, o2f, o2b);
            dbg_check_o2<<<1024, 256, 0, stream>>>(dbg_of, dbg_ob, o2f, o2b, (unsigned*)d_ws + 64); }
#endif
    }
#ifdef DBG
#ifdef DBG_VS_O2
    { float* o2f = (float*)((char*)d_ws + WS_U + SZ_HALF); float* o2b = o2f + (size_t)2064 * 1024; dbg_check_o<<<1024, 256, 0, stream>>>(o2f, o2b, (const unsigned char*)d_ws, (unsigned*)d_ws + 64); }
#else
    dbg_check_o<<<1024, 256, 0, stream>>>(dbg_of, dbg_ob, (const unsigned char*)d_ws, (unsigned*)d_ws + 64);
#endif
    dbg_report<<<1024, 256, 0, stream>>>((float*)d_out, out_size, (const unsigned*)d_ws + 64, DBG_IA, DBG_IB);
#endif
}
```
